# Optimizing an MI355X kernel written in HIP

```python
import jax, jax.numpy as jnp
from jax import lax
import numpy as np

D_MODEL = 2048
BATCH = 8
SEQ = 2048
DEPTH = 2

GRID_W = 64
CTX_LEN = 256
N_MIXERS = 2
EPS = 1e-6
ADA_CHUNKS = 6
MLSTM_HEADS = 8
MLSTM_DQK = D_MODEL // (2 * MLSTM_HEADS)
MLSTM_DV = D_MODEL // MLSTM_HEADS
QK_W = MLSTM_HEADS * MLSTM_DQK
V_W = MLSTM_HEADS * MLSTM_DV
MLSTM_IN_W = 2 * QK_W + 2 * V_W + 4 * MLSTM_HEADS
MLSTM_CHUNK = 64
GATE_CAP = 15.0
M_INIT = -1e30
N_EXPERTS = 64
TOP_K = 6
EXPERT_DIM = D_MODEL // 4
ROUTED_SCALE = 2.5
MOE_BLOCK = 128

kernel_name = 'hybrid_conv_mlstm_moe_prefix_dit'


def rmsnorm(x, w):
    xf = x.astype(jnp.float32)
    y = xf * lax.rsqrt(jnp.mean(xf * xf, axis=-1, keepdims=True) + EPS)
    return (y * w.astype(jnp.float32)).astype(x.dtype)


def ada_mod(cond, w, b):
    return jnp.split(jax.nn.silu(cond) @ w + b, ADA_CHUNKS, axis=-1)


def modulate(h, shift, scale):
    return h * (1 + scale) + shift


def dwconv3(u, w):
    pad = [(0, 0)] * (u.ndim - 2) + [(1, 1), (0, 0)]
    up = jnp.pad(u, pad)
    return up[..., :-2, :] * w[0] + up[..., 1:-1, :] * w[1] + up[..., 2:, :] * w[2]


def conv_mixer(h, w_in, w_dw, w_out, on_grid):
    b_gate, c_gate, h_in = jnp.split(h @ w_in, 3, axis=-1)
    u = c_gate * h_in
    if on_grid:
        bsz, n_tok, d = u.shape
        rows = n_tok // GRID_W
        y = dwconv3(u.reshape(bsz, rows, GRID_W, d), w_dw).reshape(bsz, n_tok, d)
    else:
        y = dwconv3(u, w_dw)
    return (b_gate * y) @ w_out


def mlstm_project(h, w_in, gate_b):
    bsz, n_tok, _ = h.shape
    q, k, v, o, g = jnp.split(h @ w_in, [QK_W, 2 * QK_W, 2 * QK_W + V_W, 2 * QK_W + 2 * V_W], axis=-1)

    def heads(t, d):
        return t.reshape(bsz, n_tok, MLSTM_HEADS, d).transpose(0, 2, 1, 3).astype(jnp.float32)

    q = heads(q, MLSTM_DQK)
    k = heads(k, MLSTM_DQK) * (MLSTM_DQK ** -0.5)
    v = heads(v, MLSTM_DV)
    g = (g + gate_b).astype(jnp.float32)
    g = GATE_CAP * jnp.tanh(g / GATE_CAP)
    g = g.reshape(bsz, n_tok, 4, MLSTM_HEADS).transpose(2, 0, 3, 1)
    gates = (g[0], jax.nn.log_sigmoid(g[1]), g[2], jax.nn.log_sigmoid(g[3]))
    return q, k, v, o, gates


def mlstm_chunkwise(q, k, v, log_i, log_f, state):
    bsz, n_head, n_tok, dqk = q.shape
    dv = v.shape[-1]
    n_chunk = n_tok // MLSTM_CHUNK

    def to_chunks(a):
        return jnp.moveaxis(a.reshape(bsz, n_head, n_chunk, MLSTM_CHUNK, *a.shape[3:]), 2, 0)

    xs = (to_chunks(q), to_chunks(k), to_chunks(v), to_chunks(log_i), to_chunks(log_f))
    tri = jnp.tril(jnp.ones((MLSTM_CHUNK, MLSTM_CHUNK), dtype=bool))

    def step(carry, inp):
        c_st, n_st, m_st = carry
        qc, kc, vc, li, lf = inp
        b = jnp.cumsum(lf, axis=-1)
        a = b + m_st[..., None]
        dmat = jnp.where(tri, b[..., :, None] - b[..., None, :] + li[..., None, :], -jnp.inf)
        m_row = jnp.maximum(a, jnp.max(dmat, axis=-1))
        w_intra = jnp.exp(dmat - m_row[..., None])
        w_inter = jnp.exp(a - m_row)
        s = jnp.einsum('bhtd,bhsd->bhts', qc, kc) * w_intra
        num = jnp.einsum('bhts,bhsv->bhtv', s, vc) + w_inter[..., None] * jnp.einsum('bhtd,bhdv->bhtv', qc, c_st)
        den = jnp.sum(s, axis=-1) + w_inter * jnp.einsum('bhtd,bhd->bht', qc, n_st)
        h = num / jnp.maximum(jnp.abs(den), jnp.exp(-m_row))[..., None]
        b_last = b[..., -1]
        g = b_last[..., None] - b + li
        m_new = jnp.maximum(b_last + m_st, jnp.max(g, axis=-1))
        decay = jnp.exp(b_last + m_st - m_new)
        wk = jnp.exp(g - m_new[..., None])
        c_new = decay[..., None, None] * c_st + jnp.einsum('bhs,bhsd,bhsv->bhdv', wk, kc, vc)
        n_new = decay[..., None] * n_st + jnp.einsum('bhs,bhsd->bhd', wk, kc)
        return (c_new, n_new, m_new), h

    state, hs = lax.scan(step, state, xs)
    h = jnp.moveaxis(hs, 0, 2).reshape(bsz, n_head, n_tok, dv)
    return h, state


def mlstm_out(h, o, norm_w, w_out, dtype):
    bsz, n_head, n_tok, dv = h.shape
    hn = h * lax.rsqrt(jnp.mean(h * h, axis=-1, keepdims=True) + EPS)
    hn = hn.transpose(0, 2, 1, 3).reshape(bsz, n_tok, n_head * dv)
    y = hn * norm_w.astype(jnp.float32) * jax.nn.sigmoid(o.astype(jnp.float32))
    return y.astype(dtype) @ w_out


def rev(a):
    return jnp.flip(a, axis=2)


def mlstm_mixer(hl, hc, w_in, gate_b, norm_w, w_out, need_ctx):
    ql, kl, vl, ol, (lif, lff, lib, lfb) = mlstm_project(hl, w_in, gate_b)
    qc, kc, vc, oc, (cif, cff, cib, cfb) = mlstm_project(hc, w_in, gate_b)
    bsz = hl.shape[0]
    state0 = (jnp.zeros((bsz, MLSTM_HEADS, MLSTM_DQK, MLSTM_DV), jnp.float32),
              jnp.zeros((bsz, MLSTM_HEADS, MLSTM_DQK), jnp.float32),
              jnp.full((bsz, MLSTM_HEADS), M_INIT, jnp.float32))
    hcf, st_f = mlstm_chunkwise(qc, kc, vc, cif, cff, state0)
    hlf, _ = mlstm_chunkwise(ql, kl, vl, lif, lff, st_f)
    hcb, st_b = mlstm_chunkwise(rev(qc), rev(kc), rev(vc), rev(cib), rev(cfb), state0)
    hlb, _ = mlstm_chunkwise(rev(ql), rev(kl), rev(vl), rev(lib), rev(lfb), st_b)
    yl = mlstm_out(hlf + rev(hlb), ol, norm_w, w_out, hl.dtype)
    yc = mlstm_out(hcf + rev(hcb), oc, norm_w, w_out, hc.dtype) if need_ctx else None
    return yl, yc


def moe(h, router_w, router_bias, w_gate, w_up, w_down, sh_gate, sh_up, sh_down):
    n_tok, d = h.shape
    scores = jax.nn.sigmoid((h @ router_w).astype(jnp.float32))
    _, idx = lax.top_k(scores + router_bias.astype(jnp.float32), TOP_K)
    sel = jnp.take_along_axis(scores, idx, axis=-1)
    gates = sel / jnp.sum(sel, axis=-1, keepdims=True) * ROUTED_SCALE
    n_assign = n_tok * TOP_K
    expert_ids = idx.reshape(n_assign)
    token_ids = jnp.repeat(jnp.arange(n_tok, dtype=jnp.int32), TOP_K)
    order = jnp.argsort(expert_ids)
    e_sorted = expert_ids[order]
    counts = jnp.bincount(expert_ids, length=N_EXPERTS)
    padded = (counts + MOE_BLOCK - 1) // MOE_BLOCK * MOE_BLOCK
    start = jnp.cumsum(counts) - counts
    pend = jnp.cumsum(padded)
    pstart = pend - padded
    dest = pstart[e_sorted] + jnp.arange(n_assign, dtype=jnp.int32) - start[e_sorted]
    n_blocks = (n_assign + N_EXPERTS * (MOE_BLOCK - 1) + MOE_BLOCK - 1) // MOE_BLOCK
    n_slots = n_blocks * MOE_BLOCK
    buf_tok = jnp.full((n_slots,), n_tok, jnp.int32).at[dest].set(token_ids[order])
    buf_gate = jnp.zeros((n_slots,), h.dtype).at[dest].set(gates.reshape(n_assign)[order].astype(h.dtype))
    blk_expert = jnp.minimum(
        jnp.searchsorted(pend, jnp.arange(n_blocks, dtype=jnp.int32) * MOE_BLOCK, side='right'), N_EXPERTS - 1)
    h_pad = jnp.concatenate([h, jnp.zeros((1, d), h.dtype)], axis=0)

    def expert_block(args):
        tok, g, e = args
        xb = h_pad[tok]
        a = jax.nn.silu(xb @ w_gate[e]) * (xb @ w_up[e])
        return (a @ w_down[e]) * g[:, None]

    yb = lax.map(expert_block, (buf_tok.reshape(n_blocks, MOE_BLOCK),
                                buf_gate.reshape(n_blocks, MOE_BLOCK), blk_expert))
    routed = jax.ops.segment_sum(yb.reshape(n_slots, d), buf_tok, num_segments=n_tok + 1)[:n_tok]
    shared = (jax.nn.silu(h @ sh_gate) * (h @ sh_up)) @ sh_down
    return routed + shared


def setup_inputs(seed: int = 0) -> dict:
    key = jax.random.key(seed)
    ks = jax.random.split(key, 24)
    d = D_MODEL
    f32 = jnp.float32
    n_a = (DEPTH + 1) // 2
    n_b = DEPTH // 2

    def nrm(k, shape, s):
        return jax.random.normal(k, shape, f32) * s

    gate_off = jnp.array([0.0, 3.0, 0.0, 3.0], f32)[None, :, None]
    return {
        'x': nrm(ks[0], (BATCH, SEQ, d), 1.0),
        'c': nrm(ks[1], (BATCH, d), 1.0),
        'ctx': nrm(ks[2], (BATCH, CTX_LEN, d), 1.0),
        'c_ctx': nrm(ks[3], (d,), 1.0),
        'ada_w': nrm(ks[4], (DEPTH, d, ADA_CHUNKS * d), 0.5 * d ** -0.5),
        'ada_b': nrm(ks[5], (DEPTH, ADA_CHUNKS * d), 0.02),
        'norm_mix_w': 1.0 + nrm(ks[6], (DEPTH, d), 0.02),
        'norm_ffn_w': 1.0 + nrm(ks[7], (DEPTH, d), 0.02),
        'conv_in_w': nrm(ks[8], (n_a, d, 3 * d), d ** -0.5),
        'conv_dw_w': nrm(ks[9], (n_a, 3, d), 3 ** -0.5),
        'conv_out_w': nrm(ks[10], (n_a, d, d), d ** -0.5),
        'mlstm_in_w': nrm(ks[11], (n_b, d, MLSTM_IN_W), d ** -0.5),
        'mlstm_gate_b': (gate_off + nrm(ks[12], (n_b, 4, MLSTM_HEADS), 0.3)).reshape(n_b, 4 * MLSTM_HEADS),
        'mlstm_norm_w': 1.0 + nrm(ks[13], (n_b, V_W), 0.02),
        'mlstm_out_w': nrm(ks[14], (n_b, V_W, d), V_W ** -0.5),
        'router_w': nrm(ks[15], (DEPTH, d, N_EXPERTS), d ** -0.5),
        'router_bias': nrm(ks[16], (DEPTH, N_EXPERTS), 0.01),
        'exp_gate_w': nrm(ks[17], (DEPTH, N_EXPERTS, d, EXPERT_DIM), d ** -0.5),
        'exp_up_w': nrm(ks[18], (DEPTH, N_EXPERTS, d, EXPERT_DIM), d ** -0.5),
        'exp_down_w': nrm(ks[19], (DEPTH, N_EXPERTS, EXPERT_DIM, d), EXPERT_DIM ** -0.5),
        'shared_gate_w': nrm(ks[20], (DEPTH, d, EXPERT_DIM), d ** -0.5),
        'shared_up_w': nrm(ks[21], (DEPTH, d, EXPERT_DIM), d ** -0.5),
        'shared_down_w': nrm(ks[22], (DEPTH, EXPERT_DIM, d), EXPERT_DIM ** -0.5),
        'final_norm_w': 1.0 + nrm(ks[23], (d,), 0.02),
    }


def reference(x, c, ctx, c_ctx, ada_w, ada_b, norm_mix_w, norm_ffn_w, conv_in_w, conv_dw_w, conv_out_w,
              mlstm_in_w, mlstm_gate_b, mlstm_norm_w, mlstm_out_w, router_w, router_bias,
              exp_gate_w, exp_up_w, exp_down_w, shared_gate_w, shared_up_w, shared_down_w, final_norm_w):
    d = x.shape[-1]
    bsz, n_ctx = ctx.shape[0], ctx.shape[1]
    xl, xc = x, ctx
    for i in range(DEPTH):
        last = i == DEPTH - 1
        j = i // N_MIXERS
        sh1l, sc1l, g1l, sh2l, sc2l, g2l = [m[:, None, :] for m in ada_mod(c, ada_w[i], ada_b[i])]
        sh1c, sc1c, g1c, sh2c, sc2c, g2c = ada_mod(c_ctx, ada_w[i], ada_b[i])
        hl = modulate(rmsnorm(xl, norm_mix_w[i]), sh1l, sc1l)
        hc = modulate(rmsnorm(xc, norm_mix_w[i]), sh1c, sc1c)
        if i % N_MIXERS == 0:
            yl = conv_mixer(hl, conv_in_w[j], conv_dw_w[j], conv_out_w[j], True)
            yc = None if last else conv_mixer(hc, conv_in_w[j], conv_dw_w[j], conv_out_w[j], False)
        else:
            yl, yc = mlstm_mixer(hl, hc, mlstm_in_w[j], mlstm_gate_b[j], mlstm_norm_w[j], mlstm_out_w[j], not last)
        xl = xl + g1l * yl
        hl2 = modulate(rmsnorm(xl, norm_ffn_w[i]), sh2l, sc2l)
        moe_w = (router_w[i], router_bias[i], exp_gate_w[i], exp_up_w[i], exp_down_w[i],
                 shared_gate_w[i], shared_up_w[i], shared_down_w[i])
        if last:
            xl = xl + g2l * moe(hl2.reshape(-1, d), *moe_w).reshape(xl.shape)
        else:
            xc = xc + g1c * yc
            hc2 = modulate(rmsnorm(xc, norm_ffn_w[i]), sh2c, sc2c)
            f = moe(jnp.concatenate([hc2.reshape(-1, d), hl2.reshape(-1, d)], axis=0), *moe_w)
            n_c = bsz * n_ctx
            xc = xc + g2c * f[:n_c].reshape(xc.shape)
            xl = xl + g2l * f[n_c:].reshape(xl.shape)
    return rmsnorm(xl, final_norm_w)
```

```cpp
#include <hip/hip_runtime.h>
#include <stdint.h>
#include <stdio.h>

#ifndef MK_PER_PHASE
#define MK_PER_PHASE 0
#endif

#define GAS __attribute__((address_space(1)))
#define LAS __attribute__((address_space(3)))
typedef unsigned short bf16_t;
typedef short bf16x8 __attribute__((ext_vector_type(8)));
typedef short s16x4 __attribute__((ext_vector_type(4)));
typedef float f32x4 __attribute__((ext_vector_type(4)));
typedef float f32x2 __attribute__((ext_vector_type(2)));
typedef unsigned u32x4 __attribute__((ext_vector_type(4)));
typedef unsigned u32x2 __attribute__((ext_vector_type(2)));

constexpr int D = 2048, NBATCH = 8, SEQ = 2048, CTXL = 256;
constexpr int NCTX = NBATCH * CTXL;
constexpr int NLAT = NBATCH * SEQ;
constexpr int NTOK = NCTX + NLAT;
constexpr int NE = 64, TOPK = 6, ED = 512;
constexpr int ADA_N = 6 * D;
constexpr int MLSTM_N = 6176, MLSTM_NP = 6400;
constexpr int NWAVES = 8, NTHR = 512, GRID = 256;
constexpr int SH_BASE = 126976;
constexpr int NSLOT = SH_BASE + NTOK;
constexpr float EPS = 1e-6f;

constexpr size_t MiB = 1u << 20, KiB = 1024;
constexpr size_t WS_CTL = 0, CTL_BYTES = 1 * MiB;
constexpr size_t WS_MOD = 1 * MiB;
constexpr size_t WS_RT = 2 * MiB;
constexpr size_t RT_HIST = WS_RT;
constexpr size_t RT_EINFO = WS_RT + 64 * KiB;
constexpr size_t RT_SELIDX = WS_RT + 128 * KiB;
constexpr size_t RT_SELGATE = WS_RT + 640 * KiB;
constexpr size_t RT_SELRANK = WS_RT + 1152 * KiB;
constexpr size_t RT_SLOTOF = WS_RT + 1664 * KiB;
constexpr size_t RT_TOKOF = WS_RT + 2176 * KiB;
constexpr size_t RT_GATEOF = WS_RT + 2816 * KiB;
constexpr size_t WS_GATES = 10 * MiB;
constexpr size_t WS_CONVIN_T = 13 * MiB;
constexpr size_t WS_CONVOUT_T = 37 * MiB;
constexpr size_t WS_MLIN_T = 45 * MiB;
constexpr size_t WS_MLOUT_T = 70 * MiB;
constexpr size_t WS_MOE0 = 78 * MiB, MOE_STRIDE = 392 * MiB;
constexpr size_t MOE_GU = 0, MOE_DN = 260 * MiB, MOE_RT = 390 * MiB;
constexpr size_t WS_H = 862 * MiB;
constexpr size_t WS_X = 934 * MiB;
constexpr size_t WS_ACT = 1078 * MiB;
constexpr size_t WS_Y = 1220 * MiB;
constexpr size_t WS_U = WS_Y, WS_BM = WS_Y + 72 * MiB, WS_Z = WS_Y + 144 * MiB;
constexpr size_t WS_Q = WS_Y, WS_K = WS_Y + 36 * MiB, WS_V = WS_Y + 72 * MiB, WS_O = WS_Y + 144 * MiB;
constexpr size_t WS_HF = WS_Y + 216 * MiB, WS_HB = WS_Y + 280 * MiB, WS_YIN = WS_Y + 344 * MiB;
constexpr size_t WS_END = 1788 * MiB;
constexpr int CW_BAR = 4096;

constexpr int RING_BYTES = 131072;
constexpr int LDSCTL_OFF = 150 * 1024;
constexpr int LDS_BYTES = 151 * 1024;

#define LDS_WAIT() asm volatile("s_waitcnt lgkmcnt(0)" ::: "memory")
#define VM_WAIT() asm volatile("s_waitcnt vmcnt(0)" ::: "memory")
__device__ __forceinline__ unsigned cvt_pk_bf16(float lo, float hi) { unsigned r; asm volatile("v_cvt_pk_bf16_f32 %0, %1, %2" : "=v"(r) : "v"(lo), "v"(hi)); return r; }
__device__ __forceinline__ float bf_lo(unsigned u) { return __uint_as_float(u << 16); }
__device__ __forceinline__ float bf_hi(unsigned u) { return __uint_as_float(u & 0xffff0000u); }
__device__ __forceinline__ float wave_sum(float v) {
#pragma unroll
    for (int o = 1; o < 64; o <<= 1) v += __shfl_xor(v, o);
    return v;
}
__device__ __forceinline__ float fast_exp(float x) { return __builtin_amdgcn_exp2f(x * 1.44269504088896341f); }
__device__ __forceinline__ float sigmoidf_(float x) { return 1.0f / (1.0f + fast_exp(-x)); }
__device__ __forceinline__ float siluf_(float x) { return x / (1.0f + fast_exp(-x)); }

#define XB_TMO      128
#define XB_XCNT(j)  (256  + 64 * (j))
#define XB_XSUB(j)  (1280 + 64 * (j))
#define XB_XGEN(j)  (2304 + 64 * (j))
#define XB_TOP      3328
#define XB_TOPGEN   3392
#define XCD_BAR_WORDS 3456
#define XB_SPIN_CAP (1u << 22)

__device__ __forceinline__ unsigned xb_ld(unsigned* p)              { return __hip_atomic_load(p, __ATOMIC_RELAXED, __HIP_MEMORY_SCOPE_AGENT); }
__device__ __forceinline__ unsigned xb_add(unsigned* p, unsigned v) { return __hip_atomic_fetch_add(p, v, __ATOMIC_RELAXED, __HIP_MEMORY_SCOPE_AGENT); }
__device__ __forceinline__ unsigned xb_xcc_id() { return (unsigned)__builtin_amdgcn_s_getreg((3 << 11) | 20) & 0xFu; }
#define XB_SPIN(cond, bar) do { unsigned _sp = 0; while (cond) { __builtin_amdgcn_s_sleep(1); \
    if ((++_sp & 255u) == 0u) { if (xb_ld(&(bar)[XB_TMO])) break; if (_sp > XB_SPIN_CAP) { atomicAdd(&(bar)[XB_TMO], 1u); break; } } } } while (0)

struct XcdBarrier { unsigned* bar; unsigned x; volatile LAS unsigned* st; };

__device__ __forceinline__ XcdBarrier xcd_barrier_post(unsigned* bar, volatile LAS unsigned* st) {
    XcdBarrier b; b.bar = bar; b.x = xb_xcc_id(); b.st = st;
    if (threadIdx.x == 0) (void)xb_add(&bar[XB_XCNT(b.x)], 1u);
    return b;
}
__device__ __forceinline__ void xcd_barrier_complete(unsigned* bar, unsigned x, unsigned& nloc, unsigned& nx) {
    const unsigned G = gridDim.x * gridDim.y * gridDim.z;
    unsigned sum, cnt, mine, sp = 0u;
    for (;;) {
        sum = 0u; cnt = 0u; mine = 0u;
#pragma unroll
        for (unsigned j = 0; j < 16; ++j) { const unsigned c = xb_ld(&bar[XB_XCNT(j)]); sum += c; cnt += (c > 0u) ? 1u : 0u; mine = (j == x) ? c : mine; }
        if (sum == G) break;
        __builtin_amdgcn_s_sleep(1);
        if ((++sp & 255u) == 0u) { if (xb_ld(&bar[XB_TMO])) break; if (sp > XB_SPIN_CAP) { atomicAdd(&bar[XB_TMO], 1u); break; } }
    }
    nloc = mine > 0u ? mine : 1u; nx = cnt > 0u ? cnt : 1u;
}
__device__ __forceinline__ void xcd_barrier(const XcdBarrier& b) {
    asm volatile("s_waitcnt vmcnt(0)" ::: "memory");
    __syncthreads();
    if (threadIdx.x == 0) {
        unsigned* bar = b.bar;
        __builtin_amdgcn_s_waitcnt(0);
        unsigned nloc = b.st[0], nx = b.st[1];
        if (nloc == 0u) { xcd_barrier_complete(bar, b.x, nloc, nx); b.st[0] = nloc; b.st[1] = nx; }
        const unsigned old = xb_add(&bar[XB_XSUB(b.x)], 1u);
        const unsigned gen = old / nloc;
        if (old + 1u == (gen + 1u) * nloc) {
            __builtin_amdgcn_fence(__ATOMIC_RELEASE, "agent");
            asm volatile("s_waitcnt vmcnt(0)" ::: "memory");
            const unsigned og = xb_add(&bar[XB_TOP], 1u);
            const unsigned tg = og / nx;
            if (og + 1u == (tg + 1u) * nx) xb_add(&bar[XB_TOPGEN], 1u);
            else XB_SPIN(xb_ld(&bar[XB_TOPGEN]) == tg, bar);
            __builtin_amdgcn_fence(__ATOMIC_ACQUIRE, "agent");
            xb_add(&bar[XB_XGEN(b.x)], 1u);
            asm volatile("s_waitcnt vmcnt(0)" ::: "memory");
        } else {
            XB_SPIN(xb_ld(&bar[XB_XGEN(b.x)]) == gen, bar);
            __builtin_amdgcn_fence(__ATOMIC_ACQUIRE, "agent");
            asm volatile("s_waitcnt vmcnt(0)" ::: "memory");
        }
    }
    __syncthreads();
}

namespace pg8 {
constexpr int BM = 256, BK = 64, HALF = 128, HTB = HALF * BK * 2, STAGE_BYTES = 8 * HTB, NXCD = 8, WGM = 8;
__host__ __device__ __forceinline__ int lds_byte(int r, int c) { const int st = (r >> 4) * 2 + (c >> 5), rr = r & 15, cc = c & 31, ob = rr * 64 + cc * 2; return st * 1024 + (ob ^ (((ob >> 9) & 1) << 5)); }
__host__ __device__ __forceinline__ void stage_rc(int b, int& R, int& C) { const int st = b / 1024, sb = b % 1024, swz = sb ^ (((sb >> 9) & 1) << 5); R = (st >> 1) * 16 + swz / 64; C = (st & 1) * 32 + (swz % 64) / 2; }
__host__ __device__ __forceinline__ int perm32(int rho) { const int n = rho >> 4, i = rho & 15; return 8 * (i >> 2) + 4 * n + (i & 3); }

struct Unit { int pm, pn, e, row0; };

struct DenseOrder {
    int nM, nN, nwg, G, c; const char* A; const char* Bt; size_t tstep;
    __device__ void init(const void* A_, const void* Bt_, int M, int N, int K, int G_, int c_) { A = (const char*)A_; Bt = (const char*)Bt_; nM = M / BM; nN = N / BM; nwg = nM * nN; G = G_; c = c_; tstep = (size_t)BM * K * 2; }
    __device__ __forceinline__ bool next(int i, Unit& u) const {
        const long L = (long)i * G + c; if (L >= nwg) return false;
        int wgid = (int)L; { const int q = nwg / NXCD, r = nwg % NXCD, xcd = wgid % NXCD, off = wgid / NXCD; wgid = (xcd < r ? xcd * (q + 1) : r * (q + 1) + (xcd - r) * q) + off; }
        const int nig = WGM * nN, gid = wgid / nig, fm = gid * WGM, gsz = (nM - fm) < WGM ? (nM - fm) : WGM;
        u.pm = fm + ((wgid % nig) % gsz); u.pn = (wgid % nig) / gsz; u.e = 0; u.row0 = u.pm * BM; return true;
    }
    __device__ __forceinline__ const char* a_base(const Unit& u) const { return A + (size_t)u.pm * tstep; }
    __device__ __forceinline__ const char* b_base(const Unit& u) const { return Bt + (size_t)u.pn * tstep; }
    __device__ __forceinline__ int gather_row(const Unit&, int) const { return 0; }
};

template <class Epi, class Sched, bool GATHER>
__device__ __forceinline__ void gemm_phase(LAS unsigned char* lds, const int K, const Sched& S, const Epi& E) {
    const int tid = threadIdx.x, wid = __builtin_amdgcn_readfirstlane(tid >> 6), lane = tid & 63, wr = wid >> 2, wc = wid & 3, fr = lane & 15, fq = lane >> 4;
    const int nt = K / BK;
    int Rst[2], Cst[2];
    unsigned voffA[2], voffB[2];
#pragma unroll
    for (int i = 0; i < 2; ++i) { int R, C; stage_rc(tid * 16 + i * 8192, R, C); const int Rb = Epi::PERM ? ((R & ~31) + perm32(R & 31)) : R;
        Rst[i] = R; Cst[i] = C; voffA[i] = (unsigned)(R * K + C) * 2u; voffB[i] = (unsigned)(Rb * K + C) * 2u; }
    const size_t kstep = (size_t)(BK * 2);
    const size_t hstep = (size_t)HALF * K * 2;
    const unsigned ldsw = (unsigned)wid * 1024u;
    const int aoff = lds_byte(wr * 64 + fr, fq * 8), boff = lds_byte(wc * 32 + fr, fq * 8);
#define PG8_SA(b, h) (((b) * 2 + (h)) * HTB)
#define PG8_SB(b, h) ((4 + (b) * 2 + (h)) * HTB)
#define PG8_STAGE(bufoff, gbase, voff) do { _Pragma("unroll") for (int _i = 0; _i < 2; ++_i) \
        __builtin_amdgcn_global_load_lds((const unsigned*)((const char*)(gbase) + (voff)[_i]), (LAS unsigned*)(lds + (bufoff) + ldsw + _i * 8192), 16, 0, 0); } while (0)
#define PG8_LDA(dst, b, h) do { _Pragma("unroll") for (int m = 0; m < 4; ++m) _Pragma("unroll") for (int k = 0; k < 2; ++k) dst[m][k] = *(const LAS bf16x8*)(lds + PG8_SA(b, h) + aoff + m * 2048 + k * 1024); } while (0)
#define PG8_LDB(dst, b, h) do { _Pragma("unroll") for (int n = 0; n < 2; ++n) _Pragma("unroll") for (int k = 0; k < 2; ++k) dst[n][k] = *(const LAS bf16x8*)(lds + PG8_SB(b, h) + boff + n * 2048 + k * 1024); } while (0)
#define PG8_MMA(ai, bj, At, Bt) do { __builtin_amdgcn_s_setprio(1); _Pragma("unroll") for (int m = 0; m < 4; ++m) _Pragma("unroll") for (int n = 0; n < 2; ++n) _Pragma("unroll") for (int k = 0; k < 2; ++k) \
        acc[ai][bj][m][n] = __builtin_amdgcn_mfma_f32_16x16x32_bf16(Bt[n][k], At[m][k], acc[ai][bj][m][n], 0, 0, 0); __builtin_amdgcn_s_setprio(0); } while (0)
#define PG8_WAIT_V(n) asm volatile("s_waitcnt vmcnt(" #n ")" ::: "memory")
#define PG8_WAIT_L(n) asm volatile("s_waitcnt lgkmcnt(" #n ")" ::: "memory")
#define PG8_BAR __builtin_amdgcn_s_barrier()
#define PG8_SCHED __builtin_amdgcn_sched_barrier(0)
    Unit cur, nxt; int ui = 0;
    if (!S.next(0, cur)) return;
    f32x4 acc[2][2][4][2];
#pragma unroll
    for (int a = 0; a < 2; ++a)
#pragma unroll
        for (int b = 0; b < 2; ++b)
#pragma unroll
            for (int m = 0; m < 4; ++m)
#pragma unroll
                for (int n = 0; n < 2; ++n) acc[a][b][m][n] = (f32x4){0.f, 0.f, 0.f, 0.f};
    bf16x8 At[4][2], B0[2][2], B1[2][2];
    const char* cA = S.a_base(cur); const char* cB = S.b_base(cur);
    unsigned vc0[2], vc1[2], vn0[2], vn1[2];
    if constexpr (GATHER) {
#pragma unroll
        for (int i = 0; i < 2; ++i) { vc0[i] = ((unsigned)S.gather_row(cur, Rst[i]) * (unsigned)K + (unsigned)Cst[i]) * 2u; vc1[i] = ((unsigned)S.gather_row(cur, HALF + Rst[i]) * (unsigned)K + (unsigned)Cst[i]) * 2u; vn0[i] = vc0[i]; vn1[i] = vc1[i]; }
    } else {
#pragma unroll
        for (int i = 0; i < 2; ++i) { vc0[i] = voffA[i]; vc1[i] = voffA[i] + (unsigned)hstep; vn0[i] = vc0[i]; vn1[i] = vc1[i]; }
    }
    PG8_STAGE(PG8_SB(0, 0), cB, voffB); PG8_STAGE(PG8_SA(0, 0), cA, vc0); PG8_STAGE(PG8_SB(0, 1), cB + hstep, voffB); PG8_STAGE(PG8_SA(0, 1), cA, vc1);
    if (wr == 1) PG8_BAR;
    PG8_WAIT_V(4); PG8_BAR;
    PG8_STAGE(PG8_SB(1, 0), cB + kstep, voffB); PG8_STAGE(PG8_SA(1, 0), cA + kstep, vc0); PG8_STAGE(PG8_SB(1, 1), cB + hstep + kstep, voffB);
    PG8_WAIT_V(6); PG8_BAR;
    for (;;) {
        const bool has_next = S.next(ui + 1, nxt);
        const char* nA = has_next ? S.a_base(nxt) : cA; const char* nB = has_next ? S.b_base(nxt) : cB;
        for (int t = 0; t < nt; t += 2) {
            const bool last = (t == nt - 2);
            const char* a1 = cA + (size_t)(t + 1) * kstep;
            const char* a2 = last ? nA : cA + (size_t)(t + 2) * kstep; const char* b2 = last ? nB : cB + (size_t)(t + 2) * kstep;
            const char* a3 = a2 + kstep; const char* b3 = b2 + kstep;
            unsigned s0[2], s1[2];
            if constexpr (GATHER) {
                if (last && has_next) {
#pragma unroll
                    for (int i = 0; i < 2; ++i) { vn0[i] = ((unsigned)S.gather_row(nxt, Rst[i]) * (unsigned)K + (unsigned)Cst[i]) * 2u; vn1[i] = ((unsigned)S.gather_row(nxt, HALF + Rst[i]) * (unsigned)K + (unsigned)Cst[i]) * 2u; }
                }
#pragma unroll
                for (int i = 0; i < 2; ++i) { s0[i] = last ? vn0[i] : vc0[i]; s1[i] = last ? vn1[i] : vc1[i]; }
            } else {
#pragma unroll
                for (int i = 0; i < 2; ++i) { s0[i] = vc0[i]; s1[i] = vc1[i]; }
            }
            PG8_LDB(B0, 0, 0); PG8_SCHED; PG8_LDA(At, 0, 0); PG8_STAGE(PG8_SA(1, 1), a1, vc1);
            PG8_WAIT_L(8); PG8_BAR; PG8_WAIT_L(0); PG8_MMA(0, 0, At, B0); PG8_BAR; PG8_SCHED;
            PG8_LDB(B1, 0, 1); PG8_STAGE(PG8_SB(0, 0), b2, voffB);
            PG8_BAR; PG8_WAIT_L(0); PG8_MMA(0, 1, At, B1); PG8_BAR;
            PG8_LDA(At, 0, 1); PG8_STAGE(PG8_SA(0, 0), a2, s0);
            PG8_BAR; PG8_WAIT_L(0); PG8_MMA(1, 0, At, B0); PG8_BAR; PG8_SCHED;
            PG8_STAGE(PG8_SB(0, 1), b2 + hstep, voffB);
            PG8_WAIT_V(6); PG8_BAR; PG8_MMA(1, 1, At, B1); PG8_BAR;
            PG8_LDB(B0, 1, 0); PG8_SCHED; PG8_LDA(At, 1, 0); PG8_STAGE(PG8_SA(0, 1), a2, s1);
            PG8_WAIT_L(8); PG8_BAR; PG8_WAIT_L(0); PG8_MMA(0, 0, At, B0); PG8_BAR; PG8_SCHED;
            PG8_LDB(B1, 1, 1); PG8_STAGE(PG8_SB(1, 0), b3, voffB);
            PG8_BAR; PG8_WAIT_L(0); PG8_MMA(0, 1, At, B1); PG8_BAR;
            PG8_LDA(At, 1, 1); PG8_STAGE(PG8_SA(1, 0), a3, s0);
            PG8_BAR; PG8_WAIT_L(0); PG8_MMA(1, 0, At, B0); PG8_BAR; PG8_SCHED;
            PG8_STAGE(PG8_SB(1, 1), b3 + hstep, voffB);
            PG8_WAIT_V(6); PG8_BAR; PG8_MMA(1, 1, At, B1); PG8_BAR;
        }
        E(acc, cur, wr, wc, fr, fq);
        if (!has_next) break;
#pragma unroll
        for (int a = 0; a < 2; ++a)
#pragma unroll
            for (int b = 0; b < 2; ++b)
#pragma unroll
                for (int m = 0; m < 4; ++m)
#pragma unroll
                    for (int n = 0; n < 2; ++n) acc[a][b][m][n] = (f32x4){0.f, 0.f, 0.f, 0.f};
        cur = nxt; cA = nA; cB = nB; ++ui;
#pragma unroll
        for (int i = 0; i < 2; ++i) { vc0[i] = vn0[i]; vc1[i] = vn1[i]; }
    }
    PG8_WAIT_V(0);
    if (wr == 0) PG8_BAR;
    PG8_BAR;
#undef PG8_SA
#undef PG8_SB
#undef PG8_STAGE
#undef PG8_LDA
#undef PG8_LDB
#undef PG8_MMA
#undef PG8_WAIT_V
#undef PG8_WAIT_L
#undef PG8_BAR
#undef PG8_SCHED
}
}
using pg8::Unit;

enum { IN_X = 0, IN_C, IN_CTX, IN_CCTX, IN_ADAW, IN_ADAB, IN_NMIXW, IN_NFFNW, IN_CONVIN, IN_CONVDW, IN_CONVOUT, IN_MLIN, IN_MLGB, IN_MLNW, IN_MLOUT,
       IN_RW, IN_RB, IN_EG, IN_EU, IN_ED, IN_SG, IN_SU, IN_SD, IN_FNW, N_IN };
struct Args { const float* in[N_IN]; float* out; unsigned char* ws; int ph_lo, ph_hi, li, pad; };

struct Frame {
    LAS unsigned char* lds;
    int tid, lane, wave, bid;
    const Args* a; float* out; unsigned char* ws;
};

__device__ __forceinline__ const float* mod_ptr(const Frame& F, int layer, int mr, int chunk) { return (const float*)(F.ws + WS_MOD) + ((size_t)(layer * 9 + mr) * ADA_N + (size_t)chunk * D); }
__device__ __forceinline__ int mod_row(int r) { return r < NCTX ? 8 : ((r - NCTX) >> 11); }

struct EpiConvIn {
    static constexpr bool PERM = true;
    bf16_t* U; bf16_t* BMt;
    __device__ __forceinline__ void operator()(const f32x4 (&acc)[2][2][4][2], const Unit& u, int wr, int wc, int fr, int fq) const {
        const int row0 = u.pm * 256 + wr * 64 + fr;
        if (u.pn < 16) {
            const int col = u.pn * 128 + wc * 32 + 8 * fq;
#pragma unroll
            for (int ai = 0; ai < 2; ++ai)
#pragma unroll
                for (int m = 0; m < 4; ++m) {
                    const f32x4 a0 = acc[ai][0][m][0] * acc[ai][1][m][0], a1 = acc[ai][0][m][1] * acc[ai][1][m][1];
                    u32x4 w; w.x = cvt_pk_bf16(a0[0], a0[1]); w.y = cvt_pk_bf16(a0[2], a0[3]); w.z = cvt_pk_bf16(a1[0], a1[1]); w.w = cvt_pk_bf16(a1[2], a1[3]);
                    *(u32x4*)(U + (size_t)(row0 + ai * 128 + m * 16) * D + col) = w; }
        } else {
            const int col = (u.pn - 16) * 256 + wc * 32 + 8 * fq;
#pragma unroll
            for (int ai = 0; ai < 2; ++ai)
#pragma unroll
                for (int m = 0; m < 4; ++m)
#pragma unroll
                    for (int bj = 0; bj < 2; ++bj) {
                        const f32x4 a0 = acc[ai][bj][m][0], a1 = acc[ai][bj][m][1];
                        u32x4 w; w.x = cvt_pk_bf16(a0[0], a0[1]); w.y = cvt_pk_bf16(a0[2], a0[3]); w.z = cvt_pk_bf16(a1[0], a1[1]); w.w = cvt_pk_bf16(a1[2], a1[3]);
                        *(u32x4*)(BMt + (size_t)(row0 + ai * 128 + m * 16) * D + col + bj * 128) = w; }
        }
    }
};
struct EpiResid {
    static constexpr bool PERM = false;
    const float* base_ctx; const float* base_lat; float* X; const float* gmod; int row_off;
    __device__ __forceinline__ void operator()(const f32x4 (&acc)[2][2][4][2], const Unit& u, int wr, int wc, int fr, int fq) const {
        const int R0 = row_off + u.pm * 256;
        const float* base = (R0 < NCTX) ? base_ctx + (size_t)R0 * D : base_lat + (size_t)(R0 - NCTX) * D;
        const float* g = gmod + (size_t)mod_row(R0) * ADA_N;
        float* o = X + (size_t)R0 * D;
        const int rl0 = wr * 64 + fr, col0 = u.pn * 256 + wc * 32 + 4 * fq;
        f32x4 gv[2][2];
#pragma unroll
        for (int bj = 0; bj < 2; ++bj)
#pragma unroll
            for (int n = 0; n < 2; ++n) gv[bj][n] = *(const f32x4*)(g + col0 + bj * 128 + n * 16);
#pragma unroll
        for (int ai = 0; ai < 2; ++ai)
#pragma unroll
            for (int m = 0; m < 4; ++m) { const size_t ro = (size_t)(rl0 + ai * 128 + m * 16) * D + col0;
#pragma unroll
                for (int bj = 0; bj < 2; ++bj)
#pragma unroll
                    for (int n = 0; n < 2; ++n) { const f32x4 bv = *(const f32x4*)(base + ro + bj * 128 + n * 16);
                        *(f32x4*)(o + ro + bj * 128 + n * 16) = bv + gv[bj][n] * acc[ai][bj][m][n]; } }
    }
};
__device__ __forceinline__ float softcap_gate(float g) {
    const float e = fast_exp(-2.0f * g * (1.0f / 15.0f)); return 15.0f * (1.0f - e) / (1.0f + e);
}
__device__ __forceinline__ float log_sigmoid_(float g) { return fminf(g, 0.0f) - __logf(1.0f + fast_exp(-fabsf(g))); }
struct EpiMlstmIn {
    static constexpr bool PERM = true;
    bf16_t *Q, *Kb, *V, *O; float* G; const float* gate_b;
    __device__ __forceinline__ void operator()(const f32x4 (&acc)[2][2][4][2], const Unit& u, int wr, int wc, int fr, int fq) const {
        const int row0 = u.pm * 256 + wr * 64 + fr;
        if (u.pn < 24) {
            bf16_t* dst; int ld, ct; float sc = 1.0f;
            if (u.pn < 4) { dst = Q; ld = 1024; ct = u.pn; } else if (u.pn < 8) { dst = Kb; ld = 1024; ct = u.pn - 4; sc = 0.08838834764831845f; }
            else if (u.pn < 16) { dst = V; ld = 2048; ct = u.pn - 8; } else { dst = O; ld = 2048; ct = u.pn - 16; }
            const int col = ct * 256 + wc * 32 + 8 * fq;
#pragma unroll
            for (int ai = 0; ai < 2; ++ai)
#pragma unroll
                for (int m = 0; m < 4; ++m)
#pragma unroll
                    for (int bj = 0; bj < 2; ++bj) {
                        const f32x4 a0 = acc[ai][bj][m][0] * sc, a1 = acc[ai][bj][m][1] * sc;
                        u32x4 w; w.x = cvt_pk_bf16(a0[0], a0[1]); w.y = cvt_pk_bf16(a0[2], a0[3]); w.z = cvt_pk_bf16(a1[0], a1[1]); w.w = cvt_pk_bf16(a1[2], a1[3]);
                        *(u32x4*)(dst + (size_t)(row0 + ai * 128 + m * 16) * ld + col + bj * 128) = w; }
        } else if (wc == 0) {
            const f32x4 b0 = *(const f32x4*)(gate_b + 8 * fq), b1 = *(const f32x4*)(gate_b + 8 * fq + 4);
#pragma unroll
            for (int ai = 0; ai < 2; ++ai)
#pragma unroll
                for (int m = 0; m < 4; ++m) {
                    f32x4 g0 = acc[ai][0][m][0] + b0, g1 = acc[ai][0][m][1] + b1;
#pragma unroll
                    for (int j = 0; j < 4; ++j) { g0[j] = softcap_gate(g0[j]); g1[j] = softcap_gate(g1[j]); if (fq & 1) { g0[j] = log_sigmoid_(g0[j]); g1[j] = log_sigmoid_(g1[j]); } }
                    float* gp = G + (size_t)(row0 + ai * 128 + m * 16) * 32 + 8 * fq;
                    *(f32x4*)gp = g0; *(f32x4*)(gp + 4) = g1; }
        }
    }
};
struct EpiSwiglu {
    static constexpr bool PERM = true;
    bf16_t* ACT;
    __device__ __forceinline__ void operator()(const f32x4 (&acc)[2][2][4][2], const Unit& u, int wr, int wc, int fr, int fq) const {
        const int row0 = u.row0 + wr * 64 + fr, col = u.pn * 128 + wc * 32 + 8 * fq;
#pragma unroll
        for (int ai = 0; ai < 2; ++ai)
#pragma unroll
            for (int m = 0; m < 4; ++m) {
                f32x4 a0, a1;
#pragma unroll
                for (int j = 0; j < 4; ++j) { a0[j] = siluf_(acc[ai][0][m][0][j]) * acc[ai][1][m][0][j]; a1[j] = siluf_(acc[ai][0][m][1][j]) * acc[ai][1][m][1][j]; }
                u32x4 w; w.x = cvt_pk_bf16(a0[0], a0[1]); w.y = cvt_pk_bf16(a0[2], a0[3]); w.z = cvt_pk_bf16(a1[0], a1[1]); w.w = cvt_pk_bf16(a1[2], a1[3]);
                *(u32x4*)(ACT + (size_t)(row0 + ai * 128 + m * 16) * ED + col) = w; }
    }
};
struct EpiDown {
    static constexpr bool PERM = true;
    bf16_t* Y; const float* gate_of;
    __device__ __forceinline__ void operator()(const f32x4 (&acc)[2][2][4][2], const Unit& u, int wr, int wc, int fr, int fq) const {
        const int row0 = u.row0 + wr * 64 + fr, col = u.pn * 256 + wc * 32 + 8 * fq;
#pragma unroll
        for (int ai = 0; ai < 2; ++ai)
#pragma unroll
            for (int m = 0; m < 4; ++m) { const int slot = row0 + ai * 128 + m * 16; const float gt = gate_of[slot];
#pragma unroll
                for (int bj = 0; bj < 2; ++bj) {
                    const f32x4 a0 = acc[ai][bj][m][0] * gt, a1 = acc[ai][bj][m][1] * gt;
                    u32x4 w; w.x = cvt_pk_bf16(a0[0], a0[1]); w.y = cvt_pk_bf16(a0[2], a0[3]); w.z = cvt_pk_bf16(a1[0], a1[1]); w.w = cvt_pk_bf16(a1[2], a1[3]);
                    *(u32x4*)(Y + (size_t)slot * D + col + bj * 128) = w; } }
    }
};

struct ExpertOrder {
    const int* einfo; int npn, shpc, c; const char* A; const char* Bt; const int* tok_of; int K, erows;
    __device__ __forceinline__ bool next(int i, Unit& u) const {
        const int x = c & 7; int q = i * 32 + (c >> 3);
#pragma unroll 1
        for (int kk = 0; kk < 8; ++kk) { const int e = x + 8 * kk; const int n = einfo[256 + e] * npn;
            if (q < n) { u.e = e; u.pm = q / npn; u.pn = q % npn; u.row0 = einfo[128 + e] + 256 * u.pm; return true; } q -= n; }
        if (q < shpc * npn) { u.e = 64; u.pm = x * shpc + q / npn; u.pn = q % npn; u.row0 = SH_BASE + 256 * u.pm; return true; }
        return false;
    }
    __device__ __forceinline__ const char* a_base(const Unit& u) const { return tok_of ? A : A + (size_t)u.row0 * K * 2; }
    __device__ __forceinline__ const char* b_base(const Unit& u) const { return Bt + ((size_t)u.e * erows + (size_t)u.pn * 256) * K * 2; }
    __device__ __forceinline__ int gather_row(const Unit& u, int r) const { return tok_of[u.row0 + r]; }
};

__device__ __forceinline__ void tr_item(const float* __restrict__ W, int ldw, int K, bf16_t* WT, int drow, int k0, int n0src, LAS float* scr, int lane) {
#pragma unroll 8
    for (int i = 0; i < 32; ++i) { const int kk = 2 * i + (lane >> 5); scr[kk * 33 + (lane & 31)] = W[(size_t)(k0 + kk) * ldw + n0src + (lane & 31)]; }
    LDS_WAIT(); asm volatile("" ::: "memory");
    const int c = lane & 7;
#pragma unroll
    for (int j = 0; j < 4; ++j) { const int n = (lane >> 3) + 8 * j; const LAS float* s = scr + (8 * c) * 33 + n;
        u32x4 o; o.x = cvt_pk_bf16(s[0 * 33], s[1 * 33]); o.y = cvt_pk_bf16(s[2 * 33], s[3 * 33]); o.z = cvt_pk_bf16(s[4 * 33], s[5 * 33]); o.w = cvt_pk_bf16(s[6 * 33], s[7 * 33]);
        *(u32x4*)(WT + (size_t)(drow + n) * K + k0 + 8 * c) = o; }
    LDS_WAIT(); asm volatile("" ::: "memory");
}
__device__ __forceinline__ void tr_job(int r, const float* src, int ldw, int col0, int K, int N, size_t sbatch, bf16_t* dst, size_t dbatch, int row_off, int seg, int segs, LAS float* scr, int lane) {
    const int nblk = N >> 5, ipb = (K >> 6) * nblk;
    const int bt = r / ipb, rr = r - bt * ipb, kb = rr / nblk, nb = rr - kb * nblk, n0 = nb << 5;
    tr_item(src + (size_t)bt * sbatch, ldw, K, dst + (size_t)bt * dbatch, row_off + (n0 / seg) * segs + (n0 % seg), kb << 6, col0 + n0, scr, lane);
}
__device__ __forceinline__ void phase_prologue(Frame& F) {
    if (F.bid < 192) {
        LAS float* cond = (LAS float*)F.lds;
        LAS float* red = (LAS float*)(F.lds + 9 * 2048 * 4);
        for (int i = F.tid; i < 9 * 2048; i += NTHR) { const int r = i >> 11, k = i & 2047; const float v = (r < 8) ? F.a->in[IN_C][r * D + k] : F.a->in[IN_CCTX][k]; cond[i] = siluf_(v); }
        __syncthreads();
        const int l = F.bid / 96, col0 = (F.bid % 96) * 128, cg = F.tid & 31, kl = F.tid >> 5;
        const float* W = F.a->in[IN_ADAW] + (size_t)l * D * ADA_N + col0 + 4 * cg;
        f32x4 acc[9];
#pragma unroll
        for (int r = 0; r < 9; ++r) acc[r] = (f32x4){0.f, 0.f, 0.f, 0.f};
#pragma unroll 4
        for (int k = kl; k < D; k += 16) { const f32x4 w4 = *(const f32x4*)(W + (size_t)k * ADA_N);
#pragma unroll
            for (int r = 0; r < 9; ++r) acc[r] += cond[r * 2048 + k] * w4; }
#pragma unroll
        for (int r = 0; r < 9; ++r) *(LAS f32x4*)(red + (kl * 9 + r) * 128 + 4 * cg) = acc[r];
        __syncthreads();
        float* mod = (float*)(F.ws + WS_MOD);
        for (int o = F.tid; o < 9 * 128; o += NTHR) { const int r = o >> 7, c = o & 127; float s = 0.f;
#pragma unroll
            for (int q = 0; q < 16; ++q) s += red[(q * 9 + r) * 128 + c];
            mod[(size_t)(l * 9 + r) * ADA_N + col0 + c] = s + F.a->in[IN_ADAB][l * ADA_N + col0 + c]; }
        __syncthreads();
    }
    LAS float* scr = (LAS float*)(F.lds + F.wave * 8704);
    const int gw = F.bid * NWAVES + F.wave, NGW = GRID * NWAVES;
    bf16_t* convin_t = (bf16_t*)(F.ws + WS_CONVIN_T); bf16_t* convout_t = (bf16_t*)(F.ws + WS_CONVOUT_T);
    bf16_t* mlin_t = (bf16_t*)(F.ws + WS_MLIN_T); bf16_t* mlout_t = (bf16_t*)(F.ws + WS_MLOUT_T);
    constexpr int I_SQ = 32 * 64, I_MLIN = 32 * 193, I_RT = 32 * 2, I_EGU = 64 * 32 * 16, I_EDN = 64 * 8 * 64, I_SGU = 32 * 16, I_SDN = 8 * 64;
    constexpr int I_MOE = I_RT + 2 * I_EGU + I_EDN + 2 * I_SGU + I_SDN;
    constexpr int NITEMS = 4 * I_SQ + I_MLIN + I_SQ + 2 * I_MOE;
    for (int it = gw; it < NITEMS; it += NGW) {
        int r = it;
        if (r < I_SQ) { tr_job(r, F.a->in[IN_CONVIN], 3 * D, 2048, D, D, 0, convin_t, 0, 0, 128, 256, scr, F.lane); continue; } r -= I_SQ;
        if (r < I_SQ) { tr_job(r, F.a->in[IN_CONVIN], 3 * D, 4096, D, D, 0, convin_t, 0, 128, 128, 256, scr, F.lane); continue; } r -= I_SQ;
        if (r < I_SQ) { tr_job(r, F.a->in[IN_CONVIN], 3 * D, 0, D, D, 0, convin_t, 0, 4096, D, 0, scr, F.lane); continue; } r -= I_SQ;
        if (r < I_SQ) { tr_job(r, F.a->in[IN_CONVOUT], D, 0, D, D, 0, convout_t, 0, 0, D, 0, scr, F.lane); continue; } r -= I_SQ;
        if (r < I_MLIN) { tr_job(r, F.a->in[IN_MLIN], MLSTM_N, 0, D, MLSTM_N, 0, mlin_t, 0, 0, 8192, 0, scr, F.lane); continue; } r -= I_MLIN;
        if (r < I_SQ) { tr_job(r, F.a->in[IN_MLOUT], D, 0, D, D, 0, mlout_t, 0, 0, D, 0, scr, F.lane); continue; } r -= I_SQ;
        const int l = r / I_MOE; r -= l * I_MOE;
        unsigned char* moe = F.ws + WS_MOE0 + (size_t)l * MOE_STRIDE;
        bf16_t* gu_t = (bf16_t*)(moe + MOE_GU); bf16_t* dn_t = (bf16_t*)(moe + MOE_DN); bf16_t* rt_t = (bf16_t*)(moe + MOE_RT);
        if (r < I_RT) { tr_job(r, F.a->in[IN_RW] + (size_t)l * D * NE, NE, 0, D, NE, 0, rt_t, 0, 0, NE, 0, scr, F.lane); continue; } r -= I_RT;
        if (r < I_EGU) { tr_job(r, F.a->in[IN_EG] + (size_t)l * NE * D * ED, ED, 0, D, ED, (size_t)D * ED, gu_t, (size_t)1024 * D, 0, 128, 256, scr, F.lane); continue; } r -= I_EGU;
        if (r < I_EGU) { tr_job(r, F.a->in[IN_EU] + (size_t)l * NE * D * ED, ED, 0, D, ED, (size_t)D * ED, gu_t, (size_t)1024 * D, 128, 128, 256, scr, F.lane); continue; } r -= I_EGU;
        if (r < I_EDN) { tr_job(r, F.a->in[IN_ED] + (size_t)l * NE * ED * D, D, 0, ED, D, (size_t)ED * D, dn_t, (size_t)D * ED, 0, D, 0, scr, F.lane); continue; } r -= I_EDN;
        if (r < I_SGU) { tr_job(r, F.a->in[IN_SG] + (size_t)l * D * ED, ED, 0, D, ED, 0, gu_t + (size_t)64 * 1024 * D, 0, 0, 128, 256, scr, F.lane); continue; } r -= I_SGU;
        if (r < I_SGU) { tr_job(r, F.a->in[IN_SU] + (size_t)l * D * ED, ED, 0, D, ED, 0, gu_t + (size_t)64 * 1024 * D, 0, 128, 128, 256, scr, F.lane); continue; } r -= I_SGU;
        tr_job(r, F.a->in[IN_SD] + (size_t)l * ED * D, D, 0, ED, D, 0, dn_t + (size_t)64 * D * ED, 0, 0, D, 0, scr, F.lane);
    }
    { u32x4* z = (u32x4*)(mlin_t + (size_t)MLSTM_N * D); const int n16 = (MLSTM_NP - MLSTM_N) * D * 2 / 16;
      for (int i = F.bid * NTHR + F.tid; i < n16; i += GRID * NTHR) z[i] = (u32x4){0u, 0u, 0u, 0u}; }
}

template <bool TO_LDS>
__device__ __forceinline__ void norm_mod_store(const f32x4 (&v)[8], float rstd, const float* w, const float* shift, const float* scale, bf16_t* orow, LAS bf16_t* lrow, int lane) {
#pragma unroll
    for (int j = 0; j < 8; ++j) { const int c = 4 * lane + 256 * j;
        const f32x4 w4 = *(const f32x4*)(w + c), sc = *(const f32x4*)(scale + c), sh = *(const f32x4*)(shift + c);
        const f32x4 y = (v[j] * rstd) * w4 * (sc + 1.0f) + sh;
        u32x2 o; o.x = cvt_pk_bf16(y[0], y[1]); o.y = cvt_pk_bf16(y[2], y[3]);
        *(u32x2*)(orow + c) = o;
        if (TO_LDS) *(LAS u32x2*)(lrow + c) = o; }
}
__device__ __forceinline__ float row_ssq(const f32x4 (&v)[8]) {
    float s = 0.f;
#pragma unroll
    for (int j = 0; j < 8; ++j) s += (v[j][0] * v[j][0] + v[j][1] * v[j][1]) + (v[j][2] * v[j][2] + v[j][3] * v[j][3]);
    return wave_sum(s);
}

__device__ __forceinline__ void phase_norm0(Frame& F) {
    bf16_t* H = (bf16_t*)(F.ws + WS_H);
    const int gw = F.bid * NWAVES + F.wave, NGW = GRID * NWAVES;
    for (int r = gw; r < NTOK; r += NGW) {
        const float* xr = (r < NCTX) ? F.a->in[IN_CTX] + (size_t)r * D : F.a->in[IN_X] + (size_t)(r - NCTX) * D;
        f32x4 v[8];
#pragma unroll
        for (int j = 0; j < 8; ++j) v[j] = *(const f32x4*)(xr + 4 * F.lane + 256 * j);
        const float rstd = rsqrtf(row_ssq(v) * (1.0f / D) + EPS);
        const int mr = mod_row(r);
        norm_mod_store<false>(v, rstd, F.a->in[IN_NMIXW], mod_ptr(F, 0, mr, 0), mod_ptr(F, 0, mr, 1), H + (size_t)r * D, (LAS bf16_t*)F.lds, F.lane);
    }
}

__device__ __forceinline__ void phase_conv(Frame& F) {
    const bf16_t* U = (const bf16_t*)(F.ws + WS_U); const bf16_t* BMt = (const bf16_t*)(F.ws + WS_BM); bf16_t* Z = (bf16_t*)(F.ws + WS_Z);
    const float* dw = F.a->in[IN_CONVDW];
    const int total = NTOK * (D / 8);
    for (int i = F.bid * NTHR + F.tid; i < total; i += GRID * NTHR) {
        const int r = i >> 8, c = (i & 255) * 8;
        const int pos = (r < NCTX) ? (r & 255) : (r & 63), seglen = (r < NCTX) ? 256 : 64;
        const u32x4 z4 = (u32x4){0u, 0u, 0u, 0u};
        const u32x4 um = (pos > 0) ? *(const u32x4*)(U + (size_t)(r - 1) * D + c) : z4;
        const u32x4 u0 = *(const u32x4*)(U + (size_t)r * D + c);
        const u32x4 up = (pos < seglen - 1) ? *(const u32x4*)(U + (size_t)(r + 1) * D + c) : z4;
        const u32x4 bb = *(const u32x4*)(BMt + (size_t)r * D + c);
        float w0[8], w1[8], w2[8];
#pragma unroll
        for (int q = 0; q < 2; ++q) { const f32x4 a = *(const f32x4*)(dw + c + 4 * q), b = *(const f32x4*)(dw + D + c + 4 * q), d = *(const f32x4*)(dw + 2 * D + c + 4 * q);
#pragma unroll
            for (int j = 0; j < 4; ++j) { w0[4 * q + j] = a[j]; w1[4 * q + j] = b[j]; w2[4 * q + j] = d[j]; } }
        u32x4 o;
#pragma unroll
        for (int q = 0; q < 4; ++q) {
            const float y0 = bf_lo(bb[q]) * (w0[2 * q] * bf_lo(um[q]) + w1[2 * q] * bf_lo(u0[q]) + w2[2 * q] * bf_lo(up[q]));
            const float y1 = bf_hi(bb[q]) * (w0[2 * q + 1] * bf_hi(um[q]) + w1[2 * q + 1] * bf_hi(u0[q]) + w2[2 * q + 1] * bf_hi(up[q]));
            o[q] = cvt_pk_bf16(y0, y1); }
        *(u32x4*)(Z + (size_t)r * D + c) = o;
    }
}

constexpr int HS_PITCH = 2056;
constexpr int RL_HS = 0, RL_PART = 16 * HS_PITCH * 2, RL_LOGIT = RL_PART + 8 * 16 * 64 * 4, RL_IDX = RL_LOGIT + 16 * 64 * 4;
__device__ __forceinline__ void phase_router(Frame& F, int layer, int rowbase, int rpb) {
    const float* X = (const float*)(F.ws + WS_X); bf16_t* H = (bf16_t*)(F.ws + WS_H);
    const bf16_t* rt_t = (const bf16_t*)(F.ws + WS_MOE0 + (size_t)layer * MOE_STRIDE + MOE_RT);
    int* sel_idx = (int*)(F.ws + RT_SELIDX); float* sel_gate = (float*)(F.ws + RT_SELGATE); int* sel_rank = (int*)(F.ws + RT_SELRANK); int* hist = (int*)(F.ws + RT_HIST);
    LAS bf16_t* hs = (LAS bf16_t*)(F.lds + RL_HS); LAS float* part = (LAS float*)(F.lds + RL_PART); LAS float* logit = (LAS float*)(F.lds + RL_LOGIT); LAS int* bidx = (LAS int*)(F.lds + RL_IDX);
    const int r0 = rowbase + F.bid * rpb, ngroups = (rpb + 15) >> 4;
    const float* nw = F.a->in[IN_NFFNW] + layer * D; const float bias = F.a->in[IN_RB][layer * NE + F.lane];
    for (int g = 0; g < ngroups; ++g) {
#pragma unroll 1
        for (int q = 0; q < 2; ++q) { const int lr = 2 * F.wave + q, br = 16 * g + lr; LAS bf16_t* lrow = hs + lr * HS_PITCH;
            if (br < rpb) { const int r = r0 + br; const float* xr = X + (size_t)r * D; f32x4 v[8];
#pragma unroll
                for (int j = 0; j < 8; ++j) v[j] = *(const f32x4*)(xr + 4 * F.lane + 256 * j);
                const float rstd = rsqrtf(row_ssq(v) * (1.0f / D) + EPS); const int mr = mod_row(r);
                norm_mod_store<true>(v, rstd, nw, mod_ptr(F, layer, mr, 3), mod_ptr(F, layer, mr, 4), H + (size_t)r * D, lrow, F.lane);
            } else {
#pragma unroll
                for (int j = 0; j < 8; ++j) *(LAS u32x2*)(lrow + 4 * F.lane + 256 * j) = (u32x2){0u, 0u}; } }
        __syncthreads();
        { f32x4 acc[4];
#pragma unroll
          for (int nt = 0; nt < 4; ++nt) acc[nt] = (f32x4){0.f, 0.f, 0.f, 0.f};
          const int fr = F.lane & 15, fq = F.lane >> 4;
#pragma unroll 2
          for (int ks = 0; ks < 8; ++ks) { const int k0 = 256 * F.wave + 32 * ks + 8 * fq;
              const bf16x8 a = *(const LAS bf16x8*)(hs + fr * HS_PITCH + k0);
#pragma unroll
              for (int nt = 0; nt < 4; ++nt) { const bf16x8 b = *(const bf16x8*)(rt_t + (size_t)(16 * nt + fr) * D + k0);
                  acc[nt] = __builtin_amdgcn_mfma_f32_16x16x32_bf16(a, b, acc[nt], 0, 0, 0); } }
#pragma unroll
          for (int nt = 0; nt < 4; ++nt)
#pragma unroll
              for (int j = 0; j < 4; ++j) part[F.wave * 1024 + (4 * fq + j) * 64 + 16 * nt + fr] = acc[nt][j]; }
        __syncthreads();
#pragma unroll
        for (int q = 0; q < 2; ++q) { const int o = F.tid + 512 * q; float s = 0.f;
#pragma unroll
            for (int w = 0; w < 8; ++w) s += part[w * 1024 + o];
            logit[o] = s; }
        __syncthreads();
#pragma unroll 1
        for (int q = 0; q < 2; ++q) { const int lr = 2 * F.wave + q, br = 16 * g + lr;
            if (br < rpb) { const int r = r0 + br;
                const float sc = sigmoidf_(logit[lr * 64 + F.lane]); float v = sc + bias;
                int myidx = 0; float mysc = 0.f;
#pragma unroll 1
                for (int k = 0; k < TOPK; ++k) { float bv = v; int bi = F.lane;
#pragma unroll
                    for (int o = 1; o < 64; o <<= 1) { const float ov = __shfl_xor(bv, o); const int oi = __shfl_xor(bi, o); if (ov > bv || (ov == bv && oi < bi)) { bv = ov; bi = oi; } }
                    const float ws = __shfl(sc, bi);
                    if (F.lane == k) { myidx = bi; mysc = ws; }
                    if (F.lane == bi) v = -3.0e38f; }
                const float ssum = wave_sum(F.lane < TOPK ? mysc : 0.f);
                if (F.lane < TOPK) { sel_idx[(size_t)r * TOPK + F.lane] = myidx; sel_gate[(size_t)r * TOPK + F.lane] = mysc / ssum * 2.5f; bidx[br * TOPK + F.lane] = myidx; } } }
    }
    __syncthreads();
    if (F.wave == 0) { int cnt = 0;
        for (int rr = 0; rr < rpb; ++rr) {
#pragma unroll
            for (int k = 0; k < TOPK; ++k) { const int id = bidx[rr * TOPK + k]; if (id == F.lane) { sel_rank[(size_t)(r0 + rr) * TOPK + k] = cnt; ++cnt; } } }
        hist[F.bid * NE + F.lane] = cnt; }
    __syncthreads();
}

__device__ __forceinline__ void phase_scatter(Frame& F, int rowbase, int rpb, int ntok) {
    const int* hist = (const int*)(F.ws + RT_HIST); int* einfo = (int*)(F.ws + RT_EINFO);
    const int* sel_idx = (const int*)(F.ws + RT_SELIDX); const float* sel_gate = (const float*)(F.ws + RT_SELGATE); const int* sel_rank = (const int*)(F.ws + RT_SELRANK);
    int* slot_of = (int*)(F.ws + RT_SLOTOF); int* tok_of = (int*)(F.ws + RT_TOKOF); float* gate_of = (float*)(F.ws + RT_GATEOF);
    LAS int* tot8 = (LAS int*)F.lds; LAS int* pre8 = tot8 + 512; LAS int* tot = pre8 + 512; LAS int* boff = tot + 64; LAS int* pst = boff + 64;
    { const int e = F.tid & 63, p = F.tid >> 6; int s = 0, pre = 0;
      for (int b = 32 * p; b < 32 * p + 32; ++b) { const int h = hist[b * NE + e]; s += h; pre += (b < F.bid) ? h : 0; }
      tot8[p * 64 + e] = s; pre8[p * 64 + e] = pre; }
    __syncthreads();
    if (F.tid < 64) { int s = 0, pre = 0;
#pragma unroll
        for (int p = 0; p < 8; ++p) { s += tot8[p * 64 + F.tid]; pre += pre8[p * 64 + F.tid]; }
        tot[F.tid] = s; boff[F.tid] = pre; }
    __syncthreads();
    if (F.tid == 0) { int a = 0; for (int e = 0; e < NE; ++e) { pst[e] = a; a += (tot[e] + 255) & ~255; } }
    __syncthreads();
    const int r0 = rowbase + F.bid * rpb;
    for (int a = F.tid; a < rpb * TOPK; a += NTHR) { const size_t ga = (size_t)r0 * TOPK + a; const int e = sel_idx[ga];
        const int slot = pst[e] + boff[e] + sel_rank[ga];
        tok_of[slot] = r0 + a / TOPK; gate_of[slot] = sel_gate[ga]; slot_of[ga] = slot; }
    for (int rr = F.tid; rr < rpb; rr += NTHR) { const int s = SH_BASE + (r0 - rowbase) + rr; tok_of[s] = r0 + rr; gate_of[s] = 1.0f; }
    if (F.bid < NE) { const int e = F.bid, lo = pst[e] + tot[e], hi = pst[e] + ((tot[e] + 255) & ~255);
        for (int s = lo + F.tid; s < hi; s += NTHR) { tok_of[s] = rowbase; gate_of[s] = 0.0f; } }
    if (F.bid == 0) {
        if (F.tid < NE) { einfo[F.tid] = tot[F.tid]; einfo[128 + F.tid] = pst[F.tid]; einfo[256 + F.tid] = (tot[F.tid] + 255) >> 8; }
        if (F.tid == NE) { einfo[NE] = ntok; einfo[128 + NE] = SH_BASE; einfo[256 + NE] = ntok >> 8; } }
    __syncthreads();
}

template <int MODE>
__device__ __forceinline__ void phase_combine(Frame& F) {
    float* X = (float*)(F.ws + WS_X); bf16_t* H = (bf16_t*)(F.ws + WS_H); const bf16_t* Y = (const bf16_t*)(F.ws + WS_Y);
    const int* slot_of = (const int*)(F.ws + RT_SLOTOF);
    const int layer = MODE, rowbase = MODE ? NCTX : 0, nrows = MODE ? NLAT : NTOK;
    const int gw = F.bid * NWAVES + F.wave, NGW = GRID * NWAVES;
    for (int rr = gw; rr < nrows; rr += NGW) { const int r = rowbase + rr;
        int sl[7];
#pragma unroll
        for (int k = 0; k < TOPK; ++k) sl[k] = slot_of[(size_t)r * TOPK + k];
        sl[6] = SH_BASE + rr;
        const int mr = mod_row(r); const float* g2 = mod_ptr(F, layer, mr, 5);
        f32x4 v[8];
#pragma unroll
        for (int j = 0; j < 8; ++j) { const int c = 4 * F.lane + 256 * j; f32x4 m = (f32x4){0.f, 0.f, 0.f, 0.f};
#pragma unroll
            for (int k = 0; k < 7; ++k) { const u32x2 y = *(const u32x2*)(Y + (size_t)sl[k] * D + c); m[0] += bf_lo(y.x); m[1] += bf_hi(y.x); m[2] += bf_lo(y.y); m[3] += bf_hi(y.y); }
            v[j] = *(const f32x4*)(X + (size_t)r * D + c) + *(const f32x4*)(g2 + c) * m; }
        const float rstd = rsqrtf(row_ssq(v) * (1.0f / D) + EPS);
        if (MODE == 0) {
#pragma unroll
            for (int j = 0; j < 8; ++j) *(f32x4*)(X + (size_t)r * D + 4 * F.lane + 256 * j) = v[j];
            norm_mod_store<false>(v, rstd, F.a->in[IN_NMIXW] + D, mod_ptr(F, 1, mr, 0), mod_ptr(F, 1, mr, 1), H + (size_t)r * D, (LAS bf16_t*)F.lds, F.lane);
        } else {
#pragma unroll
            for (int j = 0; j < 8; ++j) { const int c = 4 * F.lane + 256 * j; *(f32x4*)(F.out + (size_t)rr * D + c) = (v[j] * rstd) * *(const f32x4*)(F.a->in[IN_FNW] + c); }
        }
    }
}

__device__ __forceinline__ void phase_headnorm(Frame& F) {
    const bf16_t* HF = (const bf16_t*)(F.ws + WS_HF); const bf16_t* HB = (const bf16_t*)(F.ws + WS_HB); const bf16_t* O = (const bf16_t*)(F.ws + WS_O); bf16_t* YIN = (bf16_t*)(F.ws + WS_YIN);
    const float* nw = F.a->in[IN_MLNW];
    const int gw = F.bid * NWAVES + F.wave, NGW = GRID * NWAVES;
    for (int rr = gw; rr < NLAT; rr += NGW) {
#pragma unroll 2
        for (int hd = 0; hd < 8; ++hd) { const int c = hd * 256 + 4 * F.lane;
            const u32x2 a = *(const u32x2*)(HF + (size_t)rr * D + c), b = *(const u32x2*)(HB + (size_t)rr * D + c), o = *(const u32x2*)(O + (size_t)(NCTX + rr) * D + c);
            const f32x4 w4 = *(const f32x4*)(nw + c);
            f32x4 h; h[0] = bf_lo(a.x) + bf_lo(b.x); h[1] = bf_hi(a.x) + bf_hi(b.x); h[2] = bf_lo(a.y) + bf_lo(b.y); h[3] = bf_hi(a.y) + bf_hi(b.y);
            const float ss = wave_sum((h[0] * h[0] + h[1] * h[1]) + (h[2] * h[2] + h[3] * h[3]));
            const float rstd = rsqrtf(ss * (1.0f / 256.0f) + EPS);
            const float y0 = h[0] * rstd * w4[0] * sigmoidf_(bf_lo(o.x)), y1 = h[1] * rstd * w4[1] * sigmoidf_(bf_hi(o.x));
            const float y2 = h[2] * rstd * w4[2] * sigmoidf_(bf_lo(o.y)), y3 = h[3] * rstd * w4[3] * sigmoidf_(bf_hi(o.y));
            u32x2 w; w.x = cvt_pk_bf16(y0, y1); w.y = cvt_pk_bf16(y2, y3);
            *(u32x2*)(YIN + (size_t)rr * D + c) = w; }
    }
}

constexpr int ML_Q = 0, ML_K = 16384, ML_V = 32768, ML_VW = 49152, ML_S = 65536, ML_CT = 74752, ML_F = 113920;
constexpr int ML_SP = 144, ML_CTP = 272;
__device__ __forceinline__ unsigned off_b(unsigned row, unsigned ch) { return 256u * row + 16u * (ch ^ (((row & 3u) << 2) | ((row >> 2) & 3u))); }
__device__ __forceinline__ unsigned rowrd16(unsigned lane, unsigned rb, unsigned s) { return off_b((lane & 15u) + 16u * rb, 4u * s + (lane >> 4)); }
__device__ __forceinline__ unsigned trrd16(unsigned lane, unsigned c, unsigned ks, unsigned t) {
    const unsigned g = lane >> 4, q = (lane & 15u) >> 2, p = lane & 3u;
    return off_b(32u * ks + 8u * g + 4u * t + q, 2u * c + (p >> 1)) + 8u * (p & 1u);
}
__device__ __forceinline__ bf16x8 tr_frag(LAS unsigned char* img, unsigned lane, unsigned c, unsigned ks) {
    const s16x4 lo = __builtin_amdgcn_ds_read_tr16_b64_v4i16((LAS s16x4*)(img + trrd16(lane, c, ks, 0)));
    const s16x4 hi = __builtin_amdgcn_ds_read_tr16_b64_v4i16((LAS s16x4*)(img + trrd16(lane, c, ks, 1)));
    return (bf16x8){lo[0], lo[1], lo[2], lo[3], hi[0], hi[1], hi[2], hi[3]};
}
__device__ __forceinline__ int ml_row(int b, int dir, int p) {
    return (p < CTXL) ? b * CTXL + (dir ? (CTXL - 1 - p) : p) : NCTX + b * SEQ + (dir ? (SEQ - 1 - (p - CTXL)) : (p - CTXL));
}
__device__ __forceinline__ void phase_mlstm(Frame& F) {
    const bf16_t* Qb = (const bf16_t*)(F.ws + WS_Q); const bf16_t* Kb = (const bf16_t*)(F.ws + WS_K); const bf16_t* Vb = (const bf16_t*)(F.ws + WS_V);
    const float* G = (const float*)(F.ws + WS_GATES);
    const int wi = F.bid, b = wi >> 5, hd = (wi >> 2) & 7, dir = (wi >> 1) & 1, half = wi & 1;
    bf16_t* HD = (bf16_t*)(F.ws + (dir ? WS_HB : WS_HF));
    LAS unsigned char* L = F.lds;
    LAS float* fct = (LAS float*)(L + ML_F); LAS float* frs = fct + 64; LAS float* fwi = frs + 64; LAS float* fem = fwi + 64; LAS float* fsc = fem + 64;
    LAS bf16_t* wkb = (LAS bf16_t*)(fsc + 16); LAS float* fwk = (LAS float*)(wkb + 64);
    const unsigned lane = (unsigned)F.lane; const int w = F.wave, fr = F.lane & 15, fq = F.lane >> 4;
    for (int i = F.tid; i < 144 * ML_CTP / 16; i += NTHR) *(LAS u32x4*)(L + ML_CT + 16 * i) = (u32x4){0u, 0u, 0u, 0u};
    f32x4 cst[9];
#pragma unroll
    for (int v = 0; v < 9; ++v) cst[v] = (f32x4){0.f, 0.f, 0.f, 0.f};
    float m_st = -1.0e30f;
    __syncthreads();
#pragma unroll 1
    for (int c = 0; c < 36; ++c) {
        const int p0 = 64 * c;
        u32x4 gq[2], gk[2], gv[2];
#pragma unroll
        for (int i = 0; i < 2; ++i) { const int cid = F.tid + 512 * i, row = cid >> 4, ch = cid & 15; const size_t gr = (size_t)ml_row(b, dir, p0 + row);
            gq[i] = *(const u32x4*)(Qb + gr * 1024 + hd * 128 + 8 * ch); gk[i] = *(const u32x4*)(Kb + gr * 1024 + hd * 128 + 8 * ch);
            gv[i] = *(const u32x4*)(Vb + gr * 2048 + hd * 256 + half * 128 + 8 * ch); }
        if (w == 0) {
            const size_t gr = (size_t)ml_row(b, dir, p0 + F.lane);
            const float li = G[gr * 32 + (2 * dir) * 8 + hd], lf = G[gr * 32 + (2 * dir + 1) * 8 + hd];
            float bc = lf;
#pragma unroll
            for (int o = 1; o < 64; o <<= 1) { const float t = __shfl_up(bc, o); if (F.lane >= o) bc += t; }
            const float rsv = li - bc; float cm = rsv;
#pragma unroll
            for (int o = 1; o < 64; o <<= 1) { const float t = __shfl_up(cm, o); if (F.lane >= o) cm = fmaxf(cm, t); }
            const float mrow = bc + fmaxf(m_st, cm);
            const float blast = __shfl(bc, 63), cml = __shfl(cm, 63);
            const float mnew = fmaxf(blast + m_st, blast + cml);
            const float wk = fast_exp(blast + rsv - mnew);
            fct[F.lane] = bc - mrow; frs[F.lane] = rsv; fwi[F.lane] = fast_exp(bc + m_st - mrow); fem[F.lane] = fast_exp(-mrow); fwk[F.lane] = wk;
            wkb[F.lane] = (bf16_t)(cvt_pk_bf16(wk, 0.f) & 0xffffu);
            if (F.lane == 0) { fsc[0] = fast_exp(blast + m_st - mnew); fsc[1] = mnew; }
        }
        __syncthreads();
#pragma unroll
        for (int i = 0; i < 2; ++i) { const int cid = F.tid + 512 * i, row = cid >> 4, ch = cid & 15; const unsigned o = off_b(row, ch);
            *(LAS u32x4*)(L + ML_Q + o) = gq[i]; *(LAS u32x4*)(L + ML_K + o) = gk[i]; *(LAS u32x4*)(L + ML_V + o) = gv[i];
            const float wk = fwk[row]; u32x4 s;
#pragma unroll
            for (int q = 0; q < 4; ++q) s[q] = cvt_pk_bf16(bf_lo(gv[i][q]) * wk, bf_hi(gv[i][q]) * wk);
            *(LAS u32x4*)(L + ML_VW + o) = s; }
        __syncthreads();
        const float decay = fsc[0], mnew = fsc[1];
#pragma unroll
        for (int v = 0; v < 9; ++v) cst[v] *= decay;
#pragma unroll
        for (int ks = 0; ks < 2; ++ks) {
            const bf16x8 a = tr_frag(L + ML_K, lane, (unsigned)w, ks);
#pragma unroll
            for (int v = 0; v < 8; ++v) { const bf16x8 bb = tr_frag(L + ML_VW, lane, v, ks); cst[v] = __builtin_amdgcn_mfma_f32_16x16x32_bf16(a, bb, cst[v], 0, 0, 0); }
            bf16x8 ba = *(const LAS bf16x8*)(wkb + 32 * ks + 8 * fq);
            if (fr != 0) ba = (bf16x8){0, 0, 0, 0, 0, 0, 0, 0};
            cst[8] = __builtin_amdgcn_mfma_f32_16x16x32_bf16(a, ba, cst[8], 0, 0, 0);
        }
        if (c >= 4) {
            const int tt = w >> 1;
            bf16x8 qf[4];
#pragma unroll
            for (int ks = 0; ks < 4; ++ks) qf[ks] = *(const LAS bf16x8*)(L + ML_Q + rowrd16(lane, tt, ks));
            const int t = 16 * tt + fr; const float ctt = fct[t];
#pragma unroll
            for (int si = 0; si < 2; ++si) { const int st = 2 * (w & 1) + si; f32x4 acc = (f32x4){0.f, 0.f, 0.f, 0.f};
#pragma unroll
                for (int ks = 0; ks < 4; ++ks) { const bf16x8 kf = *(const LAS bf16x8*)(L + ML_K + rowrd16(lane, st, ks)); acc = __builtin_amdgcn_mfma_f32_16x16x32_bf16(kf, qf[ks], acc, 0, 0, 0); }
                const int s0 = 16 * st + 4 * fq; float sv[4];
#pragma unroll
                for (int j = 0; j < 4; ++j) sv[j] = (s0 + j <= t) ? acc[j] * fast_exp(ctt + frs[s0 + j]) : 0.f;
                u32x2 o; o.x = cvt_pk_bf16(sv[0], sv[1]); o.y = cvt_pk_bf16(sv[2], sv[3]);
                *(LAS u32x2*)(L + ML_S + t * ML_SP + s0 * 2) = o; }
        }
        __syncthreads();
        if (c >= 4) {
            const int tt = w >> 1;
            f32x4 sv[5], qc[5];
#pragma unroll
            for (int i = 0; i < 5; ++i) { sv[i] = (f32x4){0.f, 0.f, 0.f, 0.f}; qc[i] = (f32x4){0.f, 0.f, 0.f, 0.f}; }
#pragma unroll
            for (int ks = 0; ks < 2; ++ks) { const bf16x8 a = *(const LAS bf16x8*)(L + ML_S + (fr + 16 * tt) * ML_SP + (32 * ks + 8 * fq) * 2);
#pragma unroll
                for (int i = 0; i < 4; ++i) { const bf16x8 bb = tr_frag(L + ML_V, lane, 4 * (w & 1) + i, ks); sv[i] = __builtin_amdgcn_mfma_f32_16x16x32_bf16(a, bb, sv[i], 0, 0, 0); }
                const short one = (fr == 0) ? (short)0x3F80 : (short)0;
                const bf16x8 bo = (bf16x8){one, one, one, one, one, one, one, one};
                sv[4] = __builtin_amdgcn_mfma_f32_16x16x32_bf16(a, bo, sv[4], 0, 0, 0); }
#pragma unroll
            for (int ks = 0; ks < 4; ++ks) { const bf16x8 a = *(const LAS bf16x8*)(L + ML_Q + rowrd16(lane, tt, ks));
#pragma unroll
                for (int i = 0; i < 5; ++i) { const int vt = (i < 4) ? 4 * (w & 1) + i : 8;
                    const bf16x8 bb = *(const LAS bf16x8*)(L + ML_CT + (fr + 16 * vt) * ML_CTP + (32 * ks + 8 * fq) * 2); qc[i] = __builtin_amdgcn_mfma_f32_16x16x32_bf16(a, bb, qc[i], 0, 0, 0); } }
#pragma unroll
            for (int j = 0; j < 4; ++j) { const int tl = 16 * tt + 4 * fq + j; const float wi_ = fwi[tl], em = fem[tl];
                float den = sv[4][j] + wi_ * qc[4][j]; den = __shfl(den, F.lane & 48);
                const float inv = 1.0f / fmaxf(fabsf(den), em);
                const size_t rr = (size_t)(ml_row(b, dir, p0 + tl) - NCTX);
                bf16_t* op = HD + rr * D + hd * 256 + half * 128 + fr;
#pragma unroll
                for (int i = 0; i < 4; ++i) { const float h = (sv[i][j] + wi_ * qc[i][j]) * inv; op[16 * (4 * (w & 1) + i)] = (bf16_t)(cvt_pk_bf16(h, 0.f) & 0xffffu); } }
        }
        __syncthreads();
#pragma unroll
        for (int v = 0; v < 9; ++v) { u32x2 o; o.x = cvt_pk_bf16(cst[v][0], cst[v][1]); o.y = cvt_pk_bf16(cst[v][2], cst[v][3]);
            *(LAS u32x2*)(L + ML_CT + (16 * v + fr) * ML_CTP + (16 * w + 4 * fq) * 2) = o; }
        m_st = mnew;
    }
    __syncthreads();
}

constexpr int N_PHASES = 19;
#ifndef PHASE_MASK
#define PHASE_MASK 0x7ffff
#endif
__global__ void __launch_bounds__(NTHR, 2) fwd(Args args) {
    extern __shared__ __attribute__((aligned(16))) unsigned char lds_raw[];
    if (threadIdx.x < 4) ((LAS unsigned*)((LAS unsigned char*)lds_raw + LDSCTL_OFF))[threadIdx.x] = 0u;
    __syncthreads();
#if !MK_PER_PHASE
    XcdBarrier bar = xcd_barrier_post((unsigned*)(args.ws + WS_CTL) + CW_BAR + args.li * 4096, (volatile LAS unsigned*)((LAS unsigned char*)lds_raw + LDSCTL_OFF));
#define SEAM(k) do { if (IN(k) && IN((k) + 1)) xcd_barrier(bar); } while (0)
#else
#define SEAM(k) do { } while (0)
#endif
    const int lo = args.ph_lo, hi = args.ph_hi;
#define IN(k) (((PHASE_MASK >> (k)) & 1) && lo <= (k) && (k) < hi)
#define PHASE_FRAME() Frame F; unsigned char* ws; { unsigned char* w_ = args.ws; asm volatile("" : "+s"(w_)); int t_ = threadIdx.x; asm volatile("" : "+v"(t_)); ws = w_; \
        F.lds = (LAS unsigned char*)lds_raw; F.tid = t_; F.lane = t_ & 63; F.wave = __builtin_amdgcn_readfirstlane(t_ >> 6); F.bid = blockIdx.x; F.a = &args; F.out = args.out; F.ws = w_; }

    if (IN(0)) { PHASE_FRAME(); (void)ws; phase_prologue(F); } SEAM(0);
    if (IN(1)) { PHASE_FRAME(); (void)ws; phase_norm0(F); } SEAM(1);
    if (IN(2)) { PHASE_FRAME(); pg8::DenseOrder S; S.init(ws + WS_H, ws + WS_CONVIN_T, NTOK, 3 * D, D, GRID, F.bid);
        EpiConvIn E{(bf16_t*)(ws + WS_U), (bf16_t*)(ws + WS_BM)};
        pg8::gemm_phase<EpiConvIn, pg8::DenseOrder, false>(F.lds, D, S, E); } SEAM(2);
    if (IN(3)) { PHASE_FRAME(); (void)ws; phase_conv(F); } SEAM(3);
    if (IN(4)) { PHASE_FRAME(); pg8::DenseOrder S; S.init(ws + WS_Z, ws + WS_CONVOUT_T, NTOK, D, D, GRID, F.bid);
        EpiResid E{args.in[IN_CTX], args.in[IN_X], (float*)(ws + WS_X), mod_ptr(F, 0, 0, 2), 0};
        pg8::gemm_phase<EpiResid, pg8::DenseOrder, false>(F.lds, D, S, E); } SEAM(4);
    if (IN(5)) { PHASE_FRAME(); (void)ws; phase_router(F, 0, 0, NTOK / GRID); } SEAM(5);
    if (IN(6)) { PHASE_FRAME(); (void)ws; phase_scatter(F, 0, NTOK / GRID, NTOK); } SEAM(6);
    if (IN(7)) { PHASE_FRAME(); ExpertOrder S{(const int*)(ws + RT_EINFO), 4, NTOK / 256 / 8, F.bid, (const char*)(ws + WS_H), (const char*)(ws + WS_MOE0 + MOE_GU), (const int*)(ws + RT_TOKOF), D, 1024};
        EpiSwiglu E{(bf16_t*)(ws + WS_ACT)};
        pg8::gemm_phase<EpiSwiglu, ExpertOrder, true>(F.lds, D, S, E); } SEAM(7);
    if (IN(8)) { PHASE_FRAME(); ExpertOrder S{(const int*)(ws + RT_EINFO), 8, NTOK / 256 / 8, F.bid, (const char*)(ws + WS_ACT), (const char*)(ws + WS_MOE0 + MOE_DN), nullptr, ED, 2048};
        EpiDown E{(bf16_t*)(ws + WS_Y), (const float*)(ws + RT_GATEOF)};
        pg8::gemm_phase<EpiDown, ExpertOrder, false>(F.lds, ED, S, E); } SEAM(8);
    if (IN(9)) { PHASE_FRAME(); (void)ws; phase_combine<0>(F); } SEAM(9);
    if (IN(10)) { PHASE_FRAME(); pg8::DenseOrder S; S.init(ws + WS_H, ws + WS_MLIN_T, NTOK, MLSTM_NP, D, GRID, F.bid);
        EpiMlstmIn E{(bf16_t*)(ws + WS_Q), (bf16_t*)(ws + WS_K), (bf16_t*)(ws + WS_V), (bf16_t*)(ws + WS_O), (float*)(ws + WS_GATES), args.in[IN_MLGB]};
        pg8::gemm_phase<EpiMlstmIn, pg8::DenseOrder, false>(F.lds, D, S, E); } SEAM(10);
    if (IN(11)) { PHASE_FRAME(); (void)ws; phase_mlstm(F); } SEAM(11);
    if (IN(12)) { PHASE_FRAME(); (void)ws; phase_headnorm(F); } SEAM(12);
    if (IN(13)) { PHASE_FRAME(); pg8::DenseOrder S; S.init(ws + WS_YIN, ws + WS_MLOUT_T, NLAT, D, D, GRID, F.bid);
        float* X = (float*)(ws + WS_X);
        EpiResid E{X, X + (size_t)NCTX * D, X, mod_ptr(F, 1, 0, 2), NCTX};
        pg8::gemm_phase<EpiResid, pg8::DenseOrder, false>(F.lds, D, S, E); } SEAM(13);
    if (IN(14)) { PHASE_FRAME(); (void)ws; phase_router(F, 1, NCTX, NLAT / GRID); } SEAM(14);
    if (IN(15)) { PHASE_FRAME(); (void)ws; phase_scatter(F, NCTX, NLAT / GRID, NLAT); } SEAM(15);
    if (IN(16)) { PHASE_FRAME(); ExpertOrder S{(const int*)(ws + RT_EINFO), 4, NLAT / 256 / 8, F.bid, (const char*)(ws + WS_H), (const char*)(ws + WS_MOE0 + MOE_STRIDE + MOE_GU), (const int*)(ws + RT_TOKOF), D, 1024};
        EpiSwiglu E{(bf16_t*)(ws + WS_ACT)};
        pg8::gemm_phase<EpiSwiglu, ExpertOrder, true>(F.lds, D, S, E); } SEAM(16);
    if (IN(17)) { PHASE_FRAME(); ExpertOrder S{(const int*)(ws + RT_EINFO), 8, NLAT / 256 / 8, F.bid, (const char*)(ws + WS_ACT), (const char*)(ws + WS_MOE0 + MOE_STRIDE + MOE_DN), nullptr, ED, 2048};
        EpiDown E{(bf16_t*)(ws + WS_Y), (const float*)(ws + RT_GATEOF)};
        pg8::gemm_phase<EpiDown, ExpertOrder, false>(F.lds, ED, S, E); } SEAM(17);
    if (IN(18)) { PHASE_FRAME(); (void)ws; phase_combine<1>(F); }
#undef IN
#undef SEAM
}

extern "C" void kernel_launch(void* const* d_in, const int* in_sizes, int n_in, void* d_out, int out_size, void* d_ws, size_t ws_size, hipStream_t stream) {
    static int ready = 0;
    if (ready == 0) {
        if (n_in != N_IN || out_size != NLAT * D || ws_size < WS_END) { fprintf(stderr, "kernel_launch: unexpected problem shape (n_in %d, out %d, ws %zu)\n", n_in, out_size, ws_size); ready = -1; return; }
        if (hipFuncSetAttribute((const void*)fwd, hipFuncAttributeMaxDynamicSharedMemorySize, LDS_BYTES) != hipSuccess) { fprintf(stderr, "kernel_launch: hipFuncSetAttribute failed\n"); ready = -1; return; }
        int per_cu = 0;
        if (hipOccupancyMaxActiveBlocksPerMultiprocessor(&per_cu, (const void*)fwd, NTHR, LDS_BYTES) != hipSuccess || per_cu < 1) fprintf(stderr, "kernel_launch: note: occupancy query reports %d blocks per CU\n", per_cu);
        (void)hipGetLastError();
        ready = 1;
    }
    if (ready < 0) return;
    (void)hipMemsetAsync((char*)d_ws + WS_CTL, 0, CTL_BYTES, stream);
    Args a{};
    for (int i = 0; i < N_IN; ++i) a.in[i] = (const float*)d_in[i];
    a.out = (float*)d_out; a.ws = (unsigned char*)d_ws; a.pad = 0;
#if MK_PER_PHASE
    for (int p = 0; p < N_PHASES; ++p) { a.ph_lo = p; a.ph_hi = p + 1; a.li = 0; hipLaunchKernelGGL(fwd, dim3(GRID), dim3(NTHR), LDS_BYTES, stream, a); }
#else
    a.ph_lo = 0; a.ph_hi = N_PHASES; a.li = 0;
    hipLaunchKernelGGL(fwd, dim3(GRID), dim3(NTHR), LDS_BYTES, stream, a);
#endif
}
```

```cpp
#include <hip/hip_runtime.h>
#include <stdint.h>
#include <stdio.h>

#ifndef MK_PER_PHASE
#define MK_PER_PHASE 0
#endif

#define GAS __attribute__((address_space(1)))
#define LAS __attribute__((address_space(3)))
typedef unsigned short bf16_t;
typedef short bf16x8 __attribute__((ext_vector_type(8)));
typedef short s16x4 __attribute__((ext_vector_type(4)));
typedef float f32x4 __attribute__((ext_vector_type(4)));
typedef float f32x2 __attribute__((ext_vector_type(2)));
typedef unsigned u32x4 __attribute__((ext_vector_type(4)));
typedef unsigned u32x2 __attribute__((ext_vector_type(2)));
typedef int i32x4 __attribute__((ext_vector_type(4)));
typedef GAS float gf32; typedef GAS bf16_t gbf16; typedef GAS int gi32; typedef GAS unsigned char gu8; typedef GAS char gchar;
typedef GAS f32x4 gf32x4; typedef GAS u32x4 gu32x4; typedef GAS u32x2 gu32x2; typedef GAS bf16x8 gbf16x8; typedef GAS i32x4 gi32x4;

constexpr int D = 2048, NBATCH = 8, SEQ = 2048, CTXL = 256;
constexpr int NCTX = NBATCH * CTXL;
constexpr int NLAT = NBATCH * SEQ;
constexpr int NTOK = NCTX + NLAT;
constexpr int NE = 64, TOPK = 6, ED = 512;
constexpr int ADA_N = 6 * D;
constexpr int MLSTM_N = 6176, MLSTM_NP = 6400;
constexpr int NWAVES = 8, NTHR = 512, GRID = 256;
constexpr int SH_BASE = 126976;
constexpr int NSLOT = SH_BASE + NTOK;
constexpr float EPS = 1e-6f;

constexpr size_t MiB = 1u << 20, KiB = 1024;
constexpr size_t WS_CTL = 0, CTL_BYTES = 1 * MiB;
constexpr size_t WS_MOD = 1 * MiB;
constexpr size_t WS_RT = 2 * MiB;
constexpr size_t RT_HIST = WS_RT;
constexpr size_t RT_EINFO = WS_RT + 64 * KiB;
constexpr size_t RT_SELIDX = WS_RT + 128 * KiB;
constexpr size_t RT_SELGATE = WS_RT + 640 * KiB;
constexpr size_t RT_SELRANK = WS_RT + 1152 * KiB;
constexpr size_t RT_SLOTOF = WS_RT + 1664 * KiB;
constexpr size_t RT_TOKOF = WS_RT + 2176 * KiB;
constexpr size_t RT_GATEOF = WS_RT + 2816 * KiB;
constexpr size_t RT_UNITS1 = WS_RT + 3584 * KiB;
constexpr size_t RT_UNITS2 = WS_RT + 3840 * KiB;
constexpr int MAXU1 = 64, MAXU2 = 128;
constexpr size_t WS_GATES = 10 * MiB;
constexpr size_t WS_CONVIN_T = 13 * MiB;
constexpr size_t WS_CONVOUT_T = 37 * MiB;
constexpr size_t WS_MLIN_T = 45 * MiB;
constexpr size_t WS_MLOUT_T = 70 * MiB;
constexpr size_t WS_MOE0 = 78 * MiB, MOE_STRIDE = 392 * MiB;
constexpr size_t MOE_GU = 0, MOE_DN = 260 * MiB, MOE_RT = 390 * MiB;
constexpr size_t WS_H = 862 * MiB;
constexpr size_t WS_X = 934 * MiB;
constexpr size_t WS_ACT = 1078 * MiB;
constexpr size_t WS_Y = 1220 * MiB;
constexpr size_t WS_U = WS_Y, WS_BM = WS_Y + 72 * MiB, WS_Z = WS_Y + 144 * MiB;
constexpr size_t WS_Q = WS_Y, WS_K = WS_Y + 36 * MiB, WS_V = WS_Y + 72 * MiB, WS_O = WS_Y + 144 * MiB;
constexpr size_t WS_HF = WS_Y + 216 * MiB, WS_HB = WS_Y + 280 * MiB, WS_YIN = WS_Y + 344 * MiB;
constexpr size_t WS_END = 1788 * MiB;
constexpr int CW_BAR = 4096;

constexpr int RING_BYTES = 131072;
constexpr int LDSCTL_OFF = 150 * 1024;
constexpr int LDS_BYTES = 151 * 1024;

#define LDS_WAIT() asm volatile("s_waitcnt lgkmcnt(0)" ::: "memory")
#define VM_WAIT() asm volatile("s_waitcnt vmcnt(0)" ::: "memory")
__device__ __forceinline__ unsigned cvt_pk_bf16(float lo, float hi) { unsigned r; asm volatile("v_cvt_pk_bf16_f32 %0, %1, %2" : "=v"(r) : "v"(lo), "v"(hi)); return r; }
__device__ __forceinline__ float bf_lo(unsigned u) { return __uint_as_float(u << 16); }
__device__ __forceinline__ float bf_hi(unsigned u) { return __uint_as_float(u & 0xffff0000u); }
__device__ __forceinline__ float wave_sum(float v) {
#pragma unroll
    for (int o = 1; o < 64; o <<= 1) v += __shfl_xor(v, o);
    return v;
}
__device__ __forceinline__ float fast_exp(float x) { return __builtin_amdgcn_exp2f(x * 1.44269504088896341f); }
__device__ __forceinline__ float sigmoidf_(float x) { return 1.0f / (1.0f + fast_exp(-x)); }
__device__ __forceinline__ float siluf_(float x) { return x / (1.0f + fast_exp(-x)); }

#define XB_TMO      128
#define XB_XCNT(j)  (256  + 64 * (j))
#define XB_XSUB(j)  (1280 + 64 * (j))
#define XB_XGEN(j)  (2304 + 64 * (j))
#define XB_TOP      3328
#define XB_TOPGEN   3392
#define XCD_BAR_WORDS 3456
#define XB_SPIN_CAP (1u << 22)

__device__ __forceinline__ unsigned xb_ld(unsigned* p)              { return __hip_atomic_load(p, __ATOMIC_RELAXED, __HIP_MEMORY_SCOPE_AGENT); }
__device__ __forceinline__ unsigned xb_add(unsigned* p, unsigned v) { return __hip_atomic_fetch_add(p, v, __ATOMIC_RELAXED, __HIP_MEMORY_SCOPE_AGENT); }
__device__ __forceinline__ unsigned xb_xcc_id() { return (unsigned)__builtin_amdgcn_s_getreg((3 << 11) | 20) & 0xFu; }
#define XB_SPIN(cond, bar) do { unsigned _sp = 0; while (cond) { __builtin_amdgcn_s_sleep(1); \
    if ((++_sp & 255u) == 0u) { if (xb_ld(&(bar)[XB_TMO])) break; if (_sp > XB_SPIN_CAP) { atomicAdd(&(bar)[XB_TMO], 1u); break; } } } } while (0)

struct XcdBarrier { unsigned* bar; unsigned x; volatile LAS unsigned* st; };

__device__ __forceinline__ XcdBarrier xcd_barrier_post(unsigned* bar, volatile LAS unsigned* st) {
    XcdBarrier b; b.bar = bar; b.x = xb_xcc_id(); b.st = st;
    if (threadIdx.x == 0) (void)xb_add(&bar[XB_XCNT(b.x)], 1u);
    return b;
}
__device__ __forceinline__ void xcd_barrier_complete(unsigned* bar, unsigned x, unsigned& nloc, unsigned& nx) {
    const unsigned G = gridDim.x * gridDim.y * gridDim.z;
    unsigned sum, cnt, mine, sp = 0u;
    for (;;) {
        sum = 0u; cnt = 0u; mine = 0u;
#pragma unroll
        for (unsigned j = 0; j < 16; ++j) { const unsigned c = xb_ld(&bar[XB_XCNT(j)]); sum += c; cnt += (c > 0u) ? 1u : 0u; mine = (j == x) ? c : mine; }
        if (sum == G) break;
        __builtin_amdgcn_s_sleep(1);
        if ((++sp & 255u) == 0u) { if (xb_ld(&bar[XB_TMO])) break; if (sp > XB_SPIN_CAP) { atomicAdd(&bar[XB_TMO], 1u); break; } }
    }
    nloc = mine > 0u ? mine : 1u; nx = cnt > 0u ? cnt : 1u;
}
__device__ __forceinline__ void xcd_barrier(const XcdBarrier& b) {
    asm volatile("s_waitcnt vmcnt(0)" ::: "memory");
    __syncthreads();
    if (threadIdx.x == 0) {
        unsigned* bar = b.bar;
        __builtin_amdgcn_s_waitcnt(0);
        unsigned nloc = b.st[0], nx = b.st[1];
        if (nloc == 0u) { xcd_barrier_complete(bar, b.x, nloc, nx); b.st[0] = nloc; b.st[1] = nx; }
        const unsigned old = xb_add(&bar[XB_XSUB(b.x)], 1u);
        const unsigned gen = old / nloc;
        if (old + 1u == (gen + 1u) * nloc) {
            __builtin_amdgcn_fence(__ATOMIC_RELEASE, "agent");
            asm volatile("s_waitcnt vmcnt(0)" ::: "memory");
            const unsigned og = xb_add(&bar[XB_TOP], 1u);
            const unsigned tg = og / nx;
            if (og + 1u == (tg + 1u) * nx) xb_add(&bar[XB_TOPGEN], 1u);
            else XB_SPIN(xb_ld(&bar[XB_TOPGEN]) == tg, bar);
            __builtin_amdgcn_fence(__ATOMIC_ACQUIRE, "agent");
            xb_add(&bar[XB_XGEN(b.x)], 1u);
            asm volatile("s_waitcnt vmcnt(0)" ::: "memory");
        } else {
            XB_SPIN(xb_ld(&bar[XB_XGEN(b.x)]) == gen, bar);
            __builtin_amdgcn_fence(__ATOMIC_ACQUIRE, "agent");
            asm volatile("s_waitcnt vmcnt(0)" ::: "memory");
        }
    }
    __syncthreads();
}

namespace pg8 {
constexpr int BM = 256, BK = 64, HALF = 128, HTB = HALF * BK * 2, STAGE_BYTES = 8 * HTB, NXCD = 8, WGM = 8;
__host__ __device__ __forceinline__ int lds_byte(int r, int c) { const int st = (r >> 4) * 2 + (c >> 5), rr = r & 15, cc = c & 31, ob = rr * 64 + cc * 2; return st * 1024 + (ob ^ (((ob >> 9) & 1) << 5)); }
__host__ __device__ __forceinline__ void stage_rc(int b, int& R, int& C) { const int st = b / 1024, sb = b % 1024, swz = sb ^ (((sb >> 9) & 1) << 5); R = (st >> 1) * 16 + swz / 64; C = (st & 1) * 32 + (swz % 64) / 2; }
__host__ __device__ __forceinline__ int perm32(int rho) { const int n = rho >> 4, i = rho & 15; return 8 * (i >> 2) + 4 * n + (i & 3); }

struct Unit { int pm, pn, e, row0; };

struct DenseOrder {
    int nM, nN, nwg, G, c; const gchar* A; const gchar* Bt; size_t tstep;
    __device__ void init(const GAS void* A_, const GAS void* Bt_, int M, int N, int K, int G_, int c_) { A = (const gchar*)A_; Bt = (const gchar*)Bt_; nM = M / BM; nN = N / BM; nwg = nM * nN; G = G_; c = c_; tstep = (size_t)BM * K * 2; }
    __device__ __forceinline__ bool next(int i, Unit& u) const {
        const long L = (long)i * G + c; if (L >= nwg) return false;
        int wgid = (int)L; { const int q = nwg / NXCD, r = nwg % NXCD, xcd = wgid % NXCD, off = wgid / NXCD; wgid = (xcd < r ? xcd * (q + 1) : r * (q + 1) + (xcd - r) * q) + off; }
        const int nig = WGM * nN, gid = wgid / nig, fm = gid * WGM, gsz = (nM - fm) < WGM ? (nM - fm) : WGM;
        u.pm = fm + ((wgid % nig) % gsz); u.pn = (wgid % nig) / gsz; u.e = 0; u.row0 = u.pm * BM; return true;
    }
    __device__ __forceinline__ const gchar* a_base(const Unit& u) const { return A + (size_t)u.pm * tstep; }
    __device__ __forceinline__ const gchar* b_base(const Unit& u) const { return Bt + (size_t)u.pn * tstep; }
    __device__ __forceinline__ int gather_row(const Unit&, int) const { return 0; }
};

template <class Epi, class Sched, bool GATHER>
__device__ __forceinline__ void gemm_phase(LAS unsigned char* lds, const int K, const Sched& S, const Epi& E) {
    const int tid = threadIdx.x, wid = __builtin_amdgcn_readfirstlane(tid >> 6), lane = tid & 63, wr = wid >> 2, wc = wid & 3, fr = lane & 15, fq = lane >> 4;
    const int nt = K / BK;
    int Rst[2], Cst[2];
    unsigned voffA[2], voffB[2];
#pragma unroll
    for (int i = 0; i < 2; ++i) { int R, C; stage_rc(tid * 16 + i * 8192, R, C); const int Rb = Epi::PERM ? ((R & ~31) + perm32(R & 31)) : R;
        Rst[i] = R; Cst[i] = C; voffA[i] = (unsigned)(R * K + C) * 2u; voffB[i] = (unsigned)(Rb * K + C) * 2u; }
    const size_t kstep = (size_t)(BK * 2);
    const size_t hstep = (size_t)HALF * K * 2;
    const unsigned ldsw = (unsigned)wid * 1024u;
    const int aoff = lds_byte(wr * 64 + fr, fq * 8), boff = lds_byte(wc * 32 + fr, fq * 8);
#define PG8_SA(b, h) (((b) * 2 + (h)) * HTB)
#define PG8_SB(b, h) ((4 + (b) * 2 + (h)) * HTB)
#define PG8_STAGE(bufoff, gbase, voff) do { _Pragma("unroll") for (int _i = 0; _i < 2; ++_i) \
        __builtin_amdgcn_global_load_lds((const GAS unsigned*)((const gchar*)(gbase) + (voff)[_i]), (LAS unsigned*)(lds + (bufoff) + ldsw + _i * 8192), 16, 0, 0); } while (0)
#define PG8_LDA(dst, b, h) do { _Pragma("unroll") for (int m = 0; m < 4; ++m) _Pragma("unroll") for (int k = 0; k < 2; ++k) dst[m][k] = *(const LAS bf16x8*)(lds + PG8_SA(b, h) + aoff + m * 2048 + k * 1024); } while (0)
#define PG8_LDB(dst, b, h) do { _Pragma("unroll") for (int n = 0; n < 2; ++n) _Pragma("unroll") for (int k = 0; k < 2; ++k) dst[n][k] = *(const LAS bf16x8*)(lds + PG8_SB(b, h) + boff + n * 2048 + k * 1024); } while (0)
#define PG8_MMA(ai, bj, At, Bt) do { __builtin_amdgcn_s_setprio(1); _Pragma("unroll") for (int m = 0; m < 4; ++m) _Pragma("unroll") for (int n = 0; n < 2; ++n) _Pragma("unroll") for (int k = 0; k < 2; ++k) \
        acc[ai][bj][m][n] = __builtin_amdgcn_mfma_f32_16x16x32_bf16(Bt[n][k], At[m][k], acc[ai][bj][m][n], 0, 0, 0); __builtin_amdgcn_s_setprio(0); } while (0)
#define PG8_WAIT_V(n) asm volatile("s_waitcnt vmcnt(" #n ")" ::: "memory")
#define PG8_WAIT_L(n) asm volatile("s_waitcnt lgkmcnt(" #n ")" ::: "memory")
#define PG8_BAR __builtin_amdgcn_s_barrier()
#define PG8_SCHED __builtin_amdgcn_sched_barrier(0)
    Unit cur, nxt; int ui = 0;
    if (!S.next(0, cur)) return;
    f32x4 acc[2][2][4][2];
#pragma unroll
    for (int a = 0; a < 2; ++a)
#pragma unroll
        for (int b = 0; b < 2; ++b)
#pragma unroll
            for (int m = 0; m < 4; ++m)
#pragma unroll
                for (int n = 0; n < 2; ++n) acc[a][b][m][n] = (f32x4){0.f, 0.f, 0.f, 0.f};
    bf16x8 At[4][2], B0[2][2], B1[2][2];
    const gchar* cA = S.a_base(cur); const gchar* cB = S.b_base(cur);
    unsigned vc0[2], vc1[2], vn0[2], vn1[2];
    if constexpr (GATHER) {
#pragma unroll
        for (int i = 0; i < 2; ++i) { vc0[i] = ((unsigned)S.gather_row(cur, Rst[i]) * (unsigned)K + (unsigned)Cst[i]) * 2u; vc1[i] = ((unsigned)S.gather_row(cur, HALF + Rst[i]) * (unsigned)K + (unsigned)Cst[i]) * 2u; vn0[i] = vc0[i]; vn1[i] = vc1[i]; }
    } else {
#pragma unroll
        for (int i = 0; i < 2; ++i) { vc0[i] = voffA[i]; vc1[i] = voffA[i] + (unsigned)hstep; vn0[i] = vc0[i]; vn1[i] = vc1[i]; }
    }
    PG8_STAGE(PG8_SB(0, 0), cB, voffB); PG8_STAGE(PG8_SA(0, 0), cA, vc0); PG8_STAGE(PG8_SB(0, 1), cB + hstep, voffB); PG8_STAGE(PG8_SA(0, 1), cA, vc1);
    if (wr == 1) PG8_BAR;
    PG8_WAIT_V(4); PG8_BAR;
    PG8_STAGE(PG8_SB(1, 0), cB + kstep, voffB); PG8_STAGE(PG8_SA(1, 0), cA + kstep, vc0); PG8_STAGE(PG8_SB(1, 1), cB + hstep + kstep, voffB);
    PG8_WAIT_V(6); PG8_BAR;
    for (;;) {
        const bool has_next = S.next(ui + 1, nxt);
        const gchar* nA = has_next ? S.a_base(nxt) : cA; const gchar* nB = has_next ? S.b_base(nxt) : cB;
        for (int t = 0; t < nt; t += 2) {
            const bool last = (t == nt - 2);
            const gchar* a1 = cA + (size_t)(t + 1) * kstep;
            const gchar* a2 = last ? nA : cA + (size_t)(t + 2) * kstep; const gchar* b2 = last ? nB : cB + (size_t)(t + 2) * kstep;
            const gchar* a3 = a2 + kstep; const gchar* b3 = b2 + kstep;
            unsigned s0[2], s1[2];
            if constexpr (GATHER) {
                if (last && has_next) {
#pragma unroll
                    for (int i = 0; i < 2; ++i) { vn0[i] = ((unsigned)S.gather_row(nxt, Rst[i]) * (unsigned)K + (unsigned)Cst[i]) * 2u; vn1[i] = ((unsigned)S.gather_row(nxt, HALF + Rst[i]) * (unsigned)K + (unsigned)Cst[i]) * 2u; }
                }
#pragma unroll
                for (int i = 0; i < 2; ++i) { s0[i] = last ? vn0[i] : vc0[i]; s1[i] = last ? vn1[i] : vc1[i]; }
            } else {
#pragma unroll
                for (int i = 0; i < 2; ++i) { s0[i] = vc0[i]; s1[i] = vc1[i]; }
            }
            PG8_LDB(B0, 0, 0); PG8_SCHED; PG8_LDA(At, 0, 0); PG8_STAGE(PG8_SA(1, 1), a1, vc1);
            PG8_WAIT_L(8); PG8_BAR; PG8_WAIT_L(0); PG8_MMA(0, 0, At, B0); PG8_BAR; PG8_SCHED;
            PG8_LDB(B1, 0, 1); PG8_STAGE(PG8_SB(0, 0), b2, voffB);
            PG8_BAR; PG8_WAIT_L(0); PG8_MMA(0, 1, At, B1); PG8_BAR;
            PG8_LDA(At, 0, 1); PG8_STAGE(PG8_SA(0, 0), a2, s0);
            PG8_BAR; PG8_WAIT_L(0); PG8_MMA(1, 0, At, B0); PG8_BAR; PG8_SCHED;
            PG8_STAGE(PG8_SB(0, 1), b2 + hstep, voffB);
            PG8_WAIT_V(6); PG8_BAR; PG8_MMA(1, 1, At, B1); PG8_BAR;
            PG8_LDB(B0, 1, 0); PG8_SCHED; PG8_LDA(At, 1, 0); PG8_STAGE(PG8_SA(0, 1), a2, s1);
            PG8_WAIT_L(8); PG8_BAR; PG8_WAIT_L(0); PG8_MMA(0, 0, At, B0); PG8_BAR; PG8_SCHED;
            PG8_LDB(B1, 1, 1); PG8_STAGE(PG8_SB(1, 0), b3, voffB);
            PG8_BAR; PG8_WAIT_L(0); PG8_MMA(0, 1, At, B1); PG8_BAR;
            PG8_LDA(At, 1, 1); PG8_STAGE(PG8_SA(1, 0), a3, s0);
            PG8_BAR; PG8_WAIT_L(0); PG8_MMA(1, 0, At, B0); PG8_BAR; PG8_SCHED;
            PG8_STAGE(PG8_SB(1, 1), b3 + hstep, voffB);
            PG8_WAIT_V(6); PG8_BAR; PG8_MMA(1, 1, At, B1); PG8_BAR;
        }
        E(acc, cur, wr, wc, fr, fq);
        if (!has_next) break;
#pragma unroll
        for (int a = 0; a < 2; ++a)
#pragma unroll
            for (int b = 0; b < 2; ++b)
#pragma unroll
                for (int m = 0; m < 4; ++m)
#pragma unroll
                    for (int n = 0; n < 2; ++n) acc[a][b][m][n] = (f32x4){0.f, 0.f, 0.f, 0.f};
        cur = nxt; cA = nA; cB = nB; ++ui;
#pragma unroll
        for (int i = 0; i < 2; ++i) { vc0[i] = vn0[i]; vc1[i] = vn1[i]; }
    }
    PG8_WAIT_V(0);
    if (wr == 0) PG8_BAR;
    PG8_BAR;
#undef PG8_SA
#undef PG8_SB
#undef PG8_STAGE
#undef PG8_LDA
#undef PG8_LDB
#undef PG8_MMA
#undef PG8_WAIT_V
#undef PG8_WAIT_L
#undef PG8_BAR
#undef PG8_SCHED
}
}
using pg8::Unit;

enum { IN_X = 0, IN_C, IN_CTX, IN_CCTX, IN_ADAW, IN_ADAB, IN_NMIXW, IN_NFFNW, IN_CONVIN, IN_CONVDW, IN_CONVOUT, IN_MLIN, IN_MLGB, IN_MLNW, IN_MLOUT,
       IN_RW, IN_RB, IN_EG, IN_EU, IN_ED, IN_SG, IN_SU, IN_SD, IN_FNW, N_IN };
struct Args { const float* in[N_IN]; float* out; unsigned char* ws; int ph_lo, ph_hi, li, pad; };

#define INP(i) ((const gf32*)F.a->in[i])
struct Frame {
    LAS unsigned char* lds;
    int tid, lane, wave, bid;
    const Args* a; gf32* out; gu8* ws;
};

__device__ __forceinline__ const gf32* mod_ptr(const Frame& F, int layer, int mr, int chunk) { return (const gf32*)(F.ws + WS_MOD) + ((size_t)(layer * 9 + mr) * ADA_N + (size_t)chunk * D); }
__device__ __forceinline__ int mod_row(int r) { return r < NCTX ? 8 : ((r - NCTX) >> 11); }

struct EpiConvIn {
    static constexpr bool PERM = true;
    gbf16* U; gbf16* BMt;
    __device__ __forceinline__ void operator()(const f32x4 (&acc)[2][2][4][2], const Unit& u, int wr, int wc, int fr, int fq) const {
        const int row0 = u.pm * 256 + wr * 64 + fr;
        if (u.pn < 16) {
            const int col = u.pn * 128 + wc * 32 + 8 * fq;
#pragma unroll
            for (int ai = 0; ai < 2; ++ai)
#pragma unroll
                for (int m = 0; m < 4; ++m) {
                    const f32x4 a0 = acc[ai][0][m][0] * acc[ai][1][m][0], a1 = acc[ai][0][m][1] * acc[ai][1][m][1];
                    u32x4 w; w.x = cvt_pk_bf16(a0[0], a0[1]); w.y = cvt_pk_bf16(a0[2], a0[3]); w.z = cvt_pk_bf16(a1[0], a1[1]); w.w = cvt_pk_bf16(a1[2], a1[3]);
                    *(gu32x4*)(U + (size_t)(row0 + ai * 128 + m * 16) * D + col) = w; }
        } else {
            const int col = (u.pn - 16) * 256 + wc * 32 + 8 * fq;
#pragma unroll
            for (int ai = 0; ai < 2; ++ai)
#pragma unroll
                for (int m = 0; m < 4; ++m)
#pragma unroll
                    for (int bj = 0; bj < 2; ++bj) {
                        const f32x4 a0 = acc[ai][bj][m][0], a1 = acc[ai][bj][m][1];
                        u32x4 w; w.x = cvt_pk_bf16(a0[0], a0[1]); w.y = cvt_pk_bf16(a0[2], a0[3]); w.z = cvt_pk_bf16(a1[0], a1[1]); w.w = cvt_pk_bf16(a1[2], a1[3]);
                        *(gu32x4*)(BMt + (size_t)(row0 + ai * 128 + m * 16) * D + col + bj * 128) = w; }
        }
    }
};
struct EpiResid {
    static constexpr bool PERM = false;
    const gf32* base_ctx; const gf32* base_lat; gf32* X; const gf32* gmod; int row_off;
    __device__ __forceinline__ void operator()(const f32x4 (&acc)[2][2][4][2], const Unit& u, int wr, int wc, int fr, int fq) const {
        const int R0 = row_off + u.pm * 256;
        const gf32* base = (R0 < NCTX) ? base_ctx + (size_t)R0 * D : base_lat + (size_t)(R0 - NCTX) * D;
        const gf32* g = gmod + (size_t)mod_row(R0) * ADA_N;
        gf32* o = X + (size_t)R0 * D;
        const int rl0 = wr * 64 + fr, col0 = u.pn * 256 + wc * 32 + 4 * fq;
        f32x4 gv[2][2];
#pragma unroll
        for (int bj = 0; bj < 2; ++bj)
#pragma unroll
            for (int n = 0; n < 2; ++n) gv[bj][n] = *(const gf32x4*)(g + col0 + bj * 128 + n * 16);
#pragma unroll
        for (int ah = 0; ah < 4; ++ah) { const int ai = ah >> 1, m0 = (ah & 1) * 2;
            f32x4 bv[2][2][2];
#pragma unroll
            for (int mm = 0; mm < 2; ++mm) { const size_t ro = (size_t)(rl0 + ai * 128 + (m0 + mm) * 16) * D + col0;
#pragma unroll
                for (int bj = 0; bj < 2; ++bj)
#pragma unroll
                    for (int n = 0; n < 2; ++n) bv[mm][bj][n] = *(const gf32x4*)(base + ro + bj * 128 + n * 16); }
#pragma unroll
            for (int mm = 0; mm < 2; ++mm) { const size_t ro = (size_t)(rl0 + ai * 128 + (m0 + mm) * 16) * D + col0;
#pragma unroll
                for (int bj = 0; bj < 2; ++bj)
#pragma unroll
                    for (int n = 0; n < 2; ++n) *(gf32x4*)(o + ro + bj * 128 + n * 16) = bv[mm][bj][n] + gv[bj][n] * acc[ai][bj][m0 + mm][n]; } }
    }
};
__device__ __forceinline__ float softcap_gate(float g) {
    const float e = fast_exp(-2.0f * g * (1.0f / 15.0f)); return 15.0f * (1.0f - e) / (1.0f + e);
}
__device__ __forceinline__ float log_sigmoid_(float g) { return fminf(g, 0.0f) - __logf(1.0f + fast_exp(-fabsf(g))); }
struct EpiMlstmIn {
    static constexpr bool PERM = true;
    gbf16 *Q, *Kb, *V, *O; gf32* G; const gf32* gate_b;
    __device__ __forceinline__ void operator()(const f32x4 (&acc)[2][2][4][2], const Unit& u, int wr, int wc, int fr, int fq) const {
        const int row0 = u.pm * 256 + wr * 64 + fr;
        if (u.pn < 24) {
            gbf16* dst; int ld, ct; float sc = 1.0f;
            if (u.pn < 4) { dst = Q; ld = 1024; ct = u.pn; } else if (u.pn < 8) { dst = Kb; ld = 1024; ct = u.pn - 4; sc = 0.08838834764831845f; }
            else if (u.pn < 16) { dst = V; ld = 2048; ct = u.pn - 8; } else { dst = O; ld = 2048; ct = u.pn - 16; }
            const int col = ct * 256 + wc * 32 + 8 * fq;
#pragma unroll
            for (int ai = 0; ai < 2; ++ai)
#pragma unroll
                for (int m = 0; m < 4; ++m)
#pragma unroll
                    for (int bj = 0; bj < 2; ++bj) {
                        const f32x4 a0 = acc[ai][bj][m][0] * sc, a1 = acc[ai][bj][m][1] * sc;
                        u32x4 w; w.x = cvt_pk_bf16(a0[0], a0[1]); w.y = cvt_pk_bf16(a0[2], a0[3]); w.z = cvt_pk_bf16(a1[0], a1[1]); w.w = cvt_pk_bf16(a1[2], a1[3]);
                        *(gu32x4*)(dst + (size_t)(row0 + ai * 128 + m * 16) * ld + col + bj * 128) = w; }
        } else if (wc == 0) {
            const f32x4 b0 = *(const gf32x4*)(gate_b + 8 * fq), b1 = *(const gf32x4*)(gate_b + 8 * fq + 4);
#pragma unroll
            for (int ai = 0; ai < 2; ++ai)
#pragma unroll
                for (int m = 0; m < 4; ++m) {
                    f32x4 g0 = acc[ai][0][m][0] + b0, g1 = acc[ai][0][m][1] + b1;
#pragma unroll
                    for (int j = 0; j < 4; ++j) { g0[j] = softcap_gate(g0[j]); g1[j] = softcap_gate(g1[j]); if (fq & 1) { g0[j] = log_sigmoid_(g0[j]); g1[j] = log_sigmoid_(g1[j]); } }
                    gf32* gp = G + (size_t)(row0 + ai * 128 + m * 16) * 32 + 8 * fq;
                    *(gf32x4*)gp = g0; *(gf32x4*)(gp + 4) = g1; }
        }
    }
};
struct EpiSwiglu {
    static constexpr bool PERM = true;
    gbf16* ACT;
    __device__ __forceinline__ void operator()(const f32x4 (&acc)[2][2][4][2], const Unit& u, int wr, int wc, int fr, int fq) const {
        const int row0 = u.row0 + wr * 64 + fr, col = u.pn * 128 + wc * 32 + 8 * fq;
#pragma unroll
        for (int ai = 0; ai < 2; ++ai)
#pragma unroll
            for (int m = 0; m < 4; ++m) {
                f32x4 a0, a1;
#pragma unroll
                for (int j = 0; j < 4; ++j) { a0[j] = siluf_(acc[ai][0][m][0][j]) * acc[ai][1][m][0][j]; a1[j] = siluf_(acc[ai][0][m][1][j]) * acc[ai][1][m][1][j]; }
                u32x4 w; w.x = cvt_pk_bf16(a0[0], a0[1]); w.y = cvt_pk_bf16(a0[2], a0[3]); w.z = cvt_pk_bf16(a1[0], a1[1]); w.w = cvt_pk_bf16(a1[2], a1[3]);
                *(gu32x4*)(ACT + (size_t)(row0 + ai * 128 + m * 16) * ED + col) = w; }
    }
};
struct EpiDown {
    static constexpr bool PERM = true;
    gbf16* Y; const gf32* gate_of;
    __device__ __forceinline__ void operator()(const f32x4 (&acc)[2][2][4][2], const Unit& u, int wr, int wc, int fr, int fq) const {
        const int row0 = u.row0 + wr * 64 + fr, col = u.pn * 256 + wc * 32 + 8 * fq;
        float gts[2][4];
#pragma unroll
        for (int ai = 0; ai < 2; ++ai)
#pragma unroll
            for (int m = 0; m < 4; ++m) gts[ai][m] = gate_of[row0 + ai * 128 + m * 16];
#pragma unroll
        for (int ai = 0; ai < 2; ++ai)
#pragma unroll
            for (int m = 0; m < 4; ++m) { const int slot = row0 + ai * 128 + m * 16; const float gt = gts[ai][m];
#pragma unroll
                for (int bj = 0; bj < 2; ++bj) {
                    const f32x4 a0 = acc[ai][bj][m][0] * gt, a1 = acc[ai][bj][m][1] * gt;
                    u32x4 w; w.x = cvt_pk_bf16(a0[0], a0[1]); w.y = cvt_pk_bf16(a0[2], a0[3]); w.z = cvt_pk_bf16(a1[0], a1[1]); w.w = cvt_pk_bf16(a1[2], a1[3]);
                    *(gu32x4*)(Y + (size_t)slot * D + col + bj * 128) = w; } }
    }
};

constexpr int LDS_UNITS = RING_BYTES;
struct ExpertOrder {
    const LAS i32x4* units; const gchar* A; const gchar* Bt; const gi32* tok_of; int K, erows;
    __device__ __forceinline__ bool next(int i, Unit& u) const {
        const i32x4 d = units[i];
        u.e = __builtin_amdgcn_readfirstlane(d.x); u.pm = __builtin_amdgcn_readfirstlane(d.y); u.pn = __builtin_amdgcn_readfirstlane(d.z); u.row0 = __builtin_amdgcn_readfirstlane(d.w);
        return u.e >= 0;
    }
    __device__ __forceinline__ const gchar* a_base(const Unit& u) const { return tok_of ? A : A + (size_t)u.row0 * K * 2; }
    __device__ __forceinline__ const gchar* b_base(const Unit& u) const { return Bt + ((size_t)u.e * erows + (size_t)u.pn * 256) * K * 2; }
    __device__ __forceinline__ int gather_row(const Unit& u, int r) const { return tok_of[u.row0 + r]; }
};
__device__ __forceinline__ const LAS i32x4* stage_units(Frame& F, const gi32x4* g, int n) {
    LAS i32x4* l = (LAS i32x4*)(F.lds + LDS_UNITS);
    if (F.tid < n) l[F.tid] = g[F.tid];
    __syncthreads();
    return l;
}
__device__ __forceinline__ bool class_unit(const LAS int* tot, const LAS int* pst, int x, int q, int npn, int shpc, i32x4& d) {
#pragma unroll 1
    for (int kk = 0; kk < 8; ++kk) { const int e = x + 8 * kk; const int n = ((tot[e] + 255) >> 8) * npn;
        if (q < n) { const int mt = q / npn; d = (i32x4){e, mt, q - mt * npn, pst[e] + 256 * mt}; return true; } q -= n; }
    if (q < shpc * npn) { const int mt = x * shpc + q / npn; d = (i32x4){64, mt, q % npn, SH_BASE + 256 * mt}; return true; }
    d = (i32x4){-1, 0, 0, 0}; return false;
}

__device__ __forceinline__ void tr_item(const gf32* __restrict__ W, int ldw, int K, gbf16* WT, int drow, int k0, int n0src, LAS float* scr, int lane) {
    float tv[32];
    const gf32* wp = W + (size_t)(k0 + (lane >> 5)) * ldw + n0src + (lane & 31);
#pragma unroll
    for (int i = 0; i < 32; ++i) tv[i] = __builtin_nontemporal_load(wp + (size_t)(2 * i) * ldw);
#pragma unroll
    for (int i = 0; i < 32; ++i) scr[(2 * i + (lane >> 5)) * 33 + (lane & 31)] = tv[i];
    LDS_WAIT(); asm volatile("" ::: "memory");
    const int c = lane & 7;
#pragma unroll
    for (int j = 0; j < 4; ++j) { const int n = (lane >> 3) + 8 * j; const LAS float* s = scr + (8 * c) * 33 + n;
        u32x4 o; o.x = cvt_pk_bf16(s[0 * 33], s[1 * 33]); o.y = cvt_pk_bf16(s[2 * 33], s[3 * 33]); o.z = cvt_pk_bf16(s[4 * 33], s[5 * 33]); o.w = cvt_pk_bf16(s[6 * 33], s[7 * 33]);
        *(gu32x4*)(WT + (size_t)(drow + n) * K + k0 + 8 * c) = o; }
    LDS_WAIT(); asm volatile("" ::: "memory");
}
__device__ __forceinline__ void tr_job(int r, const gf32* src, int ldw, int col0, int K, int N, size_t sbatch, gbf16* dst, size_t dbatch, int row_off, int seg, int segs, LAS float* scr, int lane) {
    const int nblk = N >> 5, ipb = (K >> 6) * nblk;
    const int bt = r / ipb, rr = r - bt * ipb, kb = rr / nblk, nb = rr - kb * nblk, n0 = nb << 5;
    tr_item(src + (size_t)bt * sbatch, ldw, K, dst + (size_t)bt * dbatch, row_off + (n0 / seg) * segs + (n0 % seg), kb << 6, col0 + n0, scr, lane);
}
__device__ __forceinline__ void phase_prologue(Frame& F) {
    if (F.bid < 192) {
        LAS float* cond = (LAS float*)F.lds;
        LAS float* red = (LAS float*)(F.lds + 9 * 2048 * 4);
        for (int i = F.tid; i < 9 * 2048; i += NTHR) { const int r = i >> 11, k = i & 2047; const float v = (r < 8) ? INP(IN_C)[r * D + k] : INP(IN_CCTX)[k]; cond[i] = siluf_(v); }
        __syncthreads();
        const int l = F.bid / 96, col0 = (F.bid % 96) * 128, cg = F.tid & 31, kl = F.tid >> 5;
        const gf32* W = INP(IN_ADAW) + (size_t)l * D * ADA_N + col0 + 4 * cg;
        f32x4 acc[9];
#pragma unroll
        for (int r = 0; r < 9; ++r) acc[r] = (f32x4){0.f, 0.f, 0.f, 0.f};
#pragma unroll 4
        for (int k = kl; k < D; k += 16) { const f32x4 w4 = *(const gf32x4*)(W + (size_t)k * ADA_N);
#pragma unroll
            for (int r = 0; r < 9; ++r) acc[r] += cond[r * 2048 + k] * w4; }
#pragma unroll
        for (int r = 0; r < 9; ++r) *(LAS f32x4*)(red + (kl * 9 + r) * 128 + 4 * cg) = acc[r];
        __syncthreads();
        gf32* mod = (gf32*)(F.ws + WS_MOD);
        for (int o = F.tid; o < 9 * 128; o += NTHR) { const int r = o >> 7, c = o & 127; float s = 0.f;
#pragma unroll
            for (int q = 0; q < 16; ++q) s += red[(q * 9 + r) * 128 + c];
            mod[(size_t)(l * 9 + r) * ADA_N + col0 + c] = s + INP(IN_ADAB)[l * ADA_N + col0 + c]; }
        __syncthreads();
    }
    LAS float* scr = (LAS float*)(F.lds + F.wave * 8704);
    const int gw = F.bid * NWAVES + F.wave, NGW = GRID * NWAVES;
    gbf16* convin_t = (gbf16*)(F.ws + WS_CONVIN_T); gbf16* convout_t = (gbf16*)(F.ws + WS_CONVOUT_T);
    gbf16* mlin_t = (gbf16*)(F.ws + WS_MLIN_T); gbf16* mlout_t = (gbf16*)(F.ws + WS_MLOUT_T);
    constexpr int I_SQ = 32 * 64, I_MLIN = 32 * 193, I_RT = 32 * 2, I_EGU = 64 * 32 * 16, I_EDN = 64 * 8 * 64, I_SGU = 32 * 16, I_SDN = 8 * 64;
    constexpr int I_MOE = I_RT + 2 * I_EGU + I_EDN + 2 * I_SGU + I_SDN;
    constexpr int NITEMS = 4 * I_SQ + I_MLIN + I_SQ + 2 * I_MOE;
    for (int it = gw; it < NITEMS; it += NGW) {
        int r = it;
        if (r < I_SQ) { tr_job(r, INP(IN_CONVIN), 3 * D, 2048, D, D, 0, convin_t, 0, 0, 128, 256, scr, F.lane); continue; } r -= I_SQ;
        if (r < I_SQ) { tr_job(r, INP(IN_CONVIN), 3 * D, 4096, D, D, 0, convin_t, 0, 128, 128, 256, scr, F.lane); continue; } r -= I_SQ;
        if (r < I_SQ) { tr_job(r, INP(IN_CONVIN), 3 * D, 0, D, D, 0, convin_t, 0, 4096, D, 0, scr, F.lane); continue; } r -= I_SQ;
        if (r < I_SQ) { tr_job(r, INP(IN_CONVOUT), D, 0, D, D, 0, convout_t, 0, 0, D, 0, scr, F.lane); continue; } r -= I_SQ;
        if (r < I_MLIN) { tr_job(r, INP(IN_MLIN), MLSTM_N, 0, D, MLSTM_N, 0, mlin_t, 0, 0, 8192, 0, scr, F.lane); continue; } r -= I_MLIN;
        if (r < I_SQ) { tr_job(r, INP(IN_MLOUT), D, 0, D, D, 0, mlout_t, 0, 0, D, 0, scr, F.lane); continue; } r -= I_SQ;
        const int l = r / I_MOE; r -= l * I_MOE;
        gu8* moe = F.ws + WS_MOE0 + (size_t)l * MOE_STRIDE;
        gbf16* gu_t = (gbf16*)(moe + MOE_GU); gbf16* dn_t = (gbf16*)(moe + MOE_DN); gbf16* rt_t = (gbf16*)(moe + MOE_RT);
        if (r < I_RT) { tr_job(r, INP(IN_RW) + (size_t)l * D * NE, NE, 0, D, NE, 0, rt_t, 0, 0, NE, 0, scr, F.lane); continue; } r -= I_RT;
        if (r < I_EGU) { tr_job(r, INP(IN_EG) + (size_t)l * NE * D * ED, ED, 0, D, ED, (size_t)D * ED, gu_t, (size_t)1024 * D, 0, 128, 256, scr, F.lane); continue; } r -= I_EGU;
        if (r < I_EGU) { tr_job(r, INP(IN_EU) + (size_t)l * NE * D * ED, ED, 0, D, ED, (size_t)D * ED, gu_t, (size_t)1024 * D, 128, 128, 256, scr, F.lane); continue; } r -= I_EGU;
        if (r < I_EDN) { tr_job(r, INP(IN_ED) + (size_t)l * NE * ED * D, D, 0, ED, D, (size_t)ED * D, dn_t, (size_t)D * ED, 0, D, 0, scr, F.lane); continue; } r -= I_EDN;
        if (r < I_SGU) { tr_job(r, INP(IN_SG) + (size_t)l * D * ED, ED, 0, D, ED, 0, gu_t + (size_t)64 * 1024 * D, 0, 0, 128, 256, scr, F.lane); continue; } r -= I_SGU;
        if (r < I_SGU) { tr_job(r, INP(IN_SU) + (size_t)l * D * ED, ED, 0, D, ED, 0, gu_t + (size_t)64 * 1024 * D, 0, 128, 128, 256, scr, F.lane); continue; } r -= I_SGU;
        tr_job(r, INP(IN_SD) + (size_t)l * ED * D, D, 0, ED, D, 0, dn_t + (size_t)64 * D * ED, 0, 0, D, 0, scr, F.lane);
    }
    { gu32x4* z = (gu32x4*)(mlin_t + (size_t)MLSTM_N * D); const int n16 = (MLSTM_NP - MLSTM_N) * D * 2 / 16;
      for (int i = F.bid * NTHR + F.tid; i < n16; i += GRID * NTHR) z[i] = (u32x4){0u, 0u, 0u, 0u}; }
}

template <bool TO_LDS>
__device__ __forceinline__ void norm_mod_store(const f32x4 (&v)[8], float rstd, const gf32* w, const gf32* shift, const gf32* scale, gbf16* orow, LAS bf16_t* lrow, int lane) {
#pragma unroll
    for (int j = 0; j < 8; ++j) { const int c = 4 * lane + 256 * j;
        const f32x4 w4 = *(const gf32x4*)(w + c), sc = *(const gf32x4*)(scale + c), sh = *(const gf32x4*)(shift + c);
        const f32x4 y = (v[j] * rstd) * w4 * (sc + 1.0f) + sh;
        u32x2 o; o.x = cvt_pk_bf16(y[0], y[1]); o.y = cvt_pk_bf16(y[2], y[3]);
        *(gu32x2*)(orow + c) = o;
        if (TO_LDS) *(LAS u32x2*)(lrow + c) = o; }
}
__device__ __forceinline__ float row_ssq(const f32x4 (&v)[8]) {
    float s = 0.f;
#pragma unroll
    for (int j = 0; j < 8; ++j) s += (v[j][0] * v[j][0] + v[j][1] * v[j][1]) + (v[j][2] * v[j][2] + v[j][3] * v[j][3]);
    return wave_sum(s);
}

__device__ __forceinline__ void phase_norm0(Frame& F) {
    gbf16* H = (gbf16*)(F.ws + WS_H);
    const int gw = F.bid * NWAVES + F.wave, NGW = GRID * NWAVES;
    for (int r = gw; r < NTOK; r += NGW) {
        const gf32* xr = (r < NCTX) ? INP(IN_CTX) + (size_t)r * D : INP(IN_X) + (size_t)(r - NCTX) * D;
        f32x4 v[8];
#pragma unroll
        for (int j = 0; j < 8; ++j) v[j] = *(const gf32x4*)(xr + 4 * F.lane + 256 * j);
        const float rstd = rsqrtf(row_ssq(v) * (1.0f / D) + EPS);
        const int mr = mod_row(r);
        norm_mod_store<false>(v, rstd, INP(IN_NMIXW), mod_ptr(F, 0, mr, 0), mod_ptr(F, 0, mr, 1), H + (size_t)r * D, (LAS bf16_t*)F.lds, F.lane);
    }
}

__device__ __forceinline__ void phase_conv(Frame& F) {
    const gbf16* U = (const gbf16*)(F.ws + WS_U); const gbf16* BMt = (const gbf16*)(F.ws + WS_BM); gbf16* Z = (gbf16*)(F.ws + WS_Z);
    const gf32* dw = INP(IN_CONVDW);
    const int total = NTOK * (D / 8);
    for (int i = F.bid * NTHR + F.tid; i < total; i += GRID * NTHR) {
        const int r = i >> 8, c = (i & 255) * 8;
        const int pos = (r < NCTX) ? (r & 255) : (r & 63), seglen = (r < NCTX) ? 256 : 64;
        const u32x4 z4 = (u32x4){0u, 0u, 0u, 0u};
        const u32x4 um = (pos > 0) ? *(const gu32x4*)(U + (size_t)(r - 1) * D + c) : z4;
        const u32x4 u0 = *(const gu32x4*)(U + (size_t)r * D + c);
        const u32x4 up = (pos < seglen - 1) ? *(const gu32x4*)(U + (size_t)(r + 1) * D + c) : z4;
        const u32x4 bb = *(const gu32x4*)(BMt + (size_t)r * D + c);
        float w0[8], w1[8], w2[8];
#pragma unroll
        for (int q = 0; q < 2; ++q) { const f32x4 a = *(const gf32x4*)(dw + c + 4 * q), b = *(const gf32x4*)(dw + D + c + 4 * q), d = *(const gf32x4*)(dw + 2 * D + c + 4 * q);
#pragma unroll
            for (int j = 0; j < 4; ++j) { w0[4 * q + j] = a[j]; w1[4 * q + j] = b[j]; w2[4 * q + j] = d[j]; } }
        u32x4 o;
#pragma unroll
        for (int q = 0; q < 4; ++q) {
            const float y0 = bf_lo(bb[q]) * (w0[2 * q] * bf_lo(um[q]) + w1[2 * q] * bf_lo(u0[q]) + w2[2 * q] * bf_lo(up[q]));
            const float y1 = bf_hi(bb[q]) * (w0[2 * q + 1] * bf_hi(um[q]) + w1[2 * q + 1] * bf_hi(u0[q]) + w2[2 * q + 1] * bf_hi(up[q]));
            o[q] = cvt_pk_bf16(y0, y1); }
        *(gu32x4*)(Z + (size_t)r * D + c) = o;
    }
}

constexpr int HS_PITCH = 2056;
constexpr int RL_HS = 0, RL_PART = 16 * HS_PITCH * 2, RL_LOGIT = RL_PART + 8 * 16 * 64 * 4, RL_IDX = RL_LOGIT + 16 * 64 * 4;
__device__ __forceinline__ void phase_router(Frame& F, int layer, int rowbase, int rpb) {
    const gf32* X = (const gf32*)(F.ws + WS_X); gbf16* H = (gbf16*)(F.ws + WS_H);
    const gbf16* rt_t = (const gbf16*)(F.ws + WS_MOE0 + (size_t)layer * MOE_STRIDE + MOE_RT);
    gi32* sel_idx = (gi32*)(F.ws + RT_SELIDX); gf32* sel_gate = (gf32*)(F.ws + RT_SELGATE); gi32* sel_rank = (gi32*)(F.ws + RT_SELRANK); gi32* hist = (gi32*)(F.ws + RT_HIST);
    LAS bf16_t* hs = (LAS bf16_t*)(F.lds + RL_HS); LAS float* part = (LAS float*)(F.lds + RL_PART); LAS float* logit = (LAS float*)(F.lds + RL_LOGIT); LAS int* bidx = (LAS int*)(F.lds + RL_IDX);
    const int r0 = rowbase + F.bid * rpb, ngroups = (rpb + 15) >> 4;
    const gf32* nw = INP(IN_NFFNW) + layer * D; const float bias = INP(IN_RB)[layer * NE + F.lane];
    for (int g = 0; g < ngroups; ++g) {
#pragma unroll 1
        for (int q = 0; q < 2; ++q) { const int lr = 2 * F.wave + q, br = 16 * g + lr; LAS bf16_t* lrow = hs + lr * HS_PITCH;
            if (br < rpb) { const int r = r0 + br; const gf32* xr = X + (size_t)r * D; f32x4 v[8];
#pragma unroll
                for (int j = 0; j < 8; ++j) v[j] = *(const gf32x4*)(xr + 4 * F.lane + 256 * j);
                const float rstd = rsqrtf(row_ssq(v) * (1.0f / D) + EPS); const int mr = mod_row(r);
                norm_mod_store<true>(v, rstd, nw, mod_ptr(F, layer, mr, 3), mod_ptr(F, layer, mr, 4), H + (size_t)r * D, lrow, F.lane);
            } else {
#pragma unroll
                for (int j = 0; j < 8; ++j) *(LAS u32x2*)(lrow + 4 * F.lane + 256 * j) = (u32x2){0u, 0u}; } }
        __syncthreads();
        { f32x4 acc[4];
#pragma unroll
          for (int nt = 0; nt < 4; ++nt) acc[nt] = (f32x4){0.f, 0.f, 0.f, 0.f};
          const int fr = F.lane & 15, fq = F.lane >> 4;
#pragma unroll 2
          for (int ks = 0; ks < 8; ++ks) { const int k0 = 256 * F.wave + 32 * ks + 8 * fq;
              const bf16x8 a = *(const LAS bf16x8*)(hs + fr * HS_PITCH + k0);
#pragma unroll
              for (int nt = 0; nt < 4; ++nt) { const bf16x8 b = *(const gbf16x8*)(rt_t + (size_t)(16 * nt + fr) * D + k0);
                  acc[nt] = __builtin_amdgcn_mfma_f32_16x16x32_bf16(a, b, acc[nt], 0, 0, 0); } }
#pragma unroll
          for (int nt = 0; nt < 4; ++nt)
#pragma unroll
              for (int j = 0; j < 4; ++j) part[F.wave * 1024 + (4 * fq + j) * 64 + 16 * nt + fr] = acc[nt][j]; }
        __syncthreads();
#pragma unroll
        for (int q = 0; q < 2; ++q) { const int o = F.tid + 512 * q; float s = 0.f;
#pragma unroll
            for (int w = 0; w < 8; ++w) s += part[w * 1024 + o];
            logit[o] = s; }
        __syncthreads();
#pragma unroll 1
        for (int q = 0; q < 2; ++q) { const int lr = 2 * F.wave + q, br = 16 * g + lr;
            if (br < rpb) { const int r = r0 + br;
                const float sc = sigmoidf_(logit[lr * 64 + F.lane]); float v = sc + bias;
                int myidx = 0; float mysc = 0.f;
#pragma unroll 1
                for (int k = 0; k < TOPK; ++k) { float bv = v; int bi = F.lane;
#pragma unroll
                    for (int o = 1; o < 64; o <<= 1) { const float ov = __shfl_xor(bv, o); const int oi = __shfl_xor(bi, o); if (ov > bv || (ov == bv && oi < bi)) { bv = ov; bi = oi; } }
                    const float ws = __shfl(sc, bi);
                    if (F.lane == k) { myidx = bi; mysc = ws; }
                    if (F.lane == bi) v = -3.0e38f; }
                const float ssum = wave_sum(F.lane < TOPK ? mysc : 0.f);
                if (F.lane < TOPK) { sel_idx[(size_t)r * TOPK + F.lane] = myidx; sel_gate[(size_t)r * TOPK + F.lane] = mysc / ssum * 2.5f; bidx[br * TOPK + F.lane] = myidx; } } }
    }
    __syncthreads();
    if (F.wave == 0) { int cnt = 0;
        for (int rr = 0; rr < rpb; ++rr) {
#pragma unroll
            for (int k = 0; k < TOPK; ++k) { const int id = bidx[rr * TOPK + k]; if (id == F.lane) { sel_rank[(size_t)(r0 + rr) * TOPK + k] = cnt; ++cnt; } } }
        hist[F.bid * NE + F.lane] = cnt; }
    __syncthreads();
}

__device__ __forceinline__ void phase_scatter(Frame& F, int rowbase, int rpb, int ntok) {
    const gi32* hist = (const gi32*)(F.ws + RT_HIST); gi32* einfo = (gi32*)(F.ws + RT_EINFO);
    const gi32* sel_idx = (const gi32*)(F.ws + RT_SELIDX); const gf32* sel_gate = (const gf32*)(F.ws + RT_SELGATE); const gi32* sel_rank = (const gi32*)(F.ws + RT_SELRANK);
    gi32* slot_of = (gi32*)(F.ws + RT_SLOTOF); gi32* tok_of = (gi32*)(F.ws + RT_TOKOF); gf32* gate_of = (gf32*)(F.ws + RT_GATEOF);
    LAS int* tot8 = (LAS int*)F.lds; LAS int* pre8 = tot8 + 512; LAS int* tot = pre8 + 512; LAS int* boff = tot + 64; LAS int* pst = boff + 64;
    { const int e = F.tid & 63, p = F.tid >> 6; int s = 0, pre = 0;
      for (int b = 32 * p; b < 32 * p + 32; ++b) { const int h = hist[b * NE + e]; s += h; pre += (b < F.bid) ? h : 0; }
      tot8[p * 64 + e] = s; pre8[p * 64 + e] = pre; }
    __syncthreads();
    if (F.tid < 64) { int s = 0, pre = 0;
#pragma unroll
        for (int p = 0; p < 8; ++p) { s += tot8[p * 64 + F.tid]; pre += pre8[p * 64 + F.tid]; }
        tot[F.tid] = s; boff[F.tid] = pre; }
    __syncthreads();
    if (F.tid == 0) { int a = 0; for (int e = 0; e < NE; ++e) { pst[e] = a; a += (tot[e] + 255) & ~255; } }
    __syncthreads();
    const int r0 = rowbase + F.bid * rpb;
    for (int a = F.tid; a < rpb * TOPK; a += NTHR) { const size_t ga = (size_t)r0 * TOPK + a; const int e = sel_idx[ga];
        const int slot = pst[e] + boff[e] + sel_rank[ga];
        tok_of[slot] = r0 + a / TOPK; gate_of[slot] = sel_gate[ga]; slot_of[ga] = slot; }
    for (int rr = F.tid; rr < rpb; rr += NTHR) { const int s = SH_BASE + (r0 - rowbase) + rr; tok_of[s] = r0 + rr; gate_of[s] = 1.0f; }
    if (F.bid < NE) { const int e = F.bid, lo = pst[e] + tot[e], hi = pst[e] + ((tot[e] + 255) & ~255);
        for (int s = lo + F.tid; s < hi; s += NTHR) { tok_of[s] = rowbase; gate_of[s] = 0.0f; } }
    if (F.bid == 0) {
        if (F.tid < NE) { einfo[F.tid] = tot[F.tid]; einfo[128 + F.tid] = pst[F.tid]; einfo[256 + F.tid] = (tot[F.tid] + 255) >> 8; }
        if (F.tid == NE) { einfo[NE] = ntok; einfo[128 + NE] = SH_BASE; einfo[256 + NE] = ntok >> 8; } }
    { const int x = F.bid & 7, j = F.bid >> 3, shpc = (ntok >> 8) >> 3;
      gi32x4* u1 = (gi32x4*)(F.ws + RT_UNITS1) + F.bid * MAXU1; gi32x4* u2 = (gi32x4*)(F.ws + RT_UNITS2) + F.bid * MAXU2;
      if (F.tid < MAXU1) { i32x4 d; class_unit(tot, pst, x, F.tid * 32 + j, 4, shpc, d); u1[F.tid] = d; }
      else if (F.tid >= 128 && F.tid < 128 + MAXU2) { const int i = F.tid - 128; i32x4 d; class_unit(tot, pst, x, i * 32 + j, 8, shpc, d); u2[i] = d; } }
    __syncthreads();
}

template <int MODE>
__device__ __forceinline__ void phase_combine(Frame& F) {
    gf32* X = (gf32*)(F.ws + WS_X); gbf16* H = (gbf16*)(F.ws + WS_H); const gbf16* Y = (const gbf16*)(F.ws + WS_Y);
    const gi32* slot_of = (const gi32*)(F.ws + RT_SLOTOF);
    const int layer = MODE, rowbase = MODE ? NCTX : 0, nrows = MODE ? NLAT : NTOK;
    const int gw = F.bid * NWAVES + F.wave, NGW = GRID * NWAVES;
    for (int rr = gw; rr < nrows; rr += NGW) { const int r = rowbase + rr;
        int sl[7];
#pragma unroll
        for (int k = 0; k < TOPK; ++k) sl[k] = __builtin_amdgcn_readfirstlane(slot_of[(size_t)r * TOPK + k]);
        sl[6] = SH_BASE + rr;
        const int mr = mod_row(r); const gf32* g2 = mod_ptr(F, layer, mr, 5);
        f32x4 v[8];
#pragma unroll
        for (int j = 0; j < 8; ++j) { const int c = 4 * F.lane + 256 * j; f32x4 m = (f32x4){0.f, 0.f, 0.f, 0.f};
#pragma unroll
            for (int k = 0; k < 7; ++k) { const u32x2 y = *(const gu32x2*)(Y + (size_t)sl[k] * D + c); m[0] += bf_lo(y.x); m[1] += bf_hi(y.x); m[2] += bf_lo(y.y); m[3] += bf_hi(y.y); }
            v[j] = *(const gf32x4*)(X + (size_t)r * D + c) + *(const gf32x4*)(g2 + c) * m; }
        const float rstd = rsqrtf(row_ssq(v) * (1.0f / D) + EPS);
        if (MODE == 0) {
#pragma unroll
            for (int j = 0; j < 8; ++j) *(gf32x4*)(X + (size_t)r * D + 4 * F.lane + 256 * j) = v[j];
            norm_mod_store<false>(v, rstd, INP(IN_NMIXW) + D, mod_ptr(F, 1, mr, 0), mod_ptr(F, 1, mr, 1), H + (size_t)r * D, (LAS bf16_t*)F.lds, F.lane);
        } else {
#pragma unroll
            for (int j = 0; j < 8; ++j) { const int c = 4 * F.lane + 256 * j; *(gf32x4*)(F.out + (size_t)rr * D + c) = (v[j] * rstd) * *(const gf32x4*)(INP(IN_FNW) + c); }
        }
    }
}

__device__ __forceinline__ void phase_headnorm(Frame& F) {
    const gbf16* HF = (const gbf16*)(F.ws + WS_HF); const gbf16* HB = (const gbf16*)(F.ws + WS_HB); const gbf16* O = (const gbf16*)(F.ws + WS_O); gbf16* YIN = (gbf16*)(F.ws + WS_YIN);
    const gf32* nw = INP(IN_MLNW);
    const int gw = F.bid * NWAVES + F.wave, NGW = GRID * NWAVES;
    for (int rr = gw; rr < NLAT; rr += NGW) {
#pragma unroll 2
        for (int hd = 0; hd < 8; ++hd) { const int c = hd * 256 + 4 * F.lane;
            const u32x2 a = *(const gu32x2*)(HF + (size_t)rr * D + c), b = *(const gu32x2*)(HB + (size_t)rr * D + c), o = *(const gu32x2*)(O + (size_t)(NCTX + rr) * D + c);
            const f32x4 w4 = *(const gf32x4*)(nw + c);
            f32x4 h; h[0] = bf_lo(a.x) + bf_lo(b.x); h[1] = bf_hi(a.x) + bf_hi(b.x); h[2] = bf_lo(a.y) + bf_lo(b.y); h[3] = bf_hi(a.y) + bf_hi(b.y);
            const float ss = wave_sum((h[0] * h[0] + h[1] * h[1]) + (h[2] * h[2] + h[3] * h[3]));
            const float rstd = rsqrtf(ss * (1.0f / 256.0f) + EPS);
            const float y0 = h[0] * rstd * w4[0] * sigmoidf_(bf_lo(o.x)), y1 = h[1] * rstd * w4[1] * sigmoidf_(bf_hi(o.x));
            const float y2 = h[2] * rstd * w4[2] * sigmoidf_(bf_lo(o.y)), y3 = h[3] * rstd * w4[3] * sigmoidf_(bf_hi(o.y));
            u32x2 w; w.x = cvt_pk_bf16(y0, y1); w.y = cvt_pk_bf16(y2, y3);
            *(gu32x2*)(YIN + (size_t)rr * D + c) = w; }
    }
}

constexpr int ML_Q = 0, ML_K = 16384, ML_V = 32768, ML_VW = 49152, ML_S = 65536, ML_CT = 74752, ML_F = 113920;
constexpr int ML_SP = 144, ML_CTP = 272;
__device__ __forceinline__ unsigned off_b(unsigned row, unsigned ch) { return 256u * row + 16u * (ch ^ (((row & 3u) << 2) | ((row >> 2) & 3u))); }
__device__ __forceinline__ unsigned rowrd16(unsigned lane, unsigned rb, unsigned s) { return off_b((lane & 15u) + 16u * rb, 4u * s + (lane >> 4)); }
__device__ __forceinline__ unsigned trrd16(unsigned lane, unsigned c, unsigned ks, unsigned t) {
    const unsigned g = lane >> 4, q = (lane & 15u) >> 2, p = lane & 3u;
    return off_b(32u * ks + 8u * g + 4u * t + q, 2u * c + (p >> 1)) + 8u * (p & 1u);
}
__device__ __forceinline__ bf16x8 tr_frag(LAS unsigned char* img, unsigned lane, unsigned c, unsigned ks) {
    const s16x4 lo = __builtin_amdgcn_ds_read_tr16_b64_v4i16((LAS s16x4*)(img + trrd16(lane, c, ks, 0)));
    const s16x4 hi = __builtin_amdgcn_ds_read_tr16_b64_v4i16((LAS s16x4*)(img + trrd16(lane, c, ks, 1)));
    return (bf16x8){lo[0], lo[1], lo[2], lo[3], hi[0], hi[1], hi[2], hi[3]};
}
__device__ __forceinline__ int ml_row(int b, int dir, int p) {
    return (p < CTXL) ? b * CTXL + (dir ? (CTXL - 1 - p) : p) : NCTX + b * SEQ + (dir ? (SEQ - 1 - (p - CTXL)) : (p - CTXL));
}
__device__ __forceinline__ void phase_mlstm(Frame& F) {
    const gbf16* Qb = (const gbf16*)(F.ws + WS_Q); const gbf16* Kb = (const gbf16*)(F.ws + WS_K); const gbf16* Vb = (const gbf16*)(F.ws + WS_V);
    const gf32* G = (const gf32*)(F.ws + WS_GATES);
    const int wi = F.bid, b = wi >> 5, hd = (wi >> 2) & 7, dir = (wi >> 1) & 1, half = wi & 1;
    gbf16* HD = (gbf16*)(F.ws + (dir ? WS_HB : WS_HF));
    LAS unsigned char* L = F.lds;
    LAS float* fct = (LAS float*)(L + ML_F); LAS float* frs = fct + 64; LAS float* fwi = frs + 64; LAS float* fem = fwi + 64; LAS float* fsc = fem + 64;
    LAS bf16_t* wkb = (LAS bf16_t*)(fsc + 16); LAS float* fwk = (LAS float*)(wkb + 64);
    const unsigned lane = (unsigned)F.lane; const int w = F.wave, fr = F.lane & 15, fq = F.lane >> 4;
    for (int i = F.tid; i < 144 * ML_CTP / 16; i += NTHR) *(LAS u32x4*)(L + ML_CT + 16 * i) = (u32x4){0u, 0u, 0u, 0u};
    f32x4 cst[9];
#pragma unroll
    for (int v = 0; v < 9; ++v) cst[v] = (f32x4){0.f, 0.f, 0.f, 0.f};
    float m_st = -1.0e30f;
    __syncthreads();
#pragma unroll 1
    for (int c = 0; c < 36; ++c) {
        const int p0 = 64 * c;
        u32x4 gq[2], gk[2], gv[2];
#pragma unroll
        for (int i = 0; i < 2; ++i) { const int cid = F.tid + 512 * i, row = cid >> 4, ch = cid & 15; const size_t gr = (size_t)ml_row(b, dir, p0 + row);
            gq[i] = *(const gu32x4*)(Qb + gr * 1024 + hd * 128 + 8 * ch); gk[i] = *(const gu32x4*)(Kb + gr * 1024 + hd * 128 + 8 * ch);
            gv[i] = *(const gu32x4*)(Vb + gr * 2048 + hd * 256 + half * 128 + 8 * ch); }
        if (w == 0) {
            const size_t gr = (size_t)ml_row(b, dir, p0 + F.lane);
            const float li = G[gr * 32 + (2 * dir) * 8 + hd], lf = G[gr * 32 + (2 * dir + 1) * 8 + hd];
            float bc = lf;
#pragma unroll
            for (int o = 1; o < 64; o <<= 1) { const float t = __shfl_up(bc, o); if (F.lane >= o) bc += t; }
            const float rsv = li - bc; float cm = rsv;
#pragma unroll
            for (int o = 1; o < 64; o <<= 1) { const float t = __shfl_up(cm, o); if (F.lane >= o) cm = fmaxf(cm, t); }
            const float mrow = bc + fmaxf(m_st, cm);
            const float blast = __shfl(bc, 63), cml = __shfl(cm, 63);
            const float mnew = fmaxf(blast + m_st, blast + cml);
            const float wk = fast_exp(blast + rsv - mnew);
            fct[F.lane] = bc - mrow; frs[F.lane] = rsv; fwi[F.lane] = fast_exp(bc + m_st - mrow); fem[F.lane] = fast_exp(-mrow); fwk[F.lane] = wk;
            wkb[F.lane] = (bf16_t)(cvt_pk_bf16(wk, 0.f) & 0xffffu);
            if (F.lane == 0) { fsc[0] = fast_exp(blast + m_st - mnew); fsc[1] = mnew; }
        }
        __syncthreads();
#pragma unroll
        for (int i = 0; i < 2; ++i) { const int cid = F.tid + 512 * i, row = cid >> 4, ch = cid & 15; const unsigned o = off_b(row, ch);
            *(LAS u32x4*)(L + ML_Q + o) = gq[i]; *(LAS u32x4*)(L + ML_K + o) = gk[i]; *(LAS u32x4*)(L + ML_V + o) = gv[i];
            const float wk = fwk[row]; u32x4 s;
#pragma unroll
            for (int q = 0; q < 4; ++q) s[q] = cvt_pk_bf16(bf_lo(gv[i][q]) * wk, bf_hi(gv[i][q]) * wk);
            *(LAS u32x4*)(L + ML_VW + o) = s; }
        __syncthreads();
        const float decay = fsc[0], mnew = fsc[1];
#pragma unroll
        for (int v = 0; v < 9; ++v) cst[v] *= decay;
#pragma unroll
        for (int ks = 0; ks < 2; ++ks) {
            const bf16x8 a = tr_frag(L + ML_K, lane, (unsigned)w, ks);
#pragma unroll
            for (int v = 0; v < 8; ++v) { const bf16x8 bb = tr_frag(L + ML_VW, lane, v, ks); cst[v] = __builtin_amdgcn_mfma_f32_16x16x32_bf16(a, bb, cst[v], 0, 0, 0); }
            bf16x8 ba = *(const LAS bf16x8*)(wkb + 32 * ks + 8 * fq);
            if (fr != 0) ba = (bf16x8){0, 0, 0, 0, 0, 0, 0, 0};
            cst[8] = __builtin_amdgcn_mfma_f32_16x16x32_bf16(a, ba, cst[8], 0, 0, 0);
        }
        if (c >= 4) {
            const int tt = w >> 1;
            bf16x8 qf[4];
#pragma unroll
            for (int ks = 0; ks < 4; ++ks) qf[ks] = *(const LAS bf16x8*)(L + ML_Q + rowrd16(lane, tt, ks));
            const int t = 16 * tt + fr; const float ctt = fct[t];
#pragma unroll
            for (int si = 0; si < 2; ++si) { const int st = 2 * (w & 1) + si; f32x4 acc = (f32x4){0.f, 0.f, 0.f, 0.f};
#pragma unroll
                for (int ks = 0; ks < 4; ++ks) { const bf16x8 kf = *(const LAS bf16x8*)(L + ML_K + rowrd16(lane, st, ks)); acc = __builtin_amdgcn_mfma_f32_16x16x32_bf16(kf, qf[ks], acc, 0, 0, 0); }
                const int s0 = 16 * st + 4 * fq; float sv[4];
#pragma unroll
                for (int j = 0; j < 4; ++j) sv[j] = (s0 + j <= t) ? acc[j] * fast_exp(ctt + frs[s0 + j]) : 0.f;
                u32x2 o; o.x = cvt_pk_bf16(sv[0], sv[1]); o.y = cvt_pk_bf16(sv[2], sv[3]);
                *(LAS u32x2*)(L + ML_S + t * ML_SP + s0 * 2) = o; }
        }
        __syncthreads();
        if (c >= 4) {
            const int tt = w >> 1;
            f32x4 sv[5], qc[5];
#pragma unroll
            for (int i = 0; i < 5; ++i) { sv[i] = (f32x4){0.f, 0.f, 0.f, 0.f}; qc[i] = (f32x4){0.f, 0.f, 0.f, 0.f}; }
#pragma unroll
            for (int ks = 0; ks < 2; ++ks) { const bf16x8 a = *(const LAS bf16x8*)(L + ML_S + (fr + 16 * tt) * ML_SP + (32 * ks + 8 * fq) * 2);
#pragma unroll
                for (int i = 0; i < 4; ++i) { const bf16x8 bb = tr_frag(L + ML_V, lane, 4 * (w & 1) + i, ks); sv[i] = __builtin_amdgcn_mfma_f32_16x16x32_bf16(a, bb, sv[i], 0, 0, 0); }
                const short one = (fr == 0) ? (short)0x3F80 : (short)0;
                const bf16x8 bo = (bf16x8){one, one, one, one, one, one, one, one};
                sv[4] = __builtin_amdgcn_mfma_f32_16x16x32_bf16(a, bo, sv[4], 0, 0, 0); }
#pragma unroll
            for (int ks = 0; ks < 4; ++ks) { const bf16x8 a = *(const LAS bf16x8*)(L + ML_Q + rowrd16(lane, tt, ks));
#pragma unroll
                for (int i = 0; i < 5; ++i) { const int vt = (i < 4) ? 4 * (w & 1) + i : 8;
                    const bf16x8 bb = *(const LAS bf16x8*)(L + ML_CT + (fr + 16 * vt) * ML_CTP + (32 * ks + 8 * fq) * 2); qc[i] = __builtin_amdgcn_mfma_f32_16x16x32_bf16(a, bb, qc[i], 0, 0, 0); } }
#pragma unroll
            for (int j = 0; j < 4; ++j) { const int tl = 16 * tt + 4 * fq + j; const float wi_ = fwi[tl], em = fem[tl];
                float den = sv[4][j] + wi_ * qc[4][j]; den = __shfl(den, F.lane & 48);
                const float inv = 1.0f / fmaxf(fabsf(den), em);
                const size_t rr = (size_t)(ml_row(b, dir, p0 + tl) - NCTX);
                gbf16* op = HD + rr * D + hd * 256 + half * 128 + fr;
#pragma unroll
                for (int i = 0; i < 4; ++i) { const float h = (sv[i][j] + wi_ * qc[i][j]) * inv; op[16 * (4 * (w & 1) + i)] = (bf16_t)(cvt_pk_bf16(h, 0.f) & 0xffffu); } }
        }
        __syncthreads();
#pragma unroll
        for (int v = 0; v < 9; ++v) { u32x2 o; o.x = cvt_pk_bf16(cst[v][0], cst[v][1]); o.y = cvt_pk_bf16(cst[v][2], cst[v][3]);
            *(LAS u32x2*)(L + ML_CT + (16 * v + fr) * ML_CTP + (16 * w + 4 * fq) * 2) = o; }
        m_st = mnew;
    }
    __syncthreads();
}

constexpr int N_PHASES = 19;
#ifndef PHASE_MASK
#define PHASE_MASK 0x7ffff
#endif
__global__ void __launch_bounds__(NTHR, 2) fwd(Args args) {
    extern __shared__ __attribute__((aligned(16))) unsigned char lds_raw[];
    if (threadIdx.x < 4) ((LAS unsigned*)((LAS unsigned char*)lds_raw + LDSCTL_OFF))[threadIdx.x] = 0u;
    __syncthreads();
#if !MK_PER_PHASE
    XcdBarrier bar = xcd_barrier_post((unsigned*)(args.ws + WS_CTL) + CW_BAR + args.li * 4096, (volatile LAS unsigned*)((LAS unsigned char*)lds_raw + LDSCTL_OFF));
#define SEAM(k) do { if (IN(k) && IN((k) + 1)) xcd_barrier(bar); } while (0)
#else
#define SEAM(k) do { } while (0)
#endif
    const int lo = args.ph_lo, hi = args.ph_hi;
#define IN(k) (((PHASE_MASK >> (k)) & 1) && lo <= (k) && (k) < hi)
#ifndef REPEAT_MASK
#define REPEAT_MASK 0
#endif
#ifndef REPEAT_N
#define REPEAT_N 1
#endif
#define REP(k) for (int rep_ = 0; rep_ < ((((REPEAT_MASK) >> (k)) & 1) ? (REPEAT_N) : 1); ++rep_, __syncthreads())
#define PHASE_FRAME() Frame F; gu8* ws; { gu8* w_ = (gu8*)args.ws; asm volatile("" : "+s"(w_)); int t_ = threadIdx.x; asm volatile("" : "+v"(t_)); ws = w_; \
        F.lds = (LAS unsigned char*)lds_raw; F.tid = t_; F.lane = t_ & 63; F.wave = __builtin_amdgcn_readfirstlane(t_ >> 6); F.bid = blockIdx.x; F.a = &args; F.out = (gf32*)args.out; F.ws = w_; }

    if (IN(0)) REP(0) { PHASE_FRAME(); (void)ws; phase_prologue(F); } SEAM(0);
    if (IN(1)) REP(1) { PHASE_FRAME(); (void)ws; phase_norm0(F); } SEAM(1);
    if (IN(2)) REP(2) { PHASE_FRAME(); pg8::DenseOrder S; S.init(ws + WS_H, ws + WS_CONVIN_T, NTOK, 3 * D, D, GRID, F.bid);
        EpiConvIn E{(gbf16*)(ws + WS_U), (gbf16*)(ws + WS_BM)};
        pg8::gemm_phase<EpiConvIn, pg8::DenseOrder, false>(F.lds, D, S, E); } SEAM(2);
    if (IN(3)) REP(3) { PHASE_FRAME(); (void)ws; phase_conv(F); } SEAM(3);
    if (IN(4)) REP(4) { PHASE_FRAME(); pg8::DenseOrder S; S.init(ws + WS_Z, ws + WS_CONVOUT_T, NTOK, D, D, GRID, F.bid);
        EpiResid E{INP(IN_CTX), INP(IN_X), (gf32*)(ws + WS_X), mod_ptr(F, 0, 0, 2), 0};
        pg8::gemm_phase<EpiResid, pg8::DenseOrder, false>(F.lds, D, S, E); } SEAM(4);
    if (IN(5)) REP(5) { PHASE_FRAME(); (void)ws; phase_router(F, 0, 0, NTOK / GRID); } SEAM(5);
    if (IN(6)) REP(6) { PHASE_FRAME(); (void)ws; phase_scatter(F, 0, NTOK / GRID, NTOK); } SEAM(6);
    if (IN(7)) REP(7) { PHASE_FRAME(); ExpertOrder S{stage_units(F, (const gi32x4*)(ws + RT_UNITS1) + F.bid * MAXU1, MAXU1), (const gchar*)(ws + WS_H), (const gchar*)(ws + WS_MOE0 + MOE_GU), (const gi32*)(ws + RT_TOKOF), D, 1024};
        EpiSwiglu E{(gbf16*)(ws + WS_ACT)};
        pg8::gemm_phase<EpiSwiglu, ExpertOrder, true>(F.lds, D, S, E); } SEAM(7);
    if (IN(8)) REP(8) { PHASE_FRAME(); ExpertOrder S{stage_units(F, (const gi32x4*)(ws + RT_UNITS2) + F.bid * MAXU2, MAXU2), (const gchar*)(ws + WS_ACT), (const gchar*)(ws + WS_MOE0 + MOE_DN), nullptr, ED, 2048};
        EpiDown E{(gbf16*)(ws + WS_Y), (const gf32*)(ws + RT_GATEOF)};
        pg8::gemm_phase<EpiDown, ExpertOrder, false>(F.lds, ED, S, E); } SEAM(8);
    if (IN(9)) REP(9) { PHASE_FRAME(); (void)ws; phase_combine<0>(F); } SEAM(9);
    if (IN(10)) REP(10) { PHASE_FRAME(); pg8::DenseOrder S; S.init(ws + WS_H, ws + WS_MLIN_T, NTOK, MLSTM_NP, D, GRID, F.bid);
        EpiMlstmIn E{(gbf16*)(ws + WS_Q), (gbf16*)(ws + WS_K), (gbf16*)(ws + WS_V), (gbf16*)(ws + WS_O), (gf32*)(ws + WS_GATES), INP(IN_MLGB)};
        pg8::gemm_phase<EpiMlstmIn, pg8::DenseOrder, false>(F.lds, D, S, E); } SEAM(10);
    if (IN(11)) REP(11) { PHASE_FRAME(); (void)ws; phase_mlstm(F); } SEAM(11);
    if (IN(12)) REP(12) { PHASE_FRAME(); (void)ws; phase_headnorm(F); } SEAM(12);
    if (IN(13)) REP(13) { PHASE_FRAME(); pg8::DenseOrder S; S.init(ws + WS_YIN, ws + WS_MLOUT_T, NLAT, D, D, GRID, F.bid);
        gf32* X = (gf32*)(ws + WS_X);
        EpiResid E{X, X + (size_t)NCTX * D, X, mod_ptr(F, 1, 0, 2), NCTX};
        pg8::gemm_phase<EpiResid, pg8::DenseOrder, false>(F.lds, D, S, E); } SEAM(13);
    if (IN(14)) REP(14) { PHASE_FRAME(); (void)ws; phase_router(F, 1, NCTX, NLAT / GRID); } SEAM(14);
    if (IN(15)) REP(15) { PHASE_FRAME(); (void)ws; phase_scatter(F, NCTX, NLAT / GRID, NLAT); } SEAM(15);
    if (IN(16)) REP(16) { PHASE_FRAME(); ExpertOrder S{stage_units(F, (const gi32x4*)(ws + RT_UNITS1) + F.bid * MAXU1, MAXU1), (const gchar*)(ws + WS_H), (const gchar*)(ws + WS_MOE0 + MOE_STRIDE + MOE_GU), (const gi32*)(ws + RT_TOKOF), D, 1024};
        EpiSwiglu E{(gbf16*)(ws + WS_ACT)};
        pg8::gemm_phase<EpiSwiglu, ExpertOrder, true>(F.lds, D, S, E); } SEAM(16);
    if (IN(17)) REP(17) { PHASE_FRAME(); ExpertOrder S{stage_units(F, (const gi32x4*)(ws + RT_UNITS2) + F.bid * MAXU2, MAXU2), (const gchar*)(ws + WS_ACT), (const gchar*)(ws + WS_MOE0 + MOE_STRIDE + MOE_DN), nullptr, ED, 2048};
        EpiDown E{(gbf16*)(ws + WS_Y), (const gf32*)(ws + RT_GATEOF)};
        pg8::gemm_phase<EpiDown, ExpertOrder, false>(F.lds, ED, S, E); } SEAM(17);
    if (IN(18)) REP(18) { PHASE_FRAME(); (void)ws; phase_combine<1>(F); }
#undef IN
#undef SEAM
}

extern "C" void kernel_launch(void* const* d_in, const int* in_sizes, int n_in, void* d_out, int out_size, void* d_ws, size_t ws_size, hipStream_t stream) {
    static int ready = 0;
    if (ready == 0) {
        if (n_in != N_IN || out_size != NLAT * D || ws_size < WS_END) { fprintf(stderr, "kernel_launch: unexpected problem shape (n_in %d, out %d, ws %zu)\n", n_in, out_size, ws_size); ready = -1; return; }
        if (hipFuncSetAttribute((const void*)fwd, hipFuncAttributeMaxDynamicSharedMemorySize, LDS_BYTES) != hipSuccess) { fprintf(stderr, "kernel_launch: hipFuncSetAttribute failed\n"); ready = -1; return; }
        int per_cu = 0;
        if (hipOccupancyMaxActiveBlocksPerMultiprocessor(&per_cu, (const void*)fwd, NTHR, LDS_BYTES) != hipSuccess || per_cu < 1) fprintf(stderr, "kernel_launch: note: occupancy query reports %d blocks per CU\n", per_cu);
        (void)hipGetLastError();
        ready = 1;
    }
    if (ready < 0) return;
    (void)hipMemsetAsync((char*)d_ws + WS_CTL, 0, CTL_BYTES, stream);
    Args a{};
    for (int i = 0; i < N_IN; ++i) a.in[i] = (const float*)d_in[i];
    a.out = (float*)d_out; a.ws = (unsigned char*)d_ws; a.pad = 0;
#if MK_PER_PHASE
    for (int p = 0; p < N_PHASES; ++p) { a.ph_lo = p; a.ph_hi = p + 1; a.li = 0; hipLaunchKernelGGL(fwd, dim3(GRID), dim3(NTHR), LDS_BYTES, stream, a); }
#else
    a.ph_lo = 0; a.ph_hi = N_PHASES; a.li = 0;
    hipLaunchKernelGGL(fwd, dim3(GRID), dim3(NTHR), LDS_BYTES, stream, a);
#endif
}
```

```cpp
#include <hip/hip_runtime.h>
#include <stdint.h>
#include <stdio.h>

#ifndef STAGGER_TICKS
#define STAGGER_TICKS 0
#endif
#ifndef MK_PER_PHASE
#define MK_PER_PHASE 0
#endif

#define GAS __attribute__((address_space(1)))
#define LAS __attribute__((address_space(3)))
typedef unsigned short bf16_t;
typedef short bf16x8 __attribute__((ext_vector_type(8)));
typedef short s16x4 __attribute__((ext_vector_type(4)));
typedef float f32x4 __attribute__((ext_vector_type(4)));
typedef float f32x2 __attribute__((ext_vector_type(2)));
typedef unsigned u32x4 __attribute__((ext_vector_type(4)));
typedef unsigned u32x2 __attribute__((ext_vector_type(2)));
typedef int i32x4 __attribute__((ext_vector_type(4)));
typedef long i64x2 __attribute__((ext_vector_type(2)));
typedef int i32x8 __attribute__((ext_vector_type(8)));
typedef GAS float gf32; typedef GAS bf16_t gbf16; typedef GAS int gi32; typedef GAS unsigned char gu8; typedef GAS char gchar;
typedef GAS f32x4 gf32x4; typedef GAS u32x4 gu32x4; typedef GAS u32x2 gu32x2; typedef GAS bf16x8 gbf16x8; typedef GAS i32x4 gi32x4;

constexpr int D = 2048, NBATCH = 8, SEQ = 2048, CTXL = 256;
constexpr int NCTX = NBATCH * CTXL;
constexpr int NLAT = NBATCH * SEQ;
constexpr int NTOK = NCTX + NLAT;
constexpr int NE = 64, TOPK = 6, ED = 512;
constexpr int ADA_N = 6 * D;
constexpr int MLSTM_N = 6176, MLSTM_NP = 6400;
constexpr int NWAVES = 8, NTHR = 512, GRID = 256;
constexpr int SH_BASE = 126976;
constexpr int NSLOT = SH_BASE + NTOK;
constexpr float EPS = 1e-6f;

constexpr size_t MiB = 1u << 20, KiB = 1024;
constexpr size_t WS_CTL = 0, CTL_BYTES = 64 * KiB;
constexpr size_t WS_MOD = 1 * MiB;
constexpr size_t WS_RT = 2 * MiB;
constexpr size_t RT_HIST = WS_RT;
constexpr size_t RT_EINFO = WS_RT + 64 * KiB;
constexpr size_t RT_SELIDX = WS_RT + 128 * KiB;
constexpr size_t RT_SELGATE = WS_RT + 640 * KiB;
constexpr size_t RT_SELRANK = WS_RT + 1152 * KiB;
constexpr size_t RT_SLOTOF = WS_RT + 1664 * KiB;
constexpr size_t RT_TOKOF = WS_RT + 2176 * KiB;
constexpr size_t RT_GATEOF = WS_RT + 2816 * KiB;
constexpr size_t RT_UNITS1 = WS_RT + 3584 * KiB;
constexpr size_t RT_UNITS2 = WS_RT + 3840 * KiB;
constexpr int MAXU1 = 64, MAXU2 = 128;
constexpr size_t WS_GATES = 10 * MiB;
constexpr size_t WS_CONVIN_T = 13 * MiB;
constexpr size_t WS_CONVOUT_T = 37 * MiB;
constexpr size_t WS_MLIN_T = 45 * MiB;
constexpr size_t WS_MLOUT_T = 70 * MiB;
constexpr size_t WS_MOE0 = 78 * MiB, MOE_STRIDE = 392 * MiB;
constexpr size_t MOE_GU = 0, MOE_DN = 260 * MiB, MOE_RT = 390 * MiB;
constexpr size_t WS_H = 862 * MiB;
constexpr size_t WS_X = 934 * MiB;
constexpr size_t WS_ACT = 1078 * MiB;
constexpr size_t WS_Y = 1220 * MiB;
constexpr size_t WS_U = WS_Y, WS_BM = WS_Y + 72 * MiB, WS_Z = WS_Y + 144 * MiB;
constexpr size_t WS_Q = WS_Y, WS_K = WS_Y + 36 * MiB, WS_V = WS_Y + 72 * MiB, WS_O = WS_Y + 144 * MiB;
constexpr size_t WS_HF = WS_Y + 216 * MiB, WS_HB = WS_Y + 280 * MiB, WS_YIN = WS_Y + 344 * MiB;
constexpr size_t WS_H8 = 1788 * MiB;
constexpr size_t WS_END = 1824 * MiB;
constexpr float DN_WSCALE = 32.0f, ACT_SCALE = 16.0f;
constexpr float GU_WSCALE = 64.0f;
constexpr int CW_BAR = 4096;
constexpr int CW_P0CTR = 64;

constexpr int RING_BYTES = 131072;
constexpr int LDSCTL_OFF = 150 * 1024;
constexpr int LDS_BYTES = 151 * 1024;

#define LDS_WAIT() asm volatile("s_waitcnt lgkmcnt(0)" ::: "memory")
#define VM_WAIT() asm volatile("s_waitcnt vmcnt(0)" ::: "memory")
__device__ __forceinline__ unsigned cvt_pk_bf16(float lo, float hi) { unsigned r; asm volatile("v_cvt_pk_bf16_f32 %0, %1, %2" : "=v"(r) : "v"(lo), "v"(hi)); return r; }
__device__ __forceinline__ unsigned pk4_fp8(const f32x4 v) { int w = 0;
    w = __builtin_amdgcn_cvt_pk_fp8_f32(__builtin_amdgcn_fmed3f(v[0], -448.0f, 448.0f), __builtin_amdgcn_fmed3f(v[1], -448.0f, 448.0f), w, false);
    w = __builtin_amdgcn_cvt_pk_fp8_f32(__builtin_amdgcn_fmed3f(v[2], -448.0f, 448.0f), __builtin_amdgcn_fmed3f(v[3], -448.0f, 448.0f), w, true); return (unsigned)w; }
__device__ __forceinline__ void acc4_fp8(f32x4& m, unsigned w) { const f32x2 lo = __builtin_amdgcn_cvt_pk_f32_fp8((int)w, false), hi = __builtin_amdgcn_cvt_pk_f32_fp8((int)w, true); m[0] += lo[0]; m[1] += lo[1]; m[2] += hi[0]; m[3] += hi[1]; }
__device__ __forceinline__ void acc4_fp8s(f32x4& m, unsigned w, float g) { const f32x2 lo = __builtin_amdgcn_cvt_pk_f32_fp8((int)w, false), hi = __builtin_amdgcn_cvt_pk_f32_fp8((int)w, true); m[0] += g * lo[0]; m[1] += g * lo[1]; m[2] += g * hi[0]; m[3] += g * hi[1]; }
__device__ __forceinline__ float bf_lo(unsigned u) { return __uint_as_float(u << 16); }
__device__ __forceinline__ float bf_hi(unsigned u) { return __uint_as_float(u & 0xffff0000u); }
template <int CTRL> __device__ __forceinline__ float dpp_mov(float v) { return __int_as_float(__builtin_amdgcn_update_dpp(0, __float_as_int(v), CTRL, 0xf, 0xf, true)); }
__device__ __forceinline__ float wave_sum(float v) {
    v += dpp_mov<0xB1>(v); v += dpp_mov<0x4E>(v); v += dpp_mov<0x141>(v); v += dpp_mov<0x140>(v);
    const int b = __float_as_int(v);
    return (__int_as_float(__builtin_amdgcn_readlane(b, 0)) + __int_as_float(__builtin_amdgcn_readlane(b, 16))) + (__int_as_float(__builtin_amdgcn_readlane(b, 32)) + __int_as_float(__builtin_amdgcn_readlane(b, 48)));
}
__device__ __forceinline__ float fast_exp(float x) { return __builtin_amdgcn_exp2f(x * 1.44269504088896341f); }
__device__ __forceinline__ float sigmoidf_(float x) { return 1.0f / (1.0f + fast_exp(-x)); }
__device__ __forceinline__ float siluf_(float x) { return x / (1.0f + fast_exp(-x)); }

#define XB_TMO      128
#define XB_XCNT(j)  (256  + 64 * (j))
#define XB_XSUB(j)  (1280 + 64 * (j))
#define XB_XGEN(j)  (2304 + 64 * (j))
#define XB_TOP      3328
#define XB_TOPGEN   3392
#define XCD_BAR_WORDS 3456
#define XB_SPIN_CAP (1u << 22)

__device__ __forceinline__ unsigned xb_ld(unsigned* p)              { return __hip_atomic_load(p, __ATOMIC_RELAXED, __HIP_MEMORY_SCOPE_AGENT); }
__device__ __forceinline__ unsigned xb_add(unsigned* p, unsigned v) { return __hip_atomic_fetch_add(p, v, __ATOMIC_RELAXED, __HIP_MEMORY_SCOPE_AGENT); }
__device__ __forceinline__ unsigned xb_xcc_id() { return (unsigned)__builtin_amdgcn_s_getreg((3 << 11) | 20) & 0xFu; }
#define XB_SPIN(cond, bar) do { unsigned _sp = 0; while (cond) { __builtin_amdgcn_s_sleep(1); \
    if ((++_sp & 255u) == 0u) { if (xb_ld(&(bar)[XB_TMO])) break; if (_sp > XB_SPIN_CAP) { atomicAdd(&(bar)[XB_TMO], 1u); break; } } } } while (0)

struct XcdBarrier { unsigned* bar; unsigned x; volatile LAS unsigned* st; };

__device__ __forceinline__ XcdBarrier xcd_barrier_post(unsigned* bar, volatile LAS unsigned* st) {
    XcdBarrier b; b.bar = bar; b.x = xb_xcc_id(); b.st = st;
    if (threadIdx.x == 0) (void)xb_add(&bar[XB_XCNT(b.x)], 1u);
    return b;
}
__device__ __forceinline__ void xcd_barrier_complete(unsigned* bar, unsigned x, unsigned& nloc, unsigned& nx) {
    const unsigned G = gridDim.x * gridDim.y * gridDim.z;
    unsigned sum, cnt, mine, sp = 0u;
    for (;;) {
        sum = 0u; cnt = 0u; mine = 0u;
#pragma unroll
        for (unsigned j = 0; j < 16; ++j) { const unsigned c = xb_ld(&bar[XB_XCNT(j)]); sum += c; cnt += (c > 0u) ? 1u : 0u; mine = (j == x) ? c : mine; }
        if (sum == G) break;
        __builtin_amdgcn_s_sleep(1);
        if ((++sp & 255u) == 0u) { if (xb_ld(&bar[XB_TMO])) break; if (sp > XB_SPIN_CAP) { atomicAdd(&bar[XB_TMO], 1u); break; } }
    }
    nloc = mine > 0u ? mine : 1u; nx = cnt > 0u ? cnt : 1u;
}
__device__ __forceinline__ void xcd_barrier(const XcdBarrier& b) {
    asm volatile("s_waitcnt vmcnt(0)" ::: "memory");
    __syncthreads();
    if (threadIdx.x == 0) {
        unsigned* bar = b.bar;
        __builtin_amdgcn_s_waitcnt(0);
        unsigned nloc = b.st[0], nx = b.st[1];
        if (nloc == 0u) { xcd_barrier_complete(bar, b.x, nloc, nx); b.st[0] = nloc; b.st[1] = nx; }
        const unsigned old = xb_add(&bar[XB_XSUB(b.x)], 1u);
        const unsigned gen = old / nloc;
        if (old + 1u == (gen + 1u) * nloc) {
            __builtin_amdgcn_fence(__ATOMIC_RELEASE, "agent");
            asm volatile("s_waitcnt vmcnt(0)" ::: "memory");
            const unsigned og = xb_add(&bar[XB_TOP], 1u);
            const unsigned tg = og / nx;
            if (og + 1u == (tg + 1u) * nx) xb_add(&bar[XB_TOPGEN], 1u);
            else XB_SPIN(xb_ld(&bar[XB_TOPGEN]) == tg, bar);
            __builtin_amdgcn_fence(__ATOMIC_ACQUIRE, "agent");
            xb_add(&bar[XB_XGEN(b.x)], 1u);
            asm volatile("s_waitcnt vmcnt(0)" ::: "memory");
        } else {
            XB_SPIN(xb_ld(&bar[XB_XGEN(b.x)]) == gen, bar);
            __builtin_amdgcn_fence(__ATOMIC_ACQUIRE, "agent");
            asm volatile("s_waitcnt vmcnt(0)" ::: "memory");
        }
    }
    __syncthreads();
}

namespace pg8 {
constexpr int BM = 256, BK = 64, HALF = 128, HTB = HALF * BK * 2, STAGE_BYTES = 8 * HTB, NXCD = 8, WGM = 8;
__host__ __device__ __forceinline__ int lds_byte(int r, int c) { const int st = (r >> 4) * 2 + (c >> 5), rr = r & 15, cc = c & 31, ob = rr * 64 + cc * 2; return st * 1024 + (ob ^ (((ob >> 9) & 1) << 5)); }
__host__ __device__ __forceinline__ void stage_rc(int b, int& R, int& C) { const int st = b / 1024, sb = b % 1024, swz = sb ^ (((sb >> 9) & 1) << 5); R = (st >> 1) * 16 + swz / 64; C = (st & 1) * 32 + (swz % 64) / 2; }
__host__ __device__ __forceinline__ int perm32(int rho) { const int n = rho >> 4, i = rho & 15; return 8 * (i >> 2) + 4 * n + (i & 3); }

struct Unit { int pm, pn, e, row0; };

struct DenseOrder {
    int nM, nN, nwg, G, c; const gchar* A; const gchar* Bt; size_t tstep;
    __device__ void init(const GAS void* A_, const GAS void* Bt_, int M, int N, int K, int G_, int c_) { A = (const gchar*)A_; Bt = (const gchar*)Bt_; nM = M / BM; nN = N / BM; nwg = nM * nN; G = G_; c = c_; tstep = (size_t)BM * K * 2; }
    __device__ __forceinline__ bool next(int i, Unit& u) const {
        const long L = (long)i * G + c; if (L >= nwg) return false;
        int wgid = (int)L; { const int q = nwg / NXCD, r = nwg % NXCD, xcd = wgid % NXCD, off = wgid / NXCD; wgid = (xcd < r ? xcd * (q + 1) : r * (q + 1) + (xcd - r) * q) + off; }
        const int nig = WGM * nN, gid = wgid / nig, fm = gid * WGM, gsz = (nM - fm) < WGM ? (nM - fm) : WGM;
        u.pm = fm + ((wgid % nig) % gsz); u.pn = (wgid % nig) / gsz; u.e = 0; u.row0 = u.pm * BM; return true;
    }
    __device__ __forceinline__ const gchar* a_base(const Unit& u) const { return A + (size_t)u.pm * tstep; }
    __device__ __forceinline__ const gchar* b_base(const Unit& u) const { return Bt + (size_t)u.pn * tstep; }
    __device__ __forceinline__ int gather_row(const Unit&, int) const { return 0; }
};

template <class Epi, class Sched, bool GATHER, bool FP8 = false>
__device__ __forceinline__ void gemm_phase(LAS unsigned char* lds, const int K, const Sched& S, const Epi& E) {
    const int tid = threadIdx.x, wid = __builtin_amdgcn_readfirstlane(tid >> 6), lane = tid & 63, wr = wid >> 2, wc = wid & 3, fr = lane & 15, fq = lane >> 4;
    const int nt = K / BK;
    int Rst[2], Cst[2];
    unsigned voffA[2], voffB[2];
#pragma unroll
    for (int i = 0; i < 2; ++i) { int R, C; stage_rc(tid * 16 + i * 8192, R, C); const int Rb = Epi::PERM ? ((R & ~31) + perm32(R & 31)) : R;
        Rst[i] = R; Cst[i] = C; voffA[i] = (unsigned)(R * K + C) * 2u; voffB[i] = (unsigned)(Rb * K + C) * 2u; }
    const size_t kstep = (size_t)(BK * 2);
    const size_t hstep = (size_t)HALF * K * 2;
    const unsigned ldsw = (unsigned)wid * 1024u;
    const int aoff = lds_byte(wr * 64 + fr, fq * 8), boff = lds_byte(wc * 32 + fr, fq * 8);
#define PG8_SA(b, h) (((b) * 2 + (h)) * HTB)
#define PG8_SB(b, h) ((4 + (b) * 2 + (h)) * HTB)
#define PG8_STAGE(bufoff, gbase, voff) do { _Pragma("unroll") for (int _i = 0; _i < 2; ++_i) \
        __builtin_amdgcn_global_load_lds((const GAS unsigned*)((const gchar*)(gbase) + (voff)[_i]), (LAS unsigned*)(lds + (bufoff) + ldsw + _i * 8192), 16, 0, 0); } while (0)
#define PG8_LDA(dst, b, h) do { _Pragma("unroll") for (int m = 0; m < 4; ++m) _Pragma("unroll") for (int k = 0; k < 2; ++k) dst[m][k] = *(const LAS bf16x8*)(lds + PG8_SA(b, h) + aoff + m * 2048 + k * 1024); } while (0)
#define PG8_LDB(dst, b, h) do { _Pragma("unroll") for (int n = 0; n < 2; ++n) _Pragma("unroll") for (int k = 0; k < 2; ++k) dst[n][k] = *(const LAS bf16x8*)(lds + PG8_SB(b, h) + boff + n * 2048 + k * 1024); } while (0)
#define PG8_CAT(x) __builtin_shufflevector(__builtin_bit_cast(i32x4, (x)[0]), __builtin_bit_cast(i32x4, (x)[1]), 0, 1, 2, 3, 4, 5, 6, 7)
#define PG8_MMA(ai, bj, At, Bt) do { __builtin_amdgcn_s_setprio(1); \
        if constexpr (FP8) { i32x8 _a8[4], _b8[2]; _Pragma("unroll") for (int m = 0; m < 4; ++m) _a8[m] = PG8_CAT(At[m]); _Pragma("unroll") for (int n = 0; n < 2; ++n) _b8[n] = PG8_CAT(Bt[n]); \
            _Pragma("unroll") for (int m = 0; m < 4; ++m) _Pragma("unroll") for (int n = 0; n < 2; ++n) \
                asm volatile("v_mfma_scale_f32_16x16x128_f8f6f4 %0, %1, %2, %0, %3, %4 op_sel_hi:[0,0,0]" : "+v"(acc[ai][bj][m][n]) : "v"(_b8[n]), "v"(_a8[m]), "v"(mx_sc[bj]), "v"(mx_one)); } \
        else { _Pragma("unroll") for (int m = 0; m < 4; ++m) _Pragma("unroll") for (int n = 0; n < 2; ++n) _Pragma("unroll") for (int k = 0; k < 2; ++k) \
            acc[ai][bj][m][n] = __builtin_amdgcn_mfma_f32_16x16x32_bf16(Bt[n][k], At[m][k], acc[ai][bj][m][n], 0, 0, 0); } __builtin_amdgcn_s_setprio(0); } while (0)
#define PG8_MMAZ(ai, bj, At, Bt) do { __builtin_amdgcn_s_setprio(1); \
        if constexpr (FP8) { i32x8 _a8[4], _b8[2]; _Pragma("unroll") for (int m = 0; m < 4; ++m) _a8[m] = PG8_CAT(At[m]); _Pragma("unroll") for (int n = 0; n < 2; ++n) _b8[n] = PG8_CAT(Bt[n]); \
            _Pragma("unroll") for (int m = 0; m < 4; ++m) _Pragma("unroll") for (int n = 0; n < 2; ++n) \
                asm volatile("v_mfma_scale_f32_16x16x128_f8f6f4 %0, %1, %2, 0, %3, %4 op_sel_hi:[0,0,0]" : "=&v"(acc[ai][bj][m][n]) : "v"(_b8[n]), "v"(_a8[m]), "v"(mx_sc[bj]), "v"(mx_one)); } \
        else { _Pragma("unroll") for (int m = 0; m < 4; ++m) _Pragma("unroll") for (int n = 0; n < 2; ++n) { \
            acc[ai][bj][m][n] = __builtin_amdgcn_mfma_f32_16x16x32_bf16(Bt[n][0], At[m][0], (f32x4){0.f, 0.f, 0.f, 0.f}, 0, 0, 0); \
            acc[ai][bj][m][n] = __builtin_amdgcn_mfma_f32_16x16x32_bf16(Bt[n][1], At[m][1], acc[ai][bj][m][n], 0, 0, 0); } } __builtin_amdgcn_s_setprio(0); } while (0)
#define PG8_MMA1(ai, bj, At, Bt) do { if (FP8 && t == 0) PG8_MMAZ(ai, bj, At, Bt); else PG8_MMA(ai, bj, At, Bt); } while (0)
#define PG8_WAIT_V(n) asm volatile("s_waitcnt vmcnt(" #n ")" ::: "memory")
#define PG8_WAIT_L(n) asm volatile("s_waitcnt lgkmcnt(" #n ")" ::: "memory")
#define PG8_BAR __builtin_amdgcn_s_barrier()
#define PG8_SCHED __builtin_amdgcn_sched_barrier(0)
    Unit cur, nxt; int ui = 0;
    if (!S.next(0, cur)) return;
#if STAGGER_TICKS
    {
      const unsigned long long t0 = __builtin_amdgcn_s_memrealtime(); const unsigned long long dt = (unsigned long long)((blockIdx.x >> 3) & 3) * STAGGER_TICKS;
      while (__builtin_amdgcn_s_memrealtime() - t0 < dt) __builtin_amdgcn_s_sleep(8); }
#endif
    f32x4 acc[2][2][4][2];
#pragma unroll
    for (int a = 0; a < 2; ++a)
#pragma unroll
        for (int b = 0; b < 2; ++b)
#pragma unroll
            for (int m = 0; m < 4; ++m)
#pragma unroll
                for (int n = 0; n < 2; ++n) acc[a][b][m][n] = (f32x4){0.f, 0.f, 0.f, 0.f};
    bf16x8 At[4][2], B0[2][2], B1[2][2]; int mx_one = 0x7f7f7f7f; asm volatile("" : "+v"(mx_one));
    int mx_sc[2] = {0x7f7f7f7f, 0x7f7f7f7f};
    if constexpr (FP8) { mx_sc[0] = 0x01010101 * (127 + Epi::MXE0); mx_sc[1] = 0x01010101 * (127 + Epi::MXE1); asm volatile("" : "+v"(mx_sc[0]), "+v"(mx_sc[1])); }
    const gchar* cA = S.a_base(cur); const gchar* cB = S.b_base(cur);
    unsigned vc0[2], vc1[2], vn0[2], vn1[2];
    if constexpr (GATHER) {
#pragma unroll
        for (int i = 0; i < 2; ++i) { vc0[i] = ((unsigned)S.gather_row(cur, Rst[i]) * (unsigned)K + (unsigned)Cst[i]) * 2u; vc1[i] = ((unsigned)S.gather_row(cur, HALF + Rst[i]) * (unsigned)K + (unsigned)Cst[i]) * 2u; vn0[i] = vc0[i]; vn1[i] = vc1[i]; }
    } else {
#pragma unroll
        for (int i = 0; i < 2; ++i) { vc0[i] = voffA[i]; vc1[i] = voffA[i] + (unsigned)hstep; vn0[i] = vc0[i]; vn1[i] = vc1[i]; }
    }
    PG8_STAGE(PG8_SB(0, 0), cB, voffB); PG8_STAGE(PG8_SA(0, 0), cA, vc0); PG8_STAGE(PG8_SB(0, 1), cB + hstep, voffB); PG8_STAGE(PG8_SA(0, 1), cA, vc1);
    if (wr == 1) PG8_BAR;
    PG8_WAIT_V(4); PG8_BAR;
    PG8_STAGE(PG8_SB(1, 0), cB + kstep, voffB); PG8_STAGE(PG8_SA(1, 0), cA + kstep, vc0); PG8_STAGE(PG8_SB(1, 1), cB + hstep + kstep, voffB);
    PG8_WAIT_V(6); PG8_BAR;
    for (;;) {
        const bool has_next = S.next(ui + 1, nxt);
        const gchar* nA = has_next ? S.a_base(nxt) : cA; const gchar* nB = has_next ? S.b_base(nxt) : cB;
        for (int t = 0; t < nt; t += 2) {
            const bool last = (t == nt - 2);
            const gchar* a1 = cA + (size_t)(t + 1) * kstep;
            const gchar* a2 = last ? nA : cA + (size_t)(t + 2) * kstep; const gchar* b2 = last ? nB : cB + (size_t)(t + 2) * kstep;
            const gchar* a3 = a2 + kstep; const gchar* b3 = b2 + kstep;
            unsigned s0[2], s1[2];
            if constexpr (GATHER) {
                if (last && has_next) {
#pragma unroll
                    for (int i = 0; i < 2; ++i) { vn0[i] = ((unsigned)S.gather_row(nxt, Rst[i]) * (unsigned)K + (unsigned)Cst[i]) * 2u; vn1[i] = ((unsigned)S.gather_row(nxt, HALF + Rst[i]) * (unsigned)K + (unsigned)Cst[i]) * 2u; }
                }
#pragma unroll
                for (int i = 0; i < 2; ++i) { s0[i] = last ? vn0[i] : vc0[i]; s1[i] = last ? vn1[i] : vc1[i]; }
            } else {
#pragma unroll
                for (int i = 0; i < 2; ++i) { s0[i] = vc0[i]; s1[i] = vc1[i]; }
            }
            PG8_LDB(B0, 0, 0); PG8_SCHED; PG8_LDA(At, 0, 0); PG8_STAGE(PG8_SA(1, 1), a1, vc1);
            PG8_WAIT_L(8); PG8_BAR; PG8_WAIT_L(0); PG8_MMA1(0, 0, At, B0); PG8_BAR; PG8_SCHED;
            PG8_LDB(B1, 0, 1); PG8_STAGE(PG8_SB(0, 0), b2, voffB);
            PG8_BAR; PG8_WAIT_L(0); PG8_MMA1(0, 1, At, B1); PG8_BAR;
            PG8_LDA(At, 0, 1); PG8_STAGE(PG8_SA(0, 0), a2, s0);
            PG8_BAR; PG8_WAIT_L(0); PG8_MMA1(1, 0, At, B0); PG8_BAR; PG8_SCHED;
            PG8_STAGE(PG8_SB(0, 1), b2 + hstep, voffB);
            PG8_WAIT_V(6); PG8_BAR; PG8_MMA1(1, 1, At, B1); PG8_BAR;
            PG8_LDB(B0, 1, 0); PG8_SCHED; PG8_LDA(At, 1, 0); PG8_STAGE(PG8_SA(0, 1), a2, s1);
            PG8_WAIT_L(8); PG8_BAR; PG8_WAIT_L(0); PG8_MMA(0, 0, At, B0); PG8_BAR; PG8_SCHED;
            PG8_LDB(B1, 1, 1); PG8_STAGE(PG8_SB(1, 0), b3, voffB);
            PG8_BAR; PG8_WAIT_L(0); PG8_MMA(0, 1, At, B1); PG8_BAR;
            PG8_LDA(At, 1, 1); PG8_STAGE(PG8_SA(1, 0), a3, s0);
            PG8_BAR; PG8_WAIT_L(0); PG8_MMA(1, 0, At, B0); PG8_BAR; PG8_SCHED;
            PG8_STAGE(PG8_SB(1, 1), b3 + hstep, voffB);
            PG8_WAIT_V(6); PG8_BAR; PG8_MMA(1, 1, At, B1); PG8_BAR;
        }
        if constexpr (FP8) {
            asm volatile("s_nop 15\n\ts_nop 3" : "+v"(acc[1][1][0][0]), "+v"(acc[1][1][0][1]), "+v"(acc[1][1][1][0]), "+v"(acc[1][1][1][1]), "+v"(acc[1][1][2][0]), "+v"(acc[1][1][2][1]), "+v"(acc[1][1][3][0]), "+v"(acc[1][1][3][1])); }
        E(acc, cur, wr, wc, fr, fq);
        if (!has_next) break;
        if constexpr (!FP8) {
#pragma unroll
            for (int a = 0; a < 2; ++a)
#pragma unroll
                for (int b = 0; b < 2; ++b)
#pragma unroll
                    for (int m = 0; m < 4; ++m)
#pragma unroll
                        for (int n = 0; n < 2; ++n) acc[a][b][m][n] = (f32x4){0.f, 0.f, 0.f, 0.f}; }
        cur = nxt; cA = nA; cB = nB; ++ui;
#pragma unroll
        for (int i = 0; i < 2; ++i) { vc0[i] = vn0[i]; vc1[i] = vn1[i]; }
    }
    PG8_WAIT_V(0);
    if (wr == 0) PG8_BAR;
    PG8_BAR;
#undef PG8_SA
#undef PG8_SB
#undef PG8_STAGE
#undef PG8_LDA
#undef PG8_LDB
#undef PG8_MMA
#undef PG8_MMAZ
#undef PG8_MMA1
#undef PG8_CAT
#undef PG8_WAIT_V
#undef PG8_WAIT_L
#undef PG8_BAR
#undef PG8_SCHED
}
}
using pg8::Unit;

enum { IN_X = 0, IN_C, IN_CTX, IN_CCTX, IN_ADAW, IN_ADAB, IN_NMIXW, IN_NFFNW, IN_CONVIN, IN_CONVDW, IN_CONVOUT, IN_MLIN, IN_MLGB, IN_MLNW, IN_MLOUT,
       IN_RW, IN_RB, IN_EG, IN_EU, IN_ED, IN_SG, IN_SU, IN_SD, IN_FNW, N_IN };
struct Args { const float* in[N_IN]; float* out; unsigned char* ws; int ph_lo, ph_hi, li, pad; };

#define INP(i) ((const gf32*)F.a->in[i])
struct Frame {
    LAS unsigned char* lds;
    int tid, lane, wave, bid;
    const Args* a; gf32* out; gu8* ws;
};

__device__ __forceinline__ const gf32* mod_ptr(const Frame& F, int layer, int mr, int chunk) { return (const gf32*)(F.ws + WS_MOD) + ((size_t)(layer * 9 + mr) * ADA_N + (size_t)chunk * D); }
__device__ __forceinline__ int mod_row(int r) { return r < NCTX ? 8 : ((r - NCTX) >> 11); }

struct EpiConvIn {
    static constexpr bool PERM = true; static constexpr int MXE0 = 0, MXE1 = 0;
    gbf16* U; gbf16* BMt;
    __device__ __forceinline__ void operator()(const f32x4 (&acc)[2][2][4][2], const Unit& u, int wr, int wc, int fr, int fq) const {
        const int row0 = u.pm * 256 + wr * 64 + fr;
        if (u.pn < 16) {
            const int col = u.pn * 128 + wc * 32 + 8 * fq;
#pragma unroll
            for (int ai = 0; ai < 2; ++ai)
#pragma unroll
                for (int m = 0; m < 4; ++m) {
                    const f32x4 a0 = acc[ai][0][m][0] * acc[ai][1][m][0], a1 = acc[ai][0][m][1] * acc[ai][1][m][1];
                    u32x4 w; w.x = cvt_pk_bf16(a0[0], a0[1]); w.y = cvt_pk_bf16(a0[2], a0[3]); w.z = cvt_pk_bf16(a1[0], a1[1]); w.w = cvt_pk_bf16(a1[2], a1[3]);
                    *(gu32x4*)(U + (size_t)(row0 + ai * 128 + m * 16) * D + col) = w; }
        } else {
            const int col = (u.pn - 16) * 256 + wc * 32 + 8 * fq;
#pragma unroll
            for (int ai = 0; ai < 2; ++ai)
#pragma unroll
                for (int m = 0; m < 4; ++m)
#pragma unroll
                    for (int bj = 0; bj < 2; ++bj) {
                        const f32x4 a0 = acc[ai][bj][m][0], a1 = acc[ai][bj][m][1];
                        u32x4 w; w.x = cvt_pk_bf16(a0[0], a0[1]); w.y = cvt_pk_bf16(a0[2], a0[3]); w.z = cvt_pk_bf16(a1[0], a1[1]); w.w = cvt_pk_bf16(a1[2], a1[3]);
                        *(gu32x4*)(BMt + (size_t)(row0 + ai * 128 + m * 16) * D + col + bj * 128) = w; }
        }
    }
};
struct EpiResid {
    static constexpr bool PERM = false; static constexpr int MXE0 = 0, MXE1 = 0;
    const gf32* base_ctx; const gf32* base_lat; gf32* X; const gf32* gmod; int row_off;
    __device__ __forceinline__ void operator()(const f32x4 (&acc)[2][2][4][2], const Unit& u, int wr, int wc, int fr, int fq) const {
        const int R0 = row_off + u.pm * 256;
        const gf32* base = (R0 < NCTX) ? base_ctx + (size_t)R0 * D : base_lat + (size_t)(R0 - NCTX) * D;
        const gf32* g = gmod + (size_t)mod_row(R0) * ADA_N;
        gf32* o = X + (size_t)R0 * D;
        const int rl0 = wr * 64 + fr, col0 = u.pn * 256 + wc * 32 + 4 * fq;
        f32x4 gv[2][2];
#pragma unroll
        for (int bj = 0; bj < 2; ++bj)
#pragma unroll
            for (int n = 0; n < 2; ++n) gv[bj][n] = *(const gf32x4*)(g + col0 + bj * 128 + n * 16);
#pragma unroll
        for (int ah = 0; ah < 4; ++ah) { const int ai = ah >> 1, m0 = (ah & 1) * 2;
            f32x4 bv[2][2][2];
#pragma unroll
            for (int mm = 0; mm < 2; ++mm) { const size_t ro = (size_t)(rl0 + ai * 128 + (m0 + mm) * 16) * D + col0;
#pragma unroll
                for (int bj = 0; bj < 2; ++bj)
#pragma unroll
                    for (int n = 0; n < 2; ++n) bv[mm][bj][n] = *(const gf32x4*)(base + ro + bj * 128 + n * 16); }
#pragma unroll
            for (int mm = 0; mm < 2; ++mm) { const size_t ro = (size_t)(rl0 + ai * 128 + (m0 + mm) * 16) * D + col0;
#pragma unroll
                for (int bj = 0; bj < 2; ++bj)
#pragma unroll
                    for (int n = 0; n < 2; ++n) *(gf32x4*)(o + ro + bj * 128 + n * 16) = bv[mm][bj][n] + gv[bj][n] * acc[ai][bj][m0 + mm][n]; } }
    }
};
__device__ __forceinline__ float softcap_gate(float g) {
    const float e = fast_exp(-2.0f * g * (1.0f / 15.0f)); return 15.0f * (1.0f - e) / (1.0f + e);
}
__device__ __forceinline__ float log_sigmoid_(float g) { return fminf(g, 0.0f) - __logf(1.0f + fast_exp(-fabsf(g))); }
struct EpiMlstmIn {
    static constexpr bool PERM = true; static constexpr int MXE0 = 0, MXE1 = 0;
    gbf16 *Q, *Kb, *V, *O;
    __device__ __forceinline__ void operator()(const f32x4 (&acc)[2][2][4][2], const Unit& u, int wr, int wc, int fr, int fq) const {
        const int row0 = u.pm * 256 + wr * 64 + fr;
        {
            gbf16* dst; int ld, ct; float sc = 1.0f;
            if (u.pn < 4) { dst = Q; ld = 1024; ct = u.pn; } else if (u.pn < 8) { dst = Kb; ld = 1024; ct = u.pn - 4; sc = 0.08838834764831845f; }
            else if (u.pn < 16) { dst = V; ld = 2048; ct = u.pn - 8; } else { dst = O; ld = 2048; ct = u.pn - 16; }
            const int col = ct * 256 + wc * 32 + 8 * fq;
#pragma unroll
            for (int ai = 0; ai < 2; ++ai)
#pragma unroll
                for (int m = 0; m < 4; ++m)
#pragma unroll
                    for (int bj = 0; bj < 2; ++bj) {
                        const f32x4 a0 = acc[ai][bj][m][0] * sc, a1 = acc[ai][bj][m][1] * sc;
                        u32x4 w; w.x = cvt_pk_bf16(a0[0], a0[1]); w.y = cvt_pk_bf16(a0[2], a0[3]); w.z = cvt_pk_bf16(a1[0], a1[1]); w.w = cvt_pk_bf16(a1[2], a1[3]);
                        *(gu32x4*)(dst + (size_t)(row0 + ai * 128 + m * 16) * ld + col + bj * 128) = w; }
        }
    }
};
struct EpiSwiglu {
    static constexpr bool PERM = true;
    static constexpr int MXE0 = -6, MXE1 = -2;
    gu8* ACT;
    __device__ __forceinline__ void operator()(const f32x4 (&acc)[2][2][4][2], const Unit& u, int wr, int wc, int fr, int fq) const {
        const int row0 = u.row0 + wr * 64 + fr, col = u.pn * 128 + wc * 32 + 8 * fq;
#pragma unroll
        for (int ai = 0; ai < 2; ++ai)
#pragma unroll
            for (int m = 0; m < 4; ++m) {
                f32x4 a0, a1;
#pragma unroll
                for (int j = 0; j < 4; ++j) { a0[j] = siluf_(acc[ai][0][m][0][j]) * acc[ai][1][m][0][j]; a1[j] = siluf_(acc[ai][0][m][1][j]) * acc[ai][1][m][1][j]; }
                u32x2 w; w.x = pk4_fp8(a0); w.y = pk4_fp8(a1);
                *(gu32x2*)(ACT + (size_t)(row0 + ai * 128 + m * 16) * ED + col) = w; }
    }
};
struct EpiDown {
    static constexpr bool PERM = true;
    static constexpr int MXE0 = -9, MXE1 = -9;
    gu8* Y;
    __device__ __forceinline__ void operator()(const f32x4 (&acc)[2][2][4][2], const Unit& u, int wr, int wc, int fr, int fq) const {
        const int row0 = u.row0 + wr * 64 + fr, col = u.pn * 256 + wc * 64 + 16 * fq;
#pragma unroll
        for (int ai = 0; ai < 2; ++ai)
#pragma unroll
            for (int m = 0; m < 4; ++m) { const int slot = row0 + ai * 128 + m * 16;
                u32x4 w; w.x = pk4_fp8(acc[ai][0][m][0]); w.y = pk4_fp8(acc[ai][0][m][1]); w.z = pk4_fp8(acc[ai][1][m][0]); w.w = pk4_fp8(acc[ai][1][m][1]);
                *(gu32x4*)(Y + (size_t)slot * D + col) = w; }
    }
};

constexpr int LDS_UNITS = RING_BYTES;
struct ExpertOrder {
    const LAS i32x4* units; const gchar* A; const gchar* Bt; const gi32* tok_of; int K, erows;
    __device__ __forceinline__ bool next(int i, Unit& u) const {
        const i32x4 d = units[i];
        u.e = __builtin_amdgcn_readfirstlane(d.x); u.pm = __builtin_amdgcn_readfirstlane(d.y); u.pn = __builtin_amdgcn_readfirstlane(d.z); u.row0 = __builtin_amdgcn_readfirstlane(d.w);
        return u.e >= 0;
    }
    __device__ __forceinline__ const gchar* a_base(const Unit& u) const { return tok_of ? A : A + (size_t)u.row0 * K * 2; }
    __device__ __forceinline__ const gchar* b_base(const Unit& u) const { return Bt + ((size_t)u.e * erows + (size_t)u.pn * 256) * K * 2; }
    __device__ __forceinline__ int gather_row(const Unit& u, int r) const { return tok_of[u.row0 + r]; }
};
__device__ __forceinline__ const LAS i32x4* stage_units(Frame& F, const gi32x4* g, int n) {
    LAS i32x4* l = (LAS i32x4*)(F.lds + LDS_UNITS);
    if (F.tid < n) l[F.tid] = g[F.tid];
    __syncthreads();
    return l;
}
__device__ __forceinline__ bool class_unit(const LAS int* tot, const LAS int* pst, int x, int q, int npn, int shs, int shn, i32x4& d) {
#pragma unroll 1
    for (int kk = 0; kk < 8; ++kk) { const int e = x + 8 * kk; const int n = ((tot[e] + 255) >> 8) * npn;
        if (q < n) { const int mt = q / npn; d = (i32x4){e, mt, q - mt * npn, pst[e] + 256 * mt}; return true; } q -= n; }
    if (q < shn * npn) { const int mt = shs + q / npn; d = (i32x4){64, mt, q % npn, SH_BASE + 256 * mt}; return true; }
    d = (i32x4){-1, 0, 0, 0}; return false;
}
__device__ __forceinline__ void shared_share(const LAS int* rt, int S, int x, int& shs, int& shn) {
    int R = 0;
#pragma unroll
    for (int y = 0; y < 8; ++y) R += rt[y];
    int lv = (R + S + 7) >> 3;
#pragma unroll 1
    for (;;) { int cap = 0;
#pragma unroll
        for (int y = 0; y < 8; ++y) cap += max(0, lv - rt[y]);
        if (cap >= S) break; ++lv; }
    int left = S; shs = 0; shn = 0;
#pragma unroll
    for (int y = 0; y < 8; ++y) { const int n = min(max(0, lv - rt[y]), left); if (y == x) { shs = S - left; shn = n; } left -= n; }
}

__device__ __forceinline__ int down_row(int c) { return (c & ~255) + 128 * ((c >> 3) & 1) + 32 * ((c >> 6) & 3) + 8 * ((c >> 4) & 3) + (c & 7); }
__device__ __forceinline__ void tr_item(const gf32* __restrict__ W, int ldw, int K, gbf16* WT, int drow, int k0, int n0src, LAS float* scr, int lane, bool dperm = false, float fp8 = 0.f) {
    float tv[32];
    const gf32* wp = W + (size_t)(k0 + (lane >> 5)) * ldw + n0src + (lane & 31);
#pragma unroll
    for (int i = 0; i < 32; ++i) tv[i] = __builtin_nontemporal_load(wp + (size_t)(2 * i) * ldw);
#pragma unroll
    for (int i = 0; i < 32; ++i) scr[(2 * i + (lane >> 5)) * 33 + (lane & 31)] = tv[i];
    LDS_WAIT(); asm volatile("" ::: "memory");
    if (fp8 != 0.f) {
        const int c4 = lane & 3; gu8* W8 = (gu8*)WT;
#pragma unroll
        for (int j = 0; j < 2; ++j) { const int n = (lane >> 2) + 16 * j; const LAS float* s = scr + (16 * c4) * 33 + n; u32x4 o;
#pragma unroll
            for (int q = 0; q < 4; ++q) o[q] = pk4_fp8((f32x4){s[(4 * q) * 33], s[(4 * q + 1) * 33], s[(4 * q + 2) * 33], s[(4 * q + 3) * 33]} * fp8);
            *(gu32x4*)(W8 + (size_t)(dperm ? down_row(drow + n) : drow + n) * K + k0 + 16 * c4) = o; }
        LDS_WAIT(); asm volatile("" ::: "memory");
        return; }
    const int c = lane & 7;
#pragma unroll
    for (int j = 0; j < 4; ++j) { const int n = (lane >> 3) + 8 * j; const LAS float* s = scr + (8 * c) * 33 + n;
        u32x4 o; o.x = cvt_pk_bf16(s[0 * 33], s[1 * 33]); o.y = cvt_pk_bf16(s[2 * 33], s[3 * 33]); o.z = cvt_pk_bf16(s[4 * 33], s[5 * 33]); o.w = cvt_pk_bf16(s[6 * 33], s[7 * 33]);
        *(gu32x4*)(WT + (size_t)(dperm ? down_row(drow + n) : drow + n) * K + k0 + 8 * c) = o; }
    LDS_WAIT(); asm volatile("" ::: "memory");
}
__device__ __forceinline__ void tr_job(int r, const gf32* src, int ldw, int col0, int K, int N, size_t sbatch, gbf16* dst, size_t dbatch, int row_off, int seg, int segs, LAS float* scr, int lane, bool dperm = false, float fp8 = 0.f) {
    const int nblk = N >> 5, ipb = (K >> 6) * nblk;
    const int bt = r / ipb, rr = r - bt * ipb, kb = rr / nblk, nb = rr - kb * nblk, n0 = nb << 5;
    tr_item(src + (size_t)bt * sbatch, ldw, K, dst + (size_t)bt * dbatch, row_off + (n0 / seg) * segs + (n0 % seg), kb << 6, col0 + n0, scr, lane, dperm, fp8);
}
__device__ __forceinline__ void phase_prologue(Frame& F) {
    if (F.bid < 192) {
        LAS float* cond = (LAS float*)F.lds;
        LAS float* red = (LAS float*)(F.lds + 9 * 2048 * 4);
        for (int i = F.tid; i < 9 * 2048; i += NTHR) { const int r = i >> 11, k = i & 2047; const float v = (r < 8) ? INP(IN_C)[r * D + k] : INP(IN_CCTX)[k]; cond[i] = siluf_(v); }
        __syncthreads();
        const int l = F.bid / 96, col0 = (F.bid % 96) * 128, cg = F.tid & 31, kl = F.tid >> 5;
        const gf32* W = INP(IN_ADAW) + (size_t)l * D * ADA_N + col0 + 4 * cg;
        f32x4 acc[9];
#pragma unroll
        for (int r = 0; r < 9; ++r) acc[r] = (f32x4){0.f, 0.f, 0.f, 0.f};
#pragma unroll 8
        for (int k = kl; k < D; k += 16) { const f32x4 w4 = __builtin_nontemporal_load((const gf32x4*)(W + (size_t)k * ADA_N));
#pragma unroll
            for (int r = 0; r < 9; ++r) acc[r] += cond[r * 2048 + k] * w4; }
#pragma unroll
        for (int r = 0; r < 9; ++r) *(LAS f32x4*)(red + (kl * 9 + r) * 128 + 4 * cg) = acc[r];
        __syncthreads();
        gf32* mod = (gf32*)(F.ws + WS_MOD);
        for (int o = F.tid; o < 9 * 128; o += NTHR) { const int r = o >> 7, c = o & 127; float s = 0.f;
#pragma unroll
            for (int q = 0; q < 16; ++q) s += red[(q * 9 + r) * 128 + c];
            mod[(size_t)(l * 9 + r) * ADA_N + col0 + c] = s + INP(IN_ADAB)[l * ADA_N + col0 + c]; }
        __syncthreads();
    }
    LAS float* scr = (LAS float*)(F.lds + F.wave * 8704);
    const int gw = F.bid * NWAVES + F.wave, NGW = GRID * NWAVES;
    gbf16* convin_t = (gbf16*)(F.ws + WS_CONVIN_T); gbf16* convout_t = (gbf16*)(F.ws + WS_CONVOUT_T);
    gbf16* mlin_t = (gbf16*)(F.ws + WS_MLIN_T); gbf16* mlout_t = (gbf16*)(F.ws + WS_MLOUT_T);
    constexpr int I_SQ = 32 * 64, I_MLIN = 32 * 193, I_RT = 32 * 2, I_EGU = 64 * 32 * 16, I_EDN = 64 * 8 * 64, I_SGU = 32 * 16, I_SDN = 8 * 64;
    constexpr int I_MOE = I_RT + 2 * I_EGU + I_EDN + 2 * I_SGU + I_SDN;
    constexpr int NITEMS = 4 * I_SQ + I_MLIN + I_SQ + 2 * I_MOE;
    gi32* ctr = (gi32*)(F.ws + WS_CTL) + CW_P0CTR;
    (void)gw; (void)NGW;
    for (;;) {
        int base = 0; if (F.lane == 0) base = __hip_atomic_fetch_add(ctr, 16, __ATOMIC_RELAXED, __HIP_MEMORY_SCOPE_AGENT);
        base = __builtin_amdgcn_readfirstlane(base);
        if (base >= NITEMS) break;
        const int lim = (base + 16 < NITEMS) ? base + 16 : NITEMS;
      for (int it = base; it < lim; ++it) {
        int r = it;
        if (r < I_SQ) { tr_job(r, INP(IN_CONVIN), 3 * D, 2048, D, D, 0, convin_t, 0, 0, 128, 256, scr, F.lane); continue; } r -= I_SQ;
        if (r < I_SQ) { tr_job(r, INP(IN_CONVIN), 3 * D, 4096, D, D, 0, convin_t, 0, 128, 128, 256, scr, F.lane); continue; } r -= I_SQ;
        if (r < I_SQ) { tr_job(r, INP(IN_CONVIN), 3 * D, 0, D, D, 0, convin_t, 0, 4096, D, 0, scr, F.lane); continue; } r -= I_SQ;
        if (r < I_SQ) { tr_job(r, INP(IN_CONVOUT), D, 0, D, D, 0, convout_t, 0, 0, D, 0, scr, F.lane); continue; } r -= I_SQ;
        if (r < I_MLIN) { tr_job(r, INP(IN_MLIN), MLSTM_N, 0, D, MLSTM_N, 0, mlin_t, 0, 0, 8192, 0, scr, F.lane); continue; } r -= I_MLIN;
        if (r < I_SQ) { tr_job(r, INP(IN_MLOUT), D, 0, D, D, 0, mlout_t, 0, 0, D, 0, scr, F.lane); continue; } r -= I_SQ;
        const int l = r / I_MOE; r -= l * I_MOE;
        gu8* moe = F.ws + WS_MOE0 + (size_t)l * MOE_STRIDE;
        gbf16* gu_t = (gbf16*)(moe + MOE_GU); gbf16* dn_t = (gbf16*)(moe + MOE_DN); gbf16* rt_t = (gbf16*)(moe + MOE_RT);
        if (r < I_RT) { tr_job(r, INP(IN_RW) + (size_t)l * D * NE, NE, 0, D, NE, 0, rt_t, 0, 0, NE, 0, scr, F.lane); continue; } r -= I_RT;
        if (r < I_EGU) { tr_job(r, INP(IN_EG) + (size_t)l * NE * D * ED, ED, 0, D, ED, (size_t)D * ED, gu_t, (size_t)512 * D, 0, 128, 256, scr, F.lane, false, GU_WSCALE); continue; } r -= I_EGU;
        if (r < I_EGU) { tr_job(r, INP(IN_EU) + (size_t)l * NE * D * ED, ED, 0, D, ED, (size_t)D * ED, gu_t, (size_t)512 * D, 128, 128, 256, scr, F.lane, false, GU_WSCALE); continue; } r -= I_EGU;
        if (r < I_EDN) { tr_job(r, INP(IN_ED) + (size_t)l * NE * ED * D, D, 0, ED, D, (size_t)ED * D, dn_t, (size_t)D * ED / 2, 0, D, 0, scr, F.lane, true, DN_WSCALE); continue; } r -= I_EDN;
        if (r < I_SGU) { tr_job(r, INP(IN_SG) + (size_t)l * D * ED, ED, 0, D, ED, 0, gu_t + (size_t)64 * 512 * D, 0, 0, 128, 256, scr, F.lane, false, GU_WSCALE); continue; } r -= I_SGU;
        if (r < I_SGU) { tr_job(r, INP(IN_SU) + (size_t)l * D * ED, ED, 0, D, ED, 0, gu_t + (size_t)64 * 512 * D, 0, 128, 128, 256, scr, F.lane, false, GU_WSCALE); continue; } r -= I_SGU;
        tr_job(r, INP(IN_SD) + (size_t)l * ED * D, D, 0, ED, D, 0, dn_t + (size_t)64 * D * ED / 2, 0, 0, D, 0, scr, F.lane, true, DN_WSCALE);
      }
    }
    { gu32x4* z = (gu32x4*)(mlin_t + (size_t)MLSTM_N * D); const int n16 = (MLSTM_NP - MLSTM_N) * D * 2 / 16;
      for (int i = F.bid * NTHR + F.tid; i < n16; i += GRID * NTHR) z[i] = (u32x4){0u, 0u, 0u, 0u}; }
}

template <bool LB> __device__ __forceinline__ int col_of(int lane, int j) { return LB ? 16 * lane + 1024 * (j >> 2) + 4 * (j & 3) : 4 * lane + 256 * j; }
template <bool TO_LDS, bool LB = false>
__device__ __forceinline__ void norm_mod_store(const f32x4 (&v)[8], float rstd, const gf32* w, const gf32* shift, const gf32* scale, gbf16* orow, LAS bf16_t* lrow, int lane) {
#pragma unroll
    for (int j = 0; j < 8; ++j) { const int c = col_of<LB>(lane, j);
        const f32x4 w4 = *(const gf32x4*)(w + c), sc = *(const gf32x4*)(scale + c), sh = *(const gf32x4*)(shift + c);
        const f32x4 y = (v[j] * rstd) * w4 * (sc + 1.0f) + sh;
        u32x2 o; o.x = cvt_pk_bf16(y[0], y[1]); o.y = cvt_pk_bf16(y[2], y[3]);
        *(gu32x2*)(orow + c) = o;
        if (TO_LDS) *(LAS u32x2*)(lrow + c) = o; }
}
__device__ __forceinline__ float row_ssq(const f32x4 (&v)[8]) {
    float s = 0.f;
#pragma unroll
    for (int j = 0; j < 8; ++j) s += (v[j][0] * v[j][0] + v[j][1] * v[j][1]) + (v[j][2] * v[j][2] + v[j][3] * v[j][3]);
    return wave_sum(s);
}

__device__ __forceinline__ void phase_norm0(Frame& F) {
    gbf16* H = (gbf16*)(F.ws + WS_H);
    const int gw = F.bid * NWAVES + F.wave, NGW = GRID * NWAVES;
    for (int r = gw; r < NTOK; r += NGW) {
        const gf32* xr = (r < NCTX) ? INP(IN_CTX) + (size_t)r * D : INP(IN_X) + (size_t)(r - NCTX) * D;
        f32x4 v[8];
#pragma unroll
        for (int j = 0; j < 8; ++j) v[j] = *(const gf32x4*)(xr + 4 * F.lane + 256 * j);
        const float rstd = rsqrtf(row_ssq(v) * (1.0f / D) + EPS);
        const int mr = mod_row(r);
        norm_mod_store<false>(v, rstd, INP(IN_NMIXW), mod_ptr(F, 0, mr, 0), mod_ptr(F, 0, mr, 1), H + (size_t)r * D, (LAS bf16_t*)F.lds, F.lane);
    }
}

__device__ __forceinline__ void phase_conv(Frame& F) {
    const gbf16* U = (const gbf16*)(F.ws + WS_U); const gbf16* BMt = (const gbf16*)(F.ws + WS_BM); gbf16* Z = (gbf16*)(F.ws + WS_Z);
    const gf32* dw = INP(IN_CONVDW);
    const int total = NTOK * (D / 8);
    for (int i = F.bid * NTHR + F.tid; i < total; i += GRID * NTHR) {
        const int r = i >> 8, c = (i & 255) * 8;
        const int pos = (r < NCTX) ? (r & 255) : (r & 63), seglen = (r < NCTX) ? 256 : 64;
        const u32x4 z4 = (u32x4){0u, 0u, 0u, 0u};
        const u32x4 um = (pos > 0) ? *(const gu32x4*)(U + (size_t)(r - 1) * D + c) : z4;
        const u32x4 u0 = *(const gu32x4*)(U + (size_t)r * D + c);
        const u32x4 up = (pos < seglen - 1) ? *(const gu32x4*)(U + (size_t)(r + 1) * D + c) : z4;
        const u32x4 bb = *(const gu32x4*)(BMt + (size_t)r * D + c);
        float w0[8], w1[8], w2[8];
#pragma unroll
        for (int q = 0; q < 2; ++q) { const f32x4 a = *(const gf32x4*)(dw + c + 4 * q), b = *(const gf32x4*)(dw + D + c + 4 * q), d = *(const gf32x4*)(dw + 2 * D + c + 4 * q);
#pragma unroll
            for (int j = 0; j < 4; ++j) { w0[4 * q + j] = a[j]; w1[4 * q + j] = b[j]; w2[4 * q + j] = d[j]; } }
        u32x4 o;
#pragma unroll
        for (int q = 0; q < 4; ++q) {
            const float y0 = bf_lo(bb[q]) * (w0[2 * q] * bf_lo(um[q]) + w1[2 * q] * bf_lo(u0[q]) + w2[2 * q] * bf_lo(up[q]));
            const float y1 = bf_hi(bb[q]) * (w0[2 * q + 1] * bf_hi(um[q]) + w1[2 * q + 1] * bf_hi(u0[q]) + w2[2 * q + 1] * bf_hi(up[q]));
            o[q] = cvt_pk_bf16(y0, y1); }
        *(gu32x4*)(Z + (size_t)r * D + c) = o;
    }
}

constexpr int HS_PITCH = 2056;
constexpr int RL_HS = 0, RL_PART = 16 * HS_PITCH * 2, RL_LOGIT = RL_PART + 8 * 16 * 64 * 4, RL_IDX = RL_LOGIT + 16 * 64 * 4;
template <int NT>
__device__ __forceinline__ void tile16_mfma(const LAS bf16_t* hs, const gbf16* Wt, LAS float* part, int wave, int lane) {
    f32x4 acc[NT];
#pragma unroll
    for (int nt = 0; nt < NT; ++nt) acc[nt] = (f32x4){0.f, 0.f, 0.f, 0.f};
    const int fr = lane & 15, fq = lane >> 4;
#pragma unroll 4
    for (int ks = 0; ks < 8; ++ks) { const int k0 = 256 * wave + 32 * ks + 8 * fq;
        const bf16x8 a = *(const LAS bf16x8*)(hs + fr * HS_PITCH + k0);
#pragma unroll
        for (int nt = 0; nt < NT; ++nt) { const bf16x8 b = *(const gbf16x8*)(Wt + (size_t)(16 * nt + fr) * D + k0);
            acc[nt] = __builtin_amdgcn_mfma_f32_16x16x32_bf16(a, b, acc[nt], 0, 0, 0); } }
#pragma unroll
    for (int nt = 0; nt < NT; ++nt)
#pragma unroll
        for (int j = 0; j < 4; ++j) part[wave * (256 * NT) + (4 * fq + j) * (16 * NT) + 16 * nt + fr] = acc[nt][j];
}
constexpr int R_HS = 0, R_PART = 0, R_LOGIT = 32 * HS_PITCH * 2, R_VSEL = R_LOGIT + 8192, R_TSC = R_VSEL + 8192, R_BIDX = R_TSC + 1024, R_CNT = R_BIDX + 1728;
static_assert(R_CNT + 2048 <= LDSCTL_OFF, "router LDS map");
__device__ __forceinline__ void phase_router(Frame& F, int layer, int rowbase, int rpb) {
    const gf32* X = (const gf32*)(F.ws + WS_X); gbf16* H = (gbf16*)(F.ws + WS_H); gu8* H8 = (gu8*)(F.ws + WS_H8);
    const gbf16* rt_t = (const gbf16*)(F.ws + WS_MOE0 + (size_t)layer * MOE_STRIDE + MOE_RT);
    gi32* sel_idx = (gi32*)(F.ws + RT_SELIDX); gf32* sel_gate = (gf32*)(F.ws + RT_SELGATE); gi32* sel_rank = (gi32*)(F.ws + RT_SELRANK); gi32* hist = (gi32*)(F.ws + RT_HIST);
    LAS bf16_t* hs = (LAS bf16_t*)(F.lds + R_HS); LAS float* part = (LAS float*)(F.lds + R_PART); LAS float* logit = (LAS float*)(F.lds + R_LOGIT);
    LAS float* vsel = (LAS float*)(F.lds + R_VSEL); LAS float* tsc = (LAS float*)(F.lds + R_TSC); LAS int* bidx = (LAS int*)(F.lds + R_BIDX); LAS int* wcnt = (LAS int*)(F.lds + R_CNT);
    const int r0 = rowbase + F.bid * rpb, ngroups = (rpb + 31) >> 5;
    const gf32* nw = INP(IN_NFFNW) + layer * D; const float bias = INP(IN_RB)[layer * NE + F.lane];
    const int fr = F.lane & 15, fq = F.lane >> 4;
#define RT_BAR() do { asm volatile("s_waitcnt lgkmcnt(0)" ::: "memory"); __builtin_amdgcn_s_barrier(); asm volatile("" ::: "memory"); } while (0)
    f32x4 cw[8], cs[8]; int cur_mr = -1;
    for (int g = 0; g < ngroups; ++g) {
#pragma unroll 1
        for (int pr = 0; pr < 2; ++pr) { const int lr = 4 * F.wave + 2 * pr, br = 32 * g + lr; LAS bf16_t* lrow = hs + lr * HS_PITCH;
            if (br < rpb) { const int r = r0 + br, mr = mod_row(r); const gf32* xr = X + (size_t)r * D; f32x4 va[8], vb[8];
#pragma unroll
                for (int j = 0; j < 8; ++j) { va[j] = *(const gf32x4*)(xr + 4 * F.lane + 256 * j); vb[j] = *(const gf32x4*)(xr + D + 4 * F.lane + 256 * j); }
                if (mr != cur_mr) { cur_mr = mr; const gf32* sc = mod_ptr(F, layer, mr, 4); const gf32* sh = mod_ptr(F, layer, mr, 3);
#pragma unroll
                    for (int j = 0; j < 8; ++j) { const int c = 4 * F.lane + 256 * j; cw[j] = *(const gf32x4*)(nw + c) * (*(const gf32x4*)(sc + c) + 1.0f); cs[j] = *(const gf32x4*)(sh + c); } }
                const float rstd0 = rsqrtf(row_ssq(va) * (1.0f / D) + EPS), rstd1 = rsqrtf(row_ssq(vb) * (1.0f / D) + EPS);
#pragma unroll
                for (int j = 0; j < 8; ++j) { const int c = 4 * F.lane + 256 * j;
                    const f32x4 y0 = (va[j] * rstd0) * cw[j] + cs[j], y1 = (vb[j] * rstd1) * cw[j] + cs[j];
                    u32x2 o0, o1; o0.x = cvt_pk_bf16(y0[0], y0[1]); o0.y = cvt_pk_bf16(y0[2], y0[3]); o1.x = cvt_pk_bf16(y1[0], y1[1]); o1.y = cvt_pk_bf16(y1[2], y1[3]);
                    *(gu32x2*)(H + (size_t)r * D + c) = o0; *(gu32x2*)(H + (size_t)(r + 1) * D + c) = o1;
                    *(GAS unsigned*)(H8 + (size_t)r * D + c) = pk4_fp8(y0); *(GAS unsigned*)(H8 + (size_t)(r + 1) * D + c) = pk4_fp8(y1);
                    *(LAS u32x2*)(lrow + c) = o0; *(LAS u32x2*)(lrow + HS_PITCH + c) = o1; }
            } else {
#pragma unroll
                for (int j = 0; j < 8; ++j) { *(LAS u32x2*)(lrow + 4 * F.lane + 256 * j) = (u32x2){0u, 0u}; *(LAS u32x2*)(lrow + HS_PITCH + 4 * F.lane + 256 * j) = (u32x2){0u, 0u}; } } }
        RT_BAR();
        f32x4 acc[2][4];
#pragma unroll
        for (int t = 0; t < 2; ++t)
#pragma unroll
            for (int nt = 0; nt < 4; ++nt) acc[t][nt] = (f32x4){0.f, 0.f, 0.f, 0.f};
#pragma unroll 4
        for (int ks = 0; ks < 8; ++ks) { const int k0 = 256 * F.wave + 32 * ks + 8 * fq;
            const bf16x8 a0 = *(const LAS bf16x8*)(hs + fr * HS_PITCH + k0), a1 = *(const LAS bf16x8*)(hs + (16 + fr) * HS_PITCH + k0);
#pragma unroll
            for (int nt = 0; nt < 4; ++nt) { const bf16x8 bfr = *(const gbf16x8*)(rt_t + (size_t)(16 * nt + fr) * D + k0);
                acc[0][nt] = __builtin_amdgcn_mfma_f32_16x16x32_bf16(a0, bfr, acc[0][nt], 0, 0, 0); acc[1][nt] = __builtin_amdgcn_mfma_f32_16x16x32_bf16(a1, bfr, acc[1][nt], 0, 0, 0); } }
        RT_BAR();
#pragma unroll
        for (int t = 0; t < 2; ++t)
#pragma unroll
            for (int nt = 0; nt < 4; ++nt)
#pragma unroll
                for (int j = 0; j < 4; ++j) part[F.wave * 2048 + (16 * t + 4 * fq + j) * 64 + 16 * nt + fr] = acc[t][nt][j];
        RT_BAR();
#pragma unroll
        for (int q = 0; q < 4; ++q) { const int o = F.tid + 512 * q; float s = 0.f;
#pragma unroll
            for (int w = 0; w < 8; ++w) s += part[w * 2048 + o];
            const float sc = sigmoidf_(s); logit[o] = sc; vsel[o] = sc + bias; }
        RT_BAR();
#pragma unroll 1
        for (int q = 0; q < 4; ++q) { const int lr = 4 * F.wave + q, br = 32 * g + lr;
            if (br < rpb) { const int r = r0 + br;
                const float myv = vsel[lr * 64 + F.lane], mysc = logit[lr * 64 + F.lane]; int rank = 0;
#pragma unroll 4
                for (int j4 = 0; j4 < 16; ++j4) { const f32x4 o = *(const LAS f32x4*)(vsel + lr * 64 + 4 * j4);
#pragma unroll
                    for (int t = 0; t < 4; ++t) rank += (o[t] > myv || (o[t] == myv && (4 * j4 + t) < F.lane)) ? 1 : 0; }
                const bool sel = rank < TOPK;
                if (sel) tsc[lr * 8 + rank] = mysc;
                asm volatile("s_waitcnt lgkmcnt(0)" ::: "memory");
                float ssum = 0.f;
#pragma unroll
                for (int k = 0; k < TOPK; ++k) ssum += tsc[lr * 8 + k];
                if (sel) { sel_idx[(size_t)r * TOPK + rank] = F.lane; sel_gate[(size_t)r * TOPK + rank] = mysc / ssum * 2.5f; bidx[br * TOPK + rank] = F.lane; } } }
    }
    __syncthreads();
    { const int rw = rpb >> 3, rb = F.wave * rw; int cnt = 0;
      for (int rr = rb; rr < rb + rw; ++rr) {
#pragma unroll
          for (int k = 0; k < TOPK; ++k) cnt += (bidx[rr * TOPK + k] == F.lane) ? 1 : 0; }
      wcnt[F.wave * 64 + F.lane] = cnt;
      __syncthreads();
      int base = 0, tot = 0;
#pragma unroll
      for (int w = 0; w < 8; ++w) { const int c = wcnt[w * 64 + F.lane]; base += (w < F.wave) ? c : 0; tot += c; }
      for (int rr = rb; rr < rb + rw; ++rr) {
#pragma unroll
          for (int k = 0; k < TOPK; ++k) { if (bidx[rr * TOPK + k] == F.lane) { sel_rank[(size_t)(r0 + rr) * TOPK + k] = base; ++base; } } }
      if (F.wave == 0) hist[F.bid * NE + F.lane] = tot; }
    __syncthreads();
#undef RT_BAR
}

__device__ __forceinline__ void phase_scatter(Frame& F, int rowbase, int rpb, int ntok) {
    const gi32* hist = (const gi32*)(F.ws + RT_HIST); gi32* einfo = (gi32*)(F.ws + RT_EINFO);
    const gi32* sel_idx = (const gi32*)(F.ws + RT_SELIDX); const gf32* sel_gate = (const gf32*)(F.ws + RT_SELGATE); const gi32* sel_rank = (const gi32*)(F.ws + RT_SELRANK);
    gi32* slot_of = (gi32*)(F.ws + RT_SLOTOF); gi32* tok_of = (gi32*)(F.ws + RT_TOKOF); gf32* gate_of = (gf32*)(F.ws + RT_GATEOF);
    LAS int* tot8 = (LAS int*)F.lds; LAS int* pre8 = tot8 + 512; LAS int* tot = pre8 + 512; LAS int* boff = tot + 64; LAS int* pst = boff + 64;
    { const int e = F.tid & 63, p = F.tid >> 6; int s = 0, pre = 0;
      for (int b = 32 * p; b < 32 * p + 32; ++b) { const int h = hist[b * NE + e]; s += h; pre += (b < F.bid) ? h : 0; }
      tot8[p * 64 + e] = s; pre8[p * 64 + e] = pre; }
    __syncthreads();
    if (F.tid < 64) { int s = 0, pre = 0;
#pragma unroll
        for (int p = 0; p < 8; ++p) { s += tot8[p * 64 + F.tid]; pre += pre8[p * 64 + F.tid]; }
        tot[F.tid] = s; boff[F.tid] = pre; }
    __syncthreads();
    LAS int* rtl = pst + 64;
    if (F.tid == 0) { int a = 0; for (int e = 0; e < NE; ++e) { pst[e] = a; a += (tot[e] + 255) & ~255; } }
    if (F.tid >= 64 && F.tid < 72) { const int x = F.tid - 64; int t = 0;
#pragma unroll
        for (int kk = 0; kk < 8; ++kk) t += (tot[x + 8 * kk] + 255) >> 8;
        rtl[x] = t; }
    __syncthreads();
    const int r0 = rowbase + F.bid * rpb;
    for (int a = F.tid; a < rpb * TOPK; a += NTHR) { const size_t ga = (size_t)r0 * TOPK + a; const int e = sel_idx[ga];
        const int slot = pst[e] + boff[e] + sel_rank[ga];
        tok_of[slot] = r0 + a / TOPK; gate_of[slot] = sel_gate[ga]; slot_of[ga] = slot; }
    for (int rr = F.tid; rr < rpb; rr += NTHR) { const int s = SH_BASE + (r0 - rowbase) + rr; tok_of[s] = r0 + rr; gate_of[s] = 1.0f; }
    if (F.bid < NE) { const int e = F.bid, lo = pst[e] + tot[e], hi = pst[e] + ((tot[e] + 255) & ~255);
        for (int s = lo + F.tid; s < hi; s += NTHR) { tok_of[s] = rowbase; gate_of[s] = 0.0f; } }
    if (F.bid == 0) {
        if (F.tid < NE) { einfo[F.tid] = tot[F.tid]; einfo[128 + F.tid] = pst[F.tid]; einfo[256 + F.tid] = (tot[F.tid] + 255) >> 8; }
        if (F.tid == NE) { einfo[NE] = ntok; einfo[128 + NE] = SH_BASE; einfo[256 + NE] = ntok >> 8; } }
    { const int x = F.bid & 7, j = F.bid >> 3;
      gi32x4* u1 = (gi32x4*)(F.ws + RT_UNITS1) + F.bid * MAXU1; gi32x4* u2 = (gi32x4*)(F.ws + RT_UNITS2) + F.bid * MAXU2;
      if (F.tid < 128 + MAXU2) { int shs, shn; shared_share(rtl, ntok >> 8, x, shs, shn);
        if (F.tid < MAXU1) { i32x4 d; class_unit(tot, pst, x, F.tid * 32 + j, 4, shs, shn, d); u1[F.tid] = d; }
        else if (F.tid >= 128) { const int i = F.tid - 128; i32x4 d; class_unit(tot, pst, x, i * 32 + j, 8, shs, shn, d); u2[i] = d; } } }
    __syncthreads();
}

template <int MODE>
__device__ __forceinline__ void phase_combine(Frame& F) {
    gf32* X = (gf32*)(F.ws + WS_X); gbf16* H = (gbf16*)(F.ws + WS_H); const gu8* Y = (const gu8*)(F.ws + WS_Y);
    const gi32* slot_of = (const gi32*)(F.ws + RT_SLOTOF);
    const int layer = MODE, rowbase = MODE ? NCTX : 0, nrows = MODE ? NLAT : NTOK;
    const int gw = F.bid * NWAVES + F.wave, NGW = GRID * NWAVES;
    const gf32* sel_gate = (const gf32*)(F.ws + RT_SELGATE);
    int sln[TOPK]; float gln[TOPK];
    if (gw < nrows) {
#pragma unroll
        for (int k = 0; k < TOPK; ++k) { sln[k] = slot_of[(size_t)(rowbase + gw) * TOPK + k]; gln[k] = sel_gate[(size_t)(rowbase + gw) * TOPK + k]; } }
    for (int rr = gw; rr < nrows; rr += NGW) { const int r = rowbase + rr;
        int sl[7]; float gk[7];
#pragma unroll
        for (int k = 0; k < TOPK; ++k) { sl[k] = __builtin_amdgcn_readfirstlane(sln[k]); gk[k] = __int_as_float(__builtin_amdgcn_readfirstlane(__float_as_int(gln[k]))); }
        if (rr + NGW < nrows) {
#pragma unroll
            for (int k = 0; k < TOPK; ++k) { sln[k] = slot_of[(size_t)(r + NGW) * TOPK + k]; gln[k] = sel_gate[(size_t)(r + NGW) * TOPK + k]; } }
        sl[6] = SH_BASE + rr; gk[6] = 1.0f;
        const int mr = mod_row(r); const gf32* g2 = mod_ptr(F, layer, mr, 5);
        f32x4 v[8];
#pragma unroll
        for (int hh = 0; hh < 2; ++hh) {
            f32x4 m[4];
#pragma unroll
            for (int q = 0; q < 4; ++q) m[q] = (f32x4){0.f, 0.f, 0.f, 0.f};
#pragma unroll
            for (int k = 0; k < 7; ++k) { const u32x4 y = *(const gu32x4*)(Y + (size_t)sl[k] * D + 16 * F.lane + 1024 * hh);
                acc4_fp8s(m[0], y.x, gk[k]); acc4_fp8s(m[1], y.y, gk[k]); acc4_fp8s(m[2], y.z, gk[k]); acc4_fp8s(m[3], y.w, gk[k]); }
#pragma unroll
            for (int q = 0; q < 4; ++q) { const int c = 16 * F.lane + 1024 * hh + 4 * q; v[4 * hh + q] = *(const gf32x4*)(X + (size_t)r * D + c) + *(const gf32x4*)(g2 + c) * m[q]; } }
        const float rstd = rsqrtf(row_ssq(v) * (1.0f / D) + EPS);
        if (MODE == 0) {
#pragma unroll
            for (int j = 0; j < 8; ++j) *(gf32x4*)(X + (size_t)r * D + col_of<true>(F.lane, j)) = v[j];
            norm_mod_store<false, true>(v, rstd, INP(IN_NMIXW) + D, mod_ptr(F, 1, mr, 0), mod_ptr(F, 1, mr, 1), H + (size_t)r * D, (LAS bf16_t*)F.lds, F.lane);
        } else {
#pragma unroll
            for (int j = 0; j < 8; ++j) { const int c = col_of<true>(F.lane, j); *(gf32x4*)(F.out + (size_t)rr * D + c) = (v[j] * rstd) * *(const gf32x4*)(INP(IN_FNW) + c); }
        }
    }
}

__device__ __forceinline__ void phase_combine0_gates(Frame& F) {
    gf32* X = (gf32*)(F.ws + WS_X); gbf16* H = (gbf16*)(F.ws + WS_H); const gu8* Y = (const gu8*)(F.ws + WS_Y);
    const gi32* slot_of = (const gi32*)(F.ws + RT_SLOTOF); gf32* G = (gf32*)(F.ws + WS_GATES);
    const gbf16* Wg = (const gbf16*)(F.ws + WS_MLIN_T) + (size_t)6144 * D;
    LAS bf16_t* hs = (LAS bf16_t*)(F.lds + R_HS); LAS float* part = (LAS float*)(F.lds + R_PART);
    constexpr int rpb = NTOK / GRID;
    const int r0 = F.bid * rpb, ngroups = (rpb + 31) >> 5;
    const int fr = F.lane & 15, fq = F.lane >> 4;
#define CG_BAR() do { asm volatile("s_waitcnt lgkmcnt(0)" ::: "memory"); __builtin_amdgcn_s_barrier(); asm volatile("" ::: "memory"); } while (0)
    f32x4 cw[8]; int cur_mr = -1;
    for (int g = 0; g < ngroups; ++g) {
        const int lr0 = 4 * F.wave, br0 = 32 * g + lr0;
        if (br0 < rpb) {
            const int slv = slot_of[(size_t)(r0 + br0) * TOPK + (F.lane < 24 ? F.lane : 0)];
            const int glv = __float_as_int(((const gf32*)(F.ws + RT_SELGATE))[(size_t)(r0 + br0) * TOPK + (F.lane < 24 ? F.lane : 0)]);
#pragma unroll 1
            for (int q = 0; q < 4; ++q) { const int r = r0 + br0 + q, mr = mod_row(r); LAS bf16_t* lrow = hs + (lr0 + q) * HS_PITCH;
                int sl[7]; float gk[7];
#pragma unroll
                for (int k = 0; k < TOPK; ++k) { sl[k] = __builtin_amdgcn_readlane(slv, 6 * q + k); gk[k] = __int_as_float(__builtin_amdgcn_readlane(glv, 6 * q + k)); }
                sl[6] = SH_BASE + r; gk[6] = 1.0f;
                const gf32* g2 = mod_ptr(F, 0, mr, 5); const gf32* sh = mod_ptr(F, 1, mr, 0);
                if (mr != cur_mr) { cur_mr = mr; const gf32* sc = mod_ptr(F, 1, mr, 1); const gf32* nw = INP(IN_NMIXW) + D;
#pragma unroll
                    for (int j = 0; j < 8; ++j) { const int c = col_of<true>(F.lane, j); cw[j] = *(const gf32x4*)(nw + c) * (*(const gf32x4*)(sc + c) + 1.0f); } }
                f32x4 v[8];
#pragma unroll
                for (int hh = 0; hh < 2; ++hh) {
                    f32x4 m[4];
#pragma unroll
                    for (int qq = 0; qq < 4; ++qq) m[qq] = (f32x4){0.f, 0.f, 0.f, 0.f};
#pragma unroll
                    for (int k = 0; k < 7; ++k) { const u32x4 y = *(const gu32x4*)(Y + (size_t)sl[k] * D + 16 * F.lane + 1024 * hh);
                        acc4_fp8s(m[0], y.x, gk[k]); acc4_fp8s(m[1], y.y, gk[k]); acc4_fp8s(m[2], y.z, gk[k]); acc4_fp8s(m[3], y.w, gk[k]); }
#pragma unroll
                    for (int qq = 0; qq < 4; ++qq) { const int c = 16 * F.lane + 1024 * hh + 4 * qq; v[4 * hh + qq] = *(const gf32x4*)(X + (size_t)r * D + c) + *(const gf32x4*)(g2 + c) * m[qq]; } }
                const float rstd = rsqrtf(row_ssq(v) * (1.0f / D) + EPS);
#pragma unroll
                for (int j = 0; j < 8; ++j) { const int c = col_of<true>(F.lane, j);
                    *(gf32x4*)(X + (size_t)r * D + c) = v[j];
                    const f32x4 y = (v[j] * rstd) * cw[j] + *(const gf32x4*)(sh + c);
                    u32x2 o; o.x = cvt_pk_bf16(y[0], y[1]); o.y = cvt_pk_bf16(y[2], y[3]);
                    *(gu32x2*)(H + (size_t)r * D + c) = o; *(LAS u32x2*)(lrow + c) = o; } }
        } else {
#pragma unroll
            for (int q = 0; q < 4; ++q)
#pragma unroll
                for (int j = 0; j < 8; ++j) *(LAS u32x2*)(hs + (lr0 + q) * HS_PITCH + 4 * F.lane + 256 * j) = (u32x2){0u, 0u}; }
        CG_BAR();
        f32x4 acc[2][2];
#pragma unroll
        for (int t = 0; t < 2; ++t)
#pragma unroll
            for (int nt = 0; nt < 2; ++nt) acc[t][nt] = (f32x4){0.f, 0.f, 0.f, 0.f};
#pragma unroll 4
        for (int ks = 0; ks < 8; ++ks) { const int k0 = 256 * F.wave + 32 * ks + 8 * fq;
            const bf16x8 a0 = *(const LAS bf16x8*)(hs + fr * HS_PITCH + k0), a1 = *(const LAS bf16x8*)(hs + (16 + fr) * HS_PITCH + k0);
#pragma unroll
            for (int nt = 0; nt < 2; ++nt) { const bf16x8 bfr = *(const gbf16x8*)(Wg + (size_t)(16 * nt + fr) * D + k0);
                acc[0][nt] = __builtin_amdgcn_mfma_f32_16x16x32_bf16(a0, bfr, acc[0][nt], 0, 0, 0); acc[1][nt] = __builtin_amdgcn_mfma_f32_16x16x32_bf16(a1, bfr, acc[1][nt], 0, 0, 0); } }
        CG_BAR();
#pragma unroll
        for (int t = 0; t < 2; ++t)
#pragma unroll
            for (int nt = 0; nt < 2; ++nt)
#pragma unroll
                for (int j = 0; j < 4; ++j) part[F.wave * 1024 + (16 * t + 4 * fq + j) * 32 + 16 * nt + fr] = acc[t][nt][j];
        CG_BAR();
#pragma unroll
        for (int q = 0; q < 2; ++q) { const int o = F.tid + 512 * q, row = o >> 5, cidx = o & 31, br = 32 * g + row; float sacc = 0.f;
#pragma unroll
            for (int w = 0; w < 8; ++w) sacc += part[w * 1024 + o];
            if (br < rpb) { float gt = softcap_gate(sacc + INP(IN_MLGB)[cidx]); if ((cidx >> 3) & 1) gt = log_sigmoid_(gt); G[(size_t)(r0 + br) * 32 + cidx] = gt; } }
        CG_BAR();
    }
#undef CG_BAR
}

__device__ __forceinline__ void phase_headnorm(Frame& F) {
    const gbf16* HF = (const gbf16*)(F.ws + WS_HF); const gbf16* HB = (const gbf16*)(F.ws + WS_HB); const gbf16* O = (const gbf16*)(F.ws + WS_O); gbf16* YIN = (gbf16*)(F.ws + WS_YIN);
    const gf32* nw = INP(IN_MLNW);
    const int gw = F.bid * NWAVES + F.wave, NGW = GRID * NWAVES;
    const int c0 = 32 * F.lane;
    f32x4 w4[8];
#pragma unroll
    for (int q = 0; q < 8; ++q) w4[q] = *(const gf32x4*)(nw + c0 + 4 * q);
    for (int rr = gw; rr < NLAT; rr += NGW) {
        u32x4 a[4], b[4], o[4];
#pragma unroll
        for (int q = 0; q < 4; ++q) { a[q] = *(const gu32x4*)(HF + (size_t)rr * D + c0 + 8 * q); b[q] = *(const gu32x4*)(HB + (size_t)rr * D + c0 + 8 * q); o[q] = *(const gu32x4*)(O + (size_t)(NCTX + rr) * D + c0 + 8 * q); }
        float h[32]; float ss = 0.f;
#pragma unroll
        for (int q = 0; q < 4; ++q)
#pragma unroll
            for (int e = 0; e < 4; ++e) { const float h0 = bf_lo(a[q][e]) + bf_lo(b[q][e]), h1 = bf_hi(a[q][e]) + bf_hi(b[q][e]); h[8 * q + 2 * e] = h0; h[8 * q + 2 * e + 1] = h1; ss += h0 * h0 + h1 * h1; }
        ss += dpp_mov<0xB1>(ss); ss += dpp_mov<0x4E>(ss); ss += dpp_mov<0x141>(ss);
        const float rstd = rsqrtf(ss * (1.0f / 256.0f) + EPS);
#pragma unroll
        for (int q = 0; q < 4; ++q) { u32x4 w;
#pragma unroll
            for (int e = 0; e < 4; ++e) { const int i0 = 8 * q + 2 * e;
                const float y0 = h[i0] * rstd * w4[i0 >> 2][i0 & 3] * sigmoidf_(bf_lo(o[q][e])), y1 = h[i0 + 1] * rstd * w4[(i0 + 1) >> 2][(i0 + 1) & 3] * sigmoidf_(bf_hi(o[q][e]));
                w[e] = cvt_pk_bf16(y0, y1); }
            *(gu32x4*)(YIN + (size_t)rr * D + c0 + 8 * q) = w; }
    }
}

constexpr int ML_Q = 0, ML_K = 16384, ML_V = 32768, ML_VW = 49152, ML_S = 65536, ML_CT = 74752, ML_F = 113920, ML_G = 118784;
constexpr int ML_SP = 144, ML_CTP = 272;
__device__ __forceinline__ unsigned off_b(unsigned row, unsigned ch) { return 256u * row + 16u * (ch ^ (((row & 3u) << 2) | ((row >> 2) & 3u))); }
__device__ __forceinline__ unsigned rowrd16(unsigned lane, unsigned rb, unsigned s) { return off_b((lane & 15u) + 16u * rb, 4u * s + (lane >> 4)); }
__device__ __forceinline__ unsigned trrd16(unsigned lane, unsigned c, unsigned ks, unsigned t) {
    const unsigned g = lane >> 4, q = (lane & 15u) >> 2, p = lane & 3u;
    return off_b(32u * ks + 8u * g + 4u * t + q, 2u * c + (p >> 1)) + 8u * (p & 1u);
}
__device__ __forceinline__ bf16x8 tr_frag(LAS unsigned char* img, unsigned lane, unsigned c, unsigned ks) {
    const s16x4 lo = __builtin_amdgcn_ds_read_tr16_b64_v4i16((LAS s16x4*)(img + trrd16(lane, c, ks, 0)));
    const s16x4 hi = __builtin_amdgcn_ds_read_tr16_b64_v4i16((LAS s16x4*)(img + trrd16(lane, c, ks, 1)));
    return (bf16x8){lo[0], lo[1], lo[2], lo[3], hi[0], hi[1], hi[2], hi[3]};
}
__device__ __forceinline__ int ml_row(int b, int dir, int p) {
    return (p < CTXL) ? b * CTXL + (dir ? (CTXL - 1 - p) : p) : NCTX + b * SEQ + (dir ? (SEQ - 1 - (p - CTXL)) : (p - CTXL));
}
__device__ __forceinline__ void phase_mlstm(Frame& F) {
    const gbf16* Qb = (const gbf16*)(F.ws + WS_Q); const gbf16* Kb = (const gbf16*)(F.ws + WS_K); const gbf16* Vb = (const gbf16*)(F.ws + WS_V);
    const gf32* G = (const gf32*)(F.ws + WS_GATES);
    const int wi = F.bid, b = wi >> 5, hd = (wi >> 2) & 7, dir = (wi >> 1) & 1, half = wi & 1;
    gbf16* HD = (gbf16*)(F.ws + (dir ? WS_HB : WS_HF));
    LAS unsigned char* L = F.lds;
    LAS float* fct = (LAS float*)(L + ML_F); LAS float* frs = fct + 64; LAS float* fwi = frs + 64; LAS float* fem = fwi + 64; LAS float* fsc = fem + 64;
    LAS bf16_t* wkb = (LAS bf16_t*)(fsc + 16); LAS float* fwk = (LAS float*)(wkb + 64);
    const unsigned lane = (unsigned)F.lane; const int w = F.wave, fr = F.lane & 15, fq = F.lane >> 4;
    for (int i = F.tid; i < 144 * ML_CTP / 16; i += NTHR) *(LAS u32x4*)(L + ML_CT + 16 * i) = (u32x4){0u, 0u, 0u, 0u};
    f32x4 cst[9];
#pragma unroll
    for (int v = 0; v < 9; ++v) cst[v] = (f32x4){0.f, 0.f, 0.f, 0.f};
    LAS float* BC = (LAS float*)(L + ML_G); LAS float* RS = BC + 2304; LAS float* CM = RS + 2304; LAS float* BL = CM + 2304; LAS float* CML = BL + 40; LAS float* MST = CML + 40; LAS float* MNW = MST + 40; LAS float* DEC = MNW + 40;
    for (int c = w; c < 36; c += 8) { const int p = 64 * c + F.lane; const size_t gr = (size_t)ml_row(b, dir, p);
        const float li = G[gr * 32 + (2 * dir) * 8 + hd], lf = G[gr * 32 + (2 * dir + 1) * 8 + hd];
        float bc = lf;
#pragma unroll
        for (int o = 1; o < 64; o <<= 1) { const float t = __shfl_up(bc, o); if (F.lane >= o) bc += t; }
        const float rsv = li - bc; float cm = rsv;
#pragma unroll
        for (int o = 1; o < 64; o <<= 1) { const float t = __shfl_up(cm, o); if (F.lane >= o) cm = fmaxf(cm, t); }
        BC[p] = bc; RS[p] = rsv; CM[p] = cm;
        if (F.lane == 63) { BL[c] = bc; CML[c] = cm; } }
    __syncthreads();
    if (F.tid == 0) { float m = -1.0e30f;
        for (int c = 0; c < 36; ++c) { const float bl = BL[c], mn = fmaxf(bl + m, bl + CML[c]); MST[c] = m; MNW[c] = mn; DEC[c] = fast_exp(bl + m - mn); m = mn; } }
    __syncthreads();
    u32x4 gq[2], gk[2], gv[2];
#define ML_LOAD_CHUNK(P0) do { _Pragma("unroll") for (int i = 0; i < 2; ++i) { const int cid = F.tid + 512 * i, row = cid >> 4, ch = cid & 15; const size_t gr = (size_t)ml_row(b, dir, (P0) + row); \
            gq[i] = *(const gu32x4*)(Qb + gr * 1024 + hd * 128 + 8 * ch); gk[i] = *(const gu32x4*)(Kb + gr * 1024 + hd * 128 + 8 * ch); \
            gv[i] = *(const gu32x4*)(Vb + gr * 2048 + hd * 256 + half * 128 + 8 * ch); } } while (0)
    ML_LOAD_CHUNK(0);
#define ML_BAR() do { asm volatile("s_waitcnt lgkmcnt(0)" ::: "memory"); __builtin_amdgcn_s_barrier(); asm volatile("" ::: "memory"); } while (0)
#pragma unroll 1
    for (int c = 0; c < 36; ++c) {
        const int p0 = 64 * c;
        if (F.tid < 64) { const float m_st = MST[c], mnew = MNW[c], bc = BC[p0 + F.tid], rsv = RS[p0 + F.tid], cm = CM[p0 + F.tid];
            const float mrow = bc + fmaxf(m_st, cm), wk = fast_exp(BL[c] + rsv - mnew);
            fct[F.tid] = bc - mrow; frs[F.tid] = rsv; fwi[F.tid] = fast_exp(bc + m_st - mrow); fem[F.tid] = fast_exp(-mrow); fwk[F.tid] = wk;
            if (F.tid == 0) { fsc[0] = DEC[c]; fsc[1] = mnew; } }
#pragma unroll
        for (int i = 0; i < 2; ++i) { const int cid = F.tid + 512 * i, row = cid >> 4, ch = cid & 15; const unsigned o = off_b(row, ch);
            *(LAS u32x4*)(L + ML_Q + o) = gq[i]; *(LAS u32x4*)(L + ML_K + o) = gk[i]; *(LAS u32x4*)(L + ML_V + o) = gv[i]; }
        if (c + 1 < 36) ML_LOAD_CHUNK(p0 + 64);
        ML_BAR();
        const float decay = fsc[0];
#pragma unroll
        for (int v = 0; v < 9; ++v) cst[v] *= decay;
#pragma unroll
        for (int ks = 0; ks < 2; ++ks) {
            const bf16x8 a0 = tr_frag(L + ML_K, lane, (unsigned)w, ks);
            const f32x4 wk0 = *(const LAS f32x4*)(fwk + 32 * ks + 8 * fq), wk1 = *(const LAS f32x4*)(fwk + 32 * ks + 8 * fq + 4);
            bf16x8 a;
            { const unsigned p0 = cvt_pk_bf16(__uint_as_float((unsigned)(unsigned short)a0[0] << 16) * wk0[0], __uint_as_float((unsigned)(unsigned short)a0[1] << 16) * wk0[1]);
              const unsigned p1 = cvt_pk_bf16(__uint_as_float((unsigned)(unsigned short)a0[2] << 16) * wk0[2], __uint_as_float((unsigned)(unsigned short)a0[3] << 16) * wk0[3]);
              const unsigned p2 = cvt_pk_bf16(__uint_as_float((unsigned)(unsigned short)a0[4] << 16) * wk1[0], __uint_as_float((unsigned)(unsigned short)a0[5] << 16) * wk1[1]);
              const unsigned p3 = cvt_pk_bf16(__uint_as_float((unsigned)(unsigned short)a0[6] << 16) * wk1[2], __uint_as_float((unsigned)(unsigned short)a0[7] << 16) * wk1[3]);
              a = __builtin_bit_cast(bf16x8, (u32x4){p0, p1, p2, p3}); }
#pragma unroll
            for (int v = 0; v < 8; ++v) { const bf16x8 bb = tr_frag(L + ML_V, lane, v, ks); cst[v] = __builtin_amdgcn_mfma_f32_16x16x32_bf16(a, bb, cst[v], 0, 0, 0); }
            const bf16x8 ba = (bf16x8){(short)0x3F80, (short)0x3F80, (short)0x3F80, (short)0x3F80, (short)0x3F80, (short)0x3F80, (short)0x3F80, (short)0x3F80};
            cst[8] = __builtin_amdgcn_mfma_f32_16x16x32_bf16(a, ba, cst[8], 0, 0, 0);
        }
        if (c >= 4) {
            const int tt = w >> 1;
            bf16x8 qf[4];
#pragma unroll
            for (int ks = 0; ks < 4; ++ks) qf[ks] = *(const LAS bf16x8*)(L + ML_Q + rowrd16(lane, tt, ks));
            const int t = 16 * tt + fr; const float ctt = fct[t];
#pragma unroll
            for (int si = 0; si < 2; ++si) { const int st = 2 * (w & 1) + si; f32x4 acc = (f32x4){0.f, 0.f, 0.f, 0.f};
                if (st <= tt)
#pragma unroll
                for (int ks = 0; ks < 4; ++ks) { const bf16x8 kf = *(const LAS bf16x8*)(L + ML_K + rowrd16(lane, st, ks)); acc = __builtin_amdgcn_mfma_f32_16x16x32_bf16(kf, qf[ks], acc, 0, 0, 0); }
                const int s0 = 16 * st + 4 * fq; float sv[4];
#pragma unroll
                for (int j = 0; j < 4; ++j) sv[j] = (s0 + j <= t) ? acc[j] * fast_exp(ctt + frs[s0 + j]) : 0.f;
                u32x2 o; o.x = cvt_pk_bf16(sv[0], sv[1]); o.y = cvt_pk_bf16(sv[2], sv[3]);
                *(LAS u32x2*)(L + ML_S + t * ML_SP + s0 * 2) = o; }
        }
        ML_BAR();
        if (c >= 4) {
            const int tt = w >> 1;
            f32x4 sv[5], qc[5];
#pragma unroll
            for (int i = 0; i < 5; ++i) { sv[i] = (f32x4){0.f, 0.f, 0.f, 0.f}; qc[i] = (f32x4){0.f, 0.f, 0.f, 0.f}; }
#pragma unroll
            for (int ks = 0; ks < 2; ++ks) { const bf16x8 a = *(const LAS bf16x8*)(L + ML_S + (fr + 16 * tt) * ML_SP + (32 * ks + 8 * fq) * 2);
#pragma unroll
                for (int i = 0; i < 4; ++i) { const bf16x8 bb = tr_frag(L + ML_V, lane, 4 * (w & 1) + i, ks); sv[i] = __builtin_amdgcn_mfma_f32_16x16x32_bf16(a, bb, sv[i], 0, 0, 0); }
                const bf16x8 bo = (bf16x8){(short)0x3F80, (short)0x3F80, (short)0x3F80, (short)0x3F80, (short)0x3F80, (short)0x3F80, (short)0x3F80, (short)0x3F80};
                sv[4] = __builtin_amdgcn_mfma_f32_16x16x32_bf16(a, bo, sv[4], 0, 0, 0); }
#pragma unroll
            for (int ks = 0; ks < 4; ++ks) { const bf16x8 a = *(const LAS bf16x8*)(L + ML_Q + rowrd16(lane, tt, ks));
#pragma unroll
                for (int i = 0; i < 5; ++i) { const int vt = (i < 4) ? 4 * (w & 1) + i : 8;
                    const bf16x8 bb = *(const LAS bf16x8*)(L + ML_CT + (fr + 16 * vt) * ML_CTP + (32 * ks + 8 * fq) * 2); qc[i] = __builtin_amdgcn_mfma_f32_16x16x32_bf16(a, bb, qc[i], 0, 0, 0); } }
#pragma unroll
            for (int j = 0; j < 4; ++j) { const int tl = 16 * tt + 4 * fq + j; const float wi_ = fwi[tl], em = fem[tl];
                const float den = sv[4][j] + wi_ * qc[4][j];
                const float inv = 1.0f / fmaxf(fabsf(den), em);
                LAS bf16_t* op = (LAS bf16_t*)(L + ML_VW) + tl * 128 + fr;
#pragma unroll
                for (int i = 0; i < 4; ++i) { const float h = (sv[i][j] + wi_ * qc[i][j]) * inv; op[16 * (4 * (w & 1) + i)] = (bf16_t)(cvt_pk_bf16(h, 0.f) & 0xffffu); } }
        }
        ML_BAR();
        if (c >= 4) {
#pragma unroll
            for (int i = 0; i < 2; ++i) { const int cid = F.tid + 512 * i, row = cid >> 4, ch = cid & 15; const size_t rr = (size_t)(ml_row(b, dir, p0 + row) - NCTX);
                *(gu32x4*)(HD + rr * D + hd * 256 + half * 128 + 8 * ch) = *(const LAS u32x4*)(L + ML_VW + row * 256 + 16 * ch); } }
#pragma unroll
        for (int v = 0; v < 9; ++v) { u32x2 o; o.x = cvt_pk_bf16(cst[v][0], cst[v][1]); o.y = cvt_pk_bf16(cst[v][2], cst[v][3]);
            *(LAS u32x2*)(L + ML_CT + (16 * v + fr) * ML_CTP + (16 * w + 4 * fq) * 2) = o; }
    }
    __syncthreads();
}

constexpr int N_PHASES = 19;
#ifndef PHASE_MASK
#define PHASE_MASK 0x7ffff
#endif
__global__ void __launch_bounds__(NTHR, 2) fwd(Args args) {
    extern __shared__ __attribute__((aligned(16))) unsigned char lds_raw[];
    if (threadIdx.x < 4) ((LAS unsigned*)((LAS unsigned char*)lds_raw + LDSCTL_OFF))[threadIdx.x] = 0u;
    __syncthreads();
#if !MK_PER_PHASE
    XcdBarrier bar = xcd_barrier_post((unsigned*)(args.ws + WS_CTL) + CW_BAR + args.li * 4096, (volatile LAS unsigned*)((LAS unsigned char*)lds_raw + LDSCTL_OFF));
#define SEAM(k) do { if (IN(k) && IN((k) + 1)) xcd_barrier(bar); } while (0)
#else
#define SEAM(k) do { } while (0)
#endif
    const int lo = args.ph_lo, hi = args.ph_hi;
#define IN(k) (((PHASE_MASK >> (k)) & 1) && lo <= (k) && (k) < hi)
#ifndef REPEAT_MASK
#define REPEAT_MASK 0
#endif
#ifndef REPEAT_N
#define REPEAT_N 1
#endif
#define REP(k) for (int rep_ = 0; rep_ < ((((REPEAT_MASK) >> (k)) & 1) ? (REPEAT_N) : 1); ++rep_, __syncthreads())
#define PHASE_FRAME() Frame F; gu8* ws; { gu8* w_ = (gu8*)args.ws; asm volatile("" : "+s"(w_)); int t_ = threadIdx.x; asm volatile("" : "+v"(t_)); ws = w_; \
        F.lds = (LAS unsigned char*)lds_raw; F.tid = t_; F.lane = t_ & 63; F.wave = __builtin_amdgcn_readfirstlane(t_ >> 6); F.bid = blockIdx.x; F.a = &args; F.out = (gf32*)args.out; F.ws = w_; }

    if (IN(0)) REP(0) { PHASE_FRAME(); (void)ws; phase_prologue(F); } SEAM(0);
    if (IN(1)) REP(1) { PHASE_FRAME(); (void)ws; phase_norm0(F); } SEAM(1);
    if (IN(2)) REP(2) { PHASE_FRAME(); pg8::DenseOrder S; S.init(ws + WS_H, ws + WS_CONVIN_T, NTOK, 3 * D, D, GRID, F.bid);
        EpiConvIn E{(gbf16*)(ws + WS_U), (gbf16*)(ws + WS_BM)};
        pg8::gemm_phase<EpiConvIn, pg8::DenseOrder, false>(F.lds, D, S, E); } SEAM(2);
    if (IN(3)) REP(3) { PHASE_FRAME(); (void)ws; phase_conv(F); } SEAM(3);
    if (IN(4)) REP(4) { PHASE_FRAME(); pg8::DenseOrder S; S.init(ws + WS_Z, ws + WS_CONVOUT_T, NTOK, D, D, GRID, F.bid);
        EpiResid E{INP(IN_CTX), INP(IN_X), (gf32*)(ws + WS_X), mod_ptr(F, 0, 0, 2), 0};
        pg8::gemm_phase<EpiResid, pg8::DenseOrder, false>(F.lds, D, S, E); } SEAM(4);
    if (IN(5)) REP(5) { PHASE_FRAME(); (void)ws; phase_router(F, 0, 0, NTOK / GRID); } SEAM(5);
    if (IN(6)) REP(6) { PHASE_FRAME(); (void)ws; phase_scatter(F, 0, NTOK / GRID, NTOK); } SEAM(6);
    if (IN(7)) REP(7) { PHASE_FRAME(); ExpertOrder S{stage_units(F, (const gi32x4*)(ws + RT_UNITS1) + F.bid * MAXU1, MAXU1), (const gchar*)(ws + WS_H8), (const gchar*)(ws + WS_MOE0 + MOE_GU), (const gi32*)(ws + RT_TOKOF), D / 2, 1024};
        EpiSwiglu E{(gu8*)(ws + WS_ACT)};
        pg8::gemm_phase<EpiSwiglu, ExpertOrder, true, true>(F.lds, D / 2, S, E); } SEAM(7);
    if (IN(8)) REP(8) { PHASE_FRAME(); ExpertOrder S{stage_units(F, (const gi32x4*)(ws + RT_UNITS2) + F.bid * MAXU2, MAXU2), (const gchar*)(ws + WS_ACT), (const gchar*)(ws + WS_MOE0 + MOE_DN), nullptr, ED / 2, 2048};
        EpiDown E{(gu8*)(ws + WS_Y)};
        pg8::gemm_phase<EpiDown, ExpertOrder, false, true>(F.lds, ED / 2, S, E); } SEAM(8);
    if (IN(9)) REP(9) { PHASE_FRAME(); (void)ws; phase_combine0_gates(F); } SEAM(9);
    if (IN(10)) REP(10) { PHASE_FRAME(); pg8::DenseOrder S; S.init(ws + WS_H, ws + WS_MLIN_T, NTOK, 3 * D, D, GRID, F.bid);
        EpiMlstmIn E{(gbf16*)(ws + WS_Q), (gbf16*)(ws + WS_K), (gbf16*)(ws + WS_V), (gbf16*)(ws + WS_O)};
        pg8::gemm_phase<EpiMlstmIn, pg8::DenseOrder, false>(F.lds, D, S, E); } SEAM(10);
    if (IN(11)) REP(11) { PHASE_FRAME(); (void)ws; phase_mlstm(F); } SEAM(11);
    if (IN(12)) REP(12) { PHASE_FRAME(); (void)ws; phase_headnorm(F); } SEAM(12);
    if (IN(13)) REP(13) { PHASE_FRAME(); pg8::DenseOrder S; S.init(ws + WS_YIN, ws + WS_MLOUT_T, NLAT, D, D, GRID, F.bid);
        gf32* X = (gf32*)(ws + WS_X);
        EpiResid E{X, X + (size_t)NCTX * D, X, mod_ptr(F, 1, 0, 2), NCTX};
        pg8::gemm_phase<EpiResid, pg8::DenseOrder, false>(F.lds, D, S, E); } SEAM(13);
    if (IN(14)) REP(14) { PHASE_FRAME(); (void)ws; phase_router(F, 1, NCTX, NLAT / GRID); } SEAM(14);
    if (IN(15)) REP(15) { PHASE_FRAME(); (void)ws; phase_scatter(F, NCTX, NLAT / GRID, NLAT); } SEAM(15);
    if (IN(16)) REP(16) { PHASE_FRAME(); ExpertOrder S{stage_units(F, (const gi32x4*)(ws + RT_UNITS1) + F.bid * MAXU1, MAXU1), (const gchar*)(ws + WS_H8), (const gchar*)(ws + WS_MOE0 + MOE_STRIDE + MOE_GU), (const gi32*)(ws + RT_TOKOF), D / 2, 1024};
        EpiSwiglu E{(gu8*)(ws + WS_ACT)};
        pg8::gemm_phase<EpiSwiglu, ExpertOrder, true, true>(F.lds, D / 2, S, E); } SEAM(16);
    if (IN(17)) REP(17) { PHASE_FRAME(); ExpertOrder S{stage_units(F, (const gi32x4*)(ws + RT_UNITS2) + F.bid * MAXU2, MAXU2), (const gchar*)(ws + WS_ACT), (const gchar*)(ws + WS_MOE0 + MOE_STRIDE + MOE_DN), nullptr, ED / 2, 2048};
        EpiDown E{(gu8*)(ws + WS_Y)};
        pg8::gemm_phase<EpiDown, ExpertOrder, false, true>(F.lds, ED / 2, S, E); } SEAM(17);
    if (IN(18)) REP(18) { PHASE_FRAME(); (void)ws; phase_combine<1>(F); }
#undef IN
#undef SEAM
}

extern "C" void kernel_launch(void* const* d_in, const int* in_sizes, int n_in, void* d_out, int out_size, void* d_ws, size_t ws_size, hipStream_t stream) {
    static int ready = 0;
    if (ready == 0) {
        if (n_in != N_IN || out_size != NLAT * D || ws_size < WS_END) { fprintf(stderr, "kernel_launch: unexpected problem shape (n_in %d, out %d, ws %zu)\n", n_in, out_size, ws_size); ready = -1; return; }
        if (hipFuncSetAttribute((const void*)fwd, hipFuncAttributeMaxDynamicSharedMemorySize, LDS_BYTES) != hipSuccess) { fprintf(stderr, "kernel_launch: hipFuncSetAttribute failed\n"); ready = -1; return; }
        int per_cu = 0;
        if (hipOccupancyMaxActiveBlocksPerMultiprocessor(&per_cu, (const void*)fwd, NTHR, LDS_BYTES) != hipSuccess || per_cu < 1) fprintf(stderr, "kernel_launch: note: occupancy query reports %d blocks per CU\n", per_cu);
        (void)hipGetLastError();
        ready = 1;
    }
    if (ready < 0) return;
    (void)hipMemsetAsync((char*)d_ws + WS_CTL, 0, CTL_BYTES, stream);
    Args a{};
    for (int i = 0; i < N_IN; ++i) a.in[i] = (const float*)d_in[i];
    a.out = (float*)d_out; a.ws = (unsigned char*)d_ws; a.pad = 0;
#if MK_PER_PHASE
    for (int p = 0; p < N_PHASES; ++p) { a.ph_lo = p; a.ph_hi = p + 1; a.li = 0; hipLaunchKernelGGL(fwd, dim3(GRID), dim3(NTHR), LDS_BYTES, stream, a); }
#else
    a.ph_lo = 0; a.ph_hi = N_PHASES; a.li = 0;
    hipLaunchKernelGGL(fwd, dim3(GRID), dim3(NTHR), LDS_BYTES, stream, a);
#endif
}
```

```cpp
#include <hip/hip_runtime.h>
#include <stdint.h>
#include <stdio.h>

#ifndef STAGGER_TICKS
#define STAGGER_TICKS 0
#endif
#ifndef MK_PER_PHASE
#define MK_PER_PHASE 0
#endif

#define GAS __attribute__((address_space(1)))
#define LAS __attribute__((address_space(3)))
typedef unsigned short bf16_t;
typedef short bf16x8 __attribute__((ext_vector_type(8)));
typedef short s16x4 __attribute__((ext_vector_type(4)));
typedef float f32x4 __attribute__((ext_vector_type(4)));
typedef float f32x2 __attribute__((ext_vector_type(2)));
typedef unsigned u32x4 __attribute__((ext_vector_type(4)));
typedef unsigned u32x2 __attribute__((ext_vector_type(2)));
typedef int i32x4 __attribute__((ext_vector_type(4)));
typedef long i64x2 __attribute__((ext_vector_type(2)));
typedef int i32x8 __attribute__((ext_vector_type(8)));
typedef GAS float gf32; typedef GAS bf16_t gbf16; typedef GAS int gi32; typedef GAS unsigned char gu8; typedef GAS char gchar;
typedef GAS f32x4 gf32x4; typedef GAS u32x4 gu32x4; typedef GAS u32x2 gu32x2; typedef GAS bf16x8 gbf16x8; typedef GAS i32x4 gi32x4;

constexpr int D = 2048, NBATCH = 8, SEQ = 2048, CTXL = 256;
constexpr int NCTX = NBATCH * CTXL;
constexpr int NLAT = NBATCH * SEQ;
constexpr int NTOK = NCTX + NLAT;
constexpr int NE = 64, TOPK = 6, ED = 512;
constexpr int ADA_N = 6 * D;
constexpr int MLSTM_N = 6176, MLSTM_NP = 6400;
constexpr int NWAVES = 8, NTHR = 512, GRID = 256;
constexpr int SH_BASE = 126976;
constexpr int NSLOT = SH_BASE + NTOK;
constexpr float EPS = 1e-6f;

constexpr size_t MiB = 1u << 20, KiB = 1024;
constexpr size_t WS_CTL = 0, CTL_BYTES = 64 * KiB;
constexpr size_t WS_MOD = 1 * MiB;
constexpr size_t WS_RT = 2 * MiB;
constexpr size_t RT_HIST = WS_RT;
constexpr size_t RT_EINFO = WS_RT + 64 * KiB;
constexpr size_t RT_SELIDX = WS_RT + 128 * KiB;
constexpr size_t RT_SELGATE = WS_RT + 640 * KiB;
constexpr size_t RT_SELRANK = WS_RT + 1152 * KiB;
constexpr size_t RT_SLOTOF = WS_RT + 1664 * KiB;
constexpr size_t RT_TOKOF = WS_RT + 2176 * KiB;
constexpr size_t RT_GATEOF = WS_RT + 2816 * KiB;
constexpr size_t RT_UNITS1 = WS_RT + 3584 * KiB;
constexpr size_t RT_UNITS2 = WS_RT + 3840 * KiB;
constexpr int MAXU1 = 64, MAXU2 = 128;
constexpr size_t WS_GATES = 10 * MiB;
constexpr size_t WS_CONVIN_T = 13 * MiB;
constexpr size_t WS_CONVOUT_T = 37 * MiB;
constexpr size_t WS_MLIN_T = 45 * MiB;
constexpr size_t WS_MLOUT_T = 70 * MiB;
constexpr size_t WS_MOE0 = 78 * MiB, MOE_STRIDE = 392 * MiB;
constexpr size_t MOE_GU = 0, MOE_DN = 260 * MiB, MOE_RT = 390 * MiB;
constexpr size_t WS_H = 862 * MiB;
constexpr size_t WS_X = 934 * MiB;
constexpr size_t WS_ACT = 1078 * MiB;
constexpr size_t WS_Y = 1220 * MiB;
constexpr size_t WS_U = WS_Y, WS_BM = WS_Y + 72 * MiB, WS_Z = WS_Y + 144 * MiB;
constexpr size_t WS_Q = WS_Y, WS_K = WS_Y + 36 * MiB, WS_V = WS_Y + 72 * MiB, WS_O = WS_Y + 144 * MiB;
constexpr size_t WS_HF = WS_Y + 216 * MiB, WS_HB = WS_Y + 280 * MiB, WS_YIN = WS_Y + 344 * MiB;
constexpr size_t WS_H8 = 1788 * MiB;
constexpr size_t WS_END = 1824 * MiB;
constexpr float DN_WSCALE = 32.0f, ACT_SCALE = 16.0f;
constexpr float GU_WSCALE = 64.0f;
constexpr int CW_BAR = 4096;
constexpr int CW_P0CTR = 64;

constexpr int RING_BYTES = 131072;
constexpr int LDSCTL_OFF = 150 * 1024;
constexpr int LDS_BYTES = 151 * 1024;

#define LDS_WAIT() asm volatile("s_waitcnt lgkmcnt(0)" ::: "memory")
#define VM_WAIT() asm volatile("s_waitcnt vmcnt(0)" ::: "memory")
__device__ __forceinline__ unsigned cvt_pk_bf16(float lo, float hi) { unsigned r; asm volatile("v_cvt_pk_bf16_f32 %0, %1, %2" : "=v"(r) : "v"(lo), "v"(hi)); return r; }
__device__ __forceinline__ unsigned pk4_fp8(const f32x4 v) { int w = 0;
    w = __builtin_amdgcn_cvt_pk_fp8_f32(__builtin_amdgcn_fmed3f(v[0], -448.0f, 448.0f), __builtin_amdgcn_fmed3f(v[1], -448.0f, 448.0f), w, false);
    w = __builtin_amdgcn_cvt_pk_fp8_f32(__builtin_amdgcn_fmed3f(v[2], -448.0f, 448.0f), __builtin_amdgcn_fmed3f(v[3], -448.0f, 448.0f), w, true); return (unsigned)w; }
__device__ __forceinline__ void acc4_fp8(f32x4& m, unsigned w) { const f32x2 lo = __builtin_amdgcn_cvt_pk_f32_fp8((int)w, false), hi = __builtin_amdgcn_cvt_pk_f32_fp8((int)w, true); m[0] += lo[0]; m[1] += lo[1]; m[2] += hi[0]; m[3] += hi[1]; }
__device__ __forceinline__ void acc4_fp8s(f32x4& m, unsigned w, float g) { const f32x2 lo = __builtin_amdgcn_cvt_pk_f32_fp8((int)w, false), hi = __builtin_amdgcn_cvt_pk_f32_fp8((int)w, true); m[0] += g * lo[0]; m[1] += g * lo[1]; m[2] += g * hi[0]; m[3] += g * hi[1]; }
__device__ __forceinline__ float bf_lo(unsigned u) { return __uint_as_float(u << 16); }
__device__ __forceinline__ float bf_hi(unsigned u) { return __uint_as_float(u & 0xffff0000u); }
template <int CTRL> __device__ __forceinline__ float dpp_mov(float v) { return __int_as_float(__builtin_amdgcn_update_dpp(0, __float_as_int(v), CTRL, 0xf, 0xf, true)); }
__device__ __forceinline__ float wave_sum(float v) {
    v += dpp_mov<0xB1>(v); v += dpp_mov<0x4E>(v); v += dpp_mov<0x141>(v); v += dpp_mov<0x140>(v);
    const int b = __float_as_int(v);
    return (__int_as_float(__builtin_amdgcn_readlane(b, 0)) + __int_as_float(__builtin_amdgcn_readlane(b, 16))) + (__int_as_float(__builtin_amdgcn_readlane(b, 32)) + __int_as_float(__builtin_amdgcn_readlane(b, 48)));
}
__device__ __forceinline__ float fast_exp(float x) { return __builtin_amdgcn_exp2f(x * 1.44269504088896341f); }
__device__ __forceinline__ float sigmoidf_(float x) { return 1.0f / (1.0f + fast_exp(-x)); }
__device__ __forceinline__ float siluf_(float x) { return x / (1.0f + fast_exp(-x)); }

#define XB_TMO      128
#define XB_XCNT(j)  (256  + 64 * (j))
#define XB_XSUB(j)  (1280 + 64 * (j))
#define XB_XGEN(j)  (2304 + 64 * (j))
#define XB_TOP      3328
#define XB_TOPGEN   3392
#define XCD_BAR_WORDS 3456
#define XB_SPIN_CAP (1u << 22)

__device__ __forceinline__ unsigned xb_ld(unsigned* p)              { return __hip_atomic_load(p, __ATOMIC_RELAXED, __HIP_MEMORY_SCOPE_AGENT); }
__device__ __forceinline__ unsigned xb_add(unsigned* p, unsigned v) { return __hip_atomic_fetch_add(p, v, __ATOMIC_RELAXED, __HIP_MEMORY_SCOPE_AGENT); }
__device__ __forceinline__ unsigned xb_xcc_id() { return (unsigned)__builtin_amdgcn_s_getreg((3 << 11) | 20) & 0xFu; }
#define XB_SPIN(cond, bar) do { unsigned _sp = 0; while (cond) { __builtin_amdgcn_s_sleep(1); \
    if ((++_sp & 255u) == 0u) { if (xb_ld(&(bar)[XB_TMO])) break; if (_sp > XB_SPIN_CAP) { atomicAdd(&(bar)[XB_TMO], 1u); break; } } } } while (0)

struct XcdBarrier { unsigned* bar; unsigned x; volatile LAS unsigned* st; };

__device__ __forceinline__ XcdBarrier xcd_barrier_post(unsigned* bar, volatile LAS unsigned* st) {
    XcdBarrier b; b.bar = bar; b.x = xb_xcc_id(); b.st = st;
    if (threadIdx.x == 0) (void)xb_add(&bar[XB_XCNT(b.x)], 1u);
    return b;
}
__device__ __forceinline__ void xcd_barrier_complete(unsigned* bar, unsigned x, unsigned& nloc, unsigned& nx) {
    const unsigned G = gridDim.x * gridDim.y * gridDim.z;
    unsigned sum, cnt, mine, sp = 0u;
    for (;;) {
        sum = 0u; cnt = 0u; mine = 0u;
#pragma unroll
        for (unsigned j = 0; j < 16; ++j) { const unsigned c = xb_ld(&bar[XB_XCNT(j)]); sum += c; cnt += (c > 0u) ? 1u : 0u; mine = (j == x) ? c : mine; }
        if (sum == G) break;
        __builtin_amdgcn_s_sleep(1);
        if ((++sp & 255u) == 0u) { if (xb_ld(&bar[XB_TMO])) break; if (sp > XB_SPIN_CAP) { atomicAdd(&bar[XB_TMO], 1u); break; } }
    }
    nloc = mine > 0u ? mine : 1u; nx = cnt > 0u ? cnt : 1u;
}
__device__ __forceinline__ void xcd_barrier(const XcdBarrier& b) {
    asm volatile("s_waitcnt vmcnt(0)" ::: "memory");
    __syncthreads();
    if (threadIdx.x == 0) {
        unsigned* bar = b.bar;
        __builtin_amdgcn_s_waitcnt(0);
        unsigned nloc = b.st[0], nx = b.st[1];
        if (nloc == 0u) { xcd_barrier_complete(bar, b.x, nloc, nx); b.st[0] = nloc; b.st[1] = nx; }
        const unsigned old = xb_add(&bar[XB_XSUB(b.x)], 1u);
        const unsigned gen = old / nloc;
        if (old + 1u == (gen + 1u) * nloc) {
            __builtin_amdgcn_fence(__ATOMIC_RELEASE, "agent");
            asm volatile("s_waitcnt vmcnt(0)" ::: "memory");
            const unsigned og = xb_add(&bar[XB_TOP], 1u);
            const unsigned tg = og / nx;
            if (og + 1u == (tg + 1u) * nx) xb_add(&bar[XB_TOPGEN], 1u);
            else XB_SPIN(xb_ld(&bar[XB_TOPGEN]) == tg, bar);
            __builtin_amdgcn_fence(__ATOMIC_ACQUIRE, "agent");
            xb_add(&bar[XB_XGEN(b.x)], 1u);
            asm volatile("s_waitcnt vmcnt(0)" ::: "memory");
        } else {
            XB_SPIN(xb_ld(&bar[XB_XGEN(b.x)]) == gen, bar);
            __builtin_amdgcn_fence(__ATOMIC_ACQUIRE, "agent");
            asm volatile("s_waitcnt vmcnt(0)" ::: "memory");
        }
    }
    __syncthreads();
}

namespace pg8 {
constexpr int BM = 256, BK = 64, HALF = 128, HTB = HALF * BK * 2, STAGE_BYTES = 8 * HTB, NXCD = 8, WGM = 8;
__host__ __device__ __forceinline__ int lds_byte(int r, int c) { const int st = (r >> 4) * 2 + (c >> 5), rr = r & 15, cc = c & 31, ob = rr * 64 + cc * 2; return st * 1024 + (ob ^ (((ob >> 9) & 1) << 5)); }
__host__ __device__ __forceinline__ void stage_rc(int b, int& R, int& C) { const int st = b / 1024, sb = b % 1024, swz = sb ^ (((sb >> 9) & 1) << 5); R = (st >> 1) * 16 + swz / 64; C = (st & 1) * 32 + (swz % 64) / 2; }
__host__ __device__ __forceinline__ int perm32(int rho) { const int n = rho >> 4, i = rho & 15; return 8 * (i >> 2) + 4 * n + (i & 3); }

struct Unit { int pm, pn, e, row0; };

struct DenseOrder {
    int nM, nN, nwg, G, c; const gchar* A; const gchar* Bt; size_t tstep;
    __device__ void init(const GAS void* A_, const GAS void* Bt_, int M, int N, int K, int G_, int c_) { A = (const gchar*)A_; Bt = (const gchar*)Bt_; nM = M / BM; nN = N / BM; nwg = nM * nN; G = G_; c = c_; tstep = (size_t)BM * K * 2; }
    __device__ __forceinline__ bool next(int i, Unit& u) const {
        const long L = (long)i * G + c; if (L >= nwg) return false;
        int wgid = (int)L; { const int q = nwg / NXCD, r = nwg % NXCD, xcd = wgid % NXCD, off = wgid / NXCD; wgid = (xcd < r ? xcd * (q + 1) : r * (q + 1) + (xcd - r) * q) + off; }
        const int nig = WGM * nN, gid = wgid / nig, fm = gid * WGM, gsz = (nM - fm) < WGM ? (nM - fm) : WGM;
        u.pm = fm + ((wgid % nig) % gsz); u.pn = (wgid % nig) / gsz; u.e = 0; u.row0 = u.pm * BM; return true;
    }
    __device__ __forceinline__ const gchar* a_base(const Unit& u) const { return A + (size_t)u.pm * tstep; }
    __device__ __forceinline__ const gchar* b_base(const Unit& u) const { return Bt + (size_t)u.pn * tstep; }
    __device__ __forceinline__ int gather_row(const Unit&, int) const { return 0; }
};

template <class Epi, class Sched, bool GATHER, bool FP8 = false>
__device__ __forceinline__ void gemm_phase(LAS unsigned char* lds, const int K, const Sched& S, const Epi& E) {
    const int tid = threadIdx.x, wid = __builtin_amdgcn_readfirstlane(tid >> 6), lane = tid & 63, wr = wid >> 2, wc = wid & 3, fr = lane & 15, fq = lane >> 4;
    const int nt = K / BK;
    int Rst[2], Cst[2];
    unsigned voffA[2], voffB[2];
#pragma unroll
    for (int i = 0; i < 2; ++i) { int R, C; stage_rc(tid * 16 + i * 8192, R, C); const int Rb = Epi::PERM ? ((R & ~31) + perm32(R & 31)) : R;
        Rst[i] = R; Cst[i] = C; voffA[i] = (unsigned)(R * K + C) * 2u; voffB[i] = (unsigned)(Rb * K + C) * 2u; }
    const size_t kstep = (size_t)(BK * 2);
    const size_t hstep = (size_t)HALF * K * 2;
    const unsigned ldsw = (unsigned)wid * 1024u;
    const int aoff = lds_byte(wr * 64 + fr, fq * 8), boff = lds_byte(wc * 32 + fr, fq * 8);
#define PG8_SA(b, h) (((b) * 2 + (h)) * HTB)
#define PG8_SB(b, h) ((4 + (b) * 2 + (h)) * HTB)
#define PG8_STAGE(bufoff, gbase, voff) do { _Pragma("unroll") for (int _i = 0; _i < 2; ++_i) \
        __builtin_amdgcn_global_load_lds((const GAS unsigned*)((const gchar*)(gbase) + (voff)[_i]), (LAS unsigned*)(lds + (bufoff) + ldsw + _i * 8192), 16, 0, 0); } while (0)
#define PG8_LDA(dst, b, h) do { _Pragma("unroll") for (int m = 0; m < 4; ++m) _Pragma("unroll") for (int k = 0; k < 2; ++k) dst[m][k] = *(const LAS bf16x8*)(lds + PG8_SA(b, h) + aoff + m * 2048 + k * 1024); } while (0)
#define PG8_LDB(dst, b, h) do { _Pragma("unroll") for (int n = 0; n < 2; ++n) _Pragma("unroll") for (int k = 0; k < 2; ++k) dst[n][k] = *(const LAS bf16x8*)(lds + PG8_SB(b, h) + boff + n * 2048 + k * 1024); } while (0)
#define PG8_CAT(x) __builtin_shufflevector(__builtin_bit_cast(i32x4, (x)[0]), __builtin_bit_cast(i32x4, (x)[1]), 0, 1, 2, 3, 4, 5, 6, 7)
#define PG8_MMA(ai, bj, At, Bt) do { __builtin_amdgcn_s_setprio(1); \
        if constexpr (FP8) { i32x8 _a8[4], _b8[2]; _Pragma("unroll") for (int m = 0; m < 4; ++m) _a8[m] = PG8_CAT(At[m]); _Pragma("unroll") for (int n = 0; n < 2; ++n) _b8[n] = PG8_CAT(Bt[n]); \
            _Pragma("unroll") for (int m = 0; m < 4; ++m) _Pragma("unroll") for (int n = 0; n < 2; ++n) \
                asm volatile("v_mfma_scale_f32_16x16x128_f8f6f4 %0, %1, %2, %0, %3, %4 op_sel_hi:[0,0,0]" : "+v"(acc[ai][bj][m][n]) : "v"(_b8[n]), "v"(_a8[m]), "v"(mx_sc[bj]), "v"(mx_one)); } \
        else { _Pragma("unroll") for (int m = 0; m < 4; ++m) _Pragma("unroll") for (int n = 0; n < 2; ++n) _Pragma("unroll") for (int k = 0; k < 2; ++k) \
            acc[ai][bj][m][n] = __builtin_amdgcn_mfma_f32_16x16x32_bf16(Bt[n][k], At[m][k], acc[ai][bj][m][n], 0, 0, 0); } __builtin_amdgcn_s_setprio(0); } while (0)
#define PG8_MMAZ(ai, bj, At, Bt) do { __builtin_amdgcn_s_setprio(1); \
        if constexpr (FP8) { i32x8 _a8[4], _b8[2]; _Pragma("unroll") for (int m = 0; m < 4; ++m) _a8[m] = PG8_CAT(At[m]); _Pragma("unroll") for (int n = 0; n < 2; ++n) _b8[n] = PG8_CAT(Bt[n]); \
            _Pragma("unroll") for (int m = 0; m < 4; ++m) _Pragma("unroll") for (int n = 0; n < 2; ++n) \
                asm volatile("v_mfma_scale_f32_16x16x128_f8f6f4 %0, %1, %2, 0, %3, %4 op_sel_hi:[0,0,0]" : "=&v"(acc[ai][bj][m][n]) : "v"(_b8[n]), "v"(_a8[m]), "v"(mx_sc[bj]), "v"(mx_one)); } \
        else { _Pragma("unroll") for (int m = 0; m < 4; ++m) _Pragma("unroll") for (int n = 0; n < 2; ++n) { \
            acc[ai][bj][m][n] = __builtin_amdgcn_mfma_f32_16x16x32_bf16(Bt[n][0], At[m][0], (f32x4){0.f, 0.f, 0.f, 0.f}, 0, 0, 0); \
            acc[ai][bj][m][n] = __builtin_amdgcn_mfma_f32_16x16x32_bf16(Bt[n][1], At[m][1], acc[ai][bj][m][n], 0, 0, 0); } } __builtin_amdgcn_s_setprio(0); } while (0)
#define PG8_MMA1(ai, bj, At, Bt) do { if (FP8 && t == 0) PG8_MMAZ(ai, bj, At, Bt); else PG8_MMA(ai, bj, At, Bt); } while (0)
#define PG8_WAIT_V(n) asm volatile("s_waitcnt vmcnt(" #n ")" ::: "memory")
#define PG8_WAIT_L(n) asm volatile("s_waitcnt lgkmcnt(" #n ")" ::: "memory")
#define PG8_BAR __builtin_amdgcn_s_barrier()
#define PG8_SCHED __builtin_amdgcn_sched_barrier(0)
    Unit cur, nxt; int ui = 0;
    if (!S.next(0, cur)) return;
#if STAGGER_TICKS
    {
      const unsigned long long t0 = __builtin_amdgcn_s_memrealtime(); const unsigned long long dt = (unsigned long long)((blockIdx.x >> 3) & 3) * STAGGER_TICKS;
      while (__builtin_amdgcn_s_memrealtime() - t0 < dt) __builtin_amdgcn_s_sleep(8); }
#endif
    f32x4 acc[2][2][4][2];
#pragma unroll
    for (int a = 0; a < 2; ++a)
#pragma unroll
        for (int b = 0; b < 2; ++b)
#pragma unroll
            for (int m = 0; m < 4; ++m)
#pragma unroll
                for (int n = 0; n < 2; ++n) acc[a][b][m][n] = (f32x4){0.f, 0.f, 0.f, 0.f};
    bf16x8 At[4][2], B0[2][2], B1[2][2]; int mx_one = 0x7f7f7f7f; asm volatile("" : "+v"(mx_one));
    int mx_sc[2] = {0x7f7f7f7f, 0x7f7f7f7f};
    if constexpr (FP8) { mx_sc[0] = 0x01010101 * (127 + Epi::MXE0); mx_sc[1] = 0x01010101 * (127 + Epi::MXE1); asm volatile("" : "+v"(mx_sc[0]), "+v"(mx_sc[1])); }
    const gchar* cA = S.a_base(cur); const gchar* cB = S.b_base(cur);
    unsigned vc0[2], vc1[2], vn0[2], vn1[2];
    if constexpr (GATHER) {
#pragma unroll
        for (int i = 0; i < 2; ++i) { vc0[i] = ((unsigned)S.gather_row(cur, Rst[i]) * (unsigned)K + (unsigned)Cst[i]) * 2u; vc1[i] = ((unsigned)S.gather_row(cur, HALF + Rst[i]) * (unsigned)K + (unsigned)Cst[i]) * 2u; vn0[i] = vc0[i]; vn1[i] = vc1[i]; }
    } else {
#pragma unroll
        for (int i = 0; i < 2; ++i) { vc0[i] = voffA[i]; vc1[i] = voffA[i] + (unsigned)hstep; vn0[i] = vc0[i]; vn1[i] = vc1[i]; }
    }
    PG8_STAGE(PG8_SB(0, 0), cB, voffB); PG8_STAGE(PG8_SA(0, 0), cA, vc0); PG8_STAGE(PG8_SB(0, 1), cB + hstep, voffB); PG8_STAGE(PG8_SA(0, 1), cA, vc1);
    if (wr == 1) PG8_BAR;
    PG8_WAIT_V(4); PG8_BAR;
    PG8_STAGE(PG8_SB(1, 0), cB + kstep, voffB); PG8_STAGE(PG8_SA(1, 0), cA + kstep, vc0); PG8_STAGE(PG8_SB(1, 1), cB + hstep + kstep, voffB);
    PG8_WAIT_V(6); PG8_BAR;
    for (;;) {
        const bool has_next = S.next(ui + 1, nxt);
        const gchar* nA = has_next ? S.a_base(nxt) : cA; const gchar* nB = has_next ? S.b_base(nxt) : cB;
        for (int t = 0; t < nt; t += 2) {
            const bool last = (t == nt - 2);
            const gchar* a1 = cA + (size_t)(t + 1) * kstep;
            const gchar* a2 = last ? nA : cA + (size_t)(t + 2) * kstep; const gchar* b2 = last ? nB : cB + (size_t)(t + 2) * kstep;
            const gchar* a3 = a2 + kstep; const gchar* b3 = b2 + kstep;
            unsigned s0[2], s1[2];
            if constexpr (GATHER) {
                if (last && has_next) {
#pragma unroll
                    for (int i = 0; i < 2; ++i) { vn0[i] = ((unsigned)S.gather_row(nxt, Rst[i]) * (unsigned)K + (unsigned)Cst[i]) * 2u; vn1[i] = ((unsigned)S.gather_row(nxt, HALF + Rst[i]) * (unsigned)K + (unsigned)Cst[i]) * 2u; }
                }
#pragma unroll
                for (int i = 0; i < 2; ++i) { s0[i] = last ? vn0[i] : vc0[i]; s1[i] = last ? vn1[i] : vc1[i]; }
            } else {
#pragma unroll
                for (int i = 0; i < 2; ++i) { s0[i] = vc0[i]; s1[i] = vc1[i]; }
            }
            PG8_LDB(B0, 0, 0); PG8_SCHED; PG8_LDA(At, 0, 0); PG8_STAGE(PG8_SA(1, 1), a1, vc1);
            PG8_WAIT_L(8); PG8_BAR; PG8_WAIT_L(0); PG8_MMA1(0, 0, At, B0); PG8_BAR; PG8_SCHED;
            PG8_LDB(B1, 0, 1); PG8_STAGE(PG8_SB(0, 0), b2, voffB);
            PG8_BAR; PG8_WAIT_L(0); PG8_MMA1(0, 1, At, B1); PG8_BAR;
            PG8_LDA(At, 0, 1); PG8_STAGE(PG8_SA(0, 0), a2, s0);
            PG8_BAR; PG8_WAIT_L(0); PG8_MMA1(1, 0, At, B0); PG8_BAR; PG8_SCHED;
            PG8_STAGE(PG8_SB(0, 1), b2 + hstep, voffB);
            PG8_WAIT_V(6); PG8_BAR; PG8_MMA1(1, 1, At, B1); PG8_BAR;
            PG8_LDB(B0, 1, 0); PG8_SCHED; PG8_LDA(At, 1, 0); PG8_STAGE(PG8_SA(0, 1), a2, s1);
            PG8_WAIT_L(8); PG8_BAR; PG8_WAIT_L(0); PG8_MMA(0, 0, At, B0); PG8_BAR; PG8_SCHED;
            PG8_LDB(B1, 1, 1); PG8_STAGE(PG8_SB(1, 0), b3, voffB);
            PG8_BAR; PG8_WAIT_L(0); PG8_MMA(0, 1, At, B1); PG8_BAR;
            PG8_LDA(At, 1, 1); PG8_STAGE(PG8_SA(1, 0), a3, s0);
            PG8_BAR; PG8_WAIT_L(0); PG8_MMA(1, 0, At, B0); PG8_BAR; PG8_SCHED;
            PG8_STAGE(PG8_SB(1, 1), b3 + hstep, voffB);
            PG8_WAIT_V(6); PG8_BAR; PG8_MMA(1, 1, At, B1); PG8_BAR;
        }
        if constexpr (FP8) {
            asm volatile("s_nop 15\n\ts_nop 3" : "+v"(acc[1][1][0][0]), "+v"(acc[1][1][0][1]), "+v"(acc[1][1][1][0]), "+v"(acc[1][1][1][1]), "+v"(acc[1][1][2][0]), "+v"(acc[1][1][2][1]), "+v"(acc[1][1][3][0]), "+v"(acc[1][1][3][1])); }
        E(acc, cur, wr, wc, fr, fq);
        if (!has_next) break;
        if constexpr (!FP8) {
#pragma unroll
            for (int a = 0; a < 2; ++a)
#pragma unroll
                for (int b = 0; b < 2; ++b)
#pragma unroll
                    for (int m = 0; m < 4; ++m)
#pragma unroll
                        for (int n = 0; n < 2; ++n) acc[a][b][m][n] = (f32x4){0.f, 0.f, 0.f, 0.f}; }
        cur = nxt; cA = nA; cB = nB; ++ui;
#pragma unroll
        for (int i = 0; i < 2; ++i) { vc0[i] = vn0[i]; vc1[i] = vn1[i]; }
    }
    PG8_WAIT_V(0);
    if (wr == 0) PG8_BAR;
    PG8_BAR;
#undef PG8_SA
#undef PG8_SB
#undef PG8_STAGE
#undef PG8_LDA
#undef PG8_LDB
#undef PG8_MMA
#undef PG8_MMAZ
#undef PG8_MMA1
#undef PG8_CAT
#undef PG8_WAIT_V
#undef PG8_WAIT_L
#undef PG8_BAR
#undef PG8_SCHED
}
}
using pg8::Unit;

enum { IN_X = 0, IN_C, IN_CTX, IN_CCTX, IN_ADAW, IN_ADAB, IN_NMIXW, IN_NFFNW, IN_CONVIN, IN_CONVDW, IN_CONVOUT, IN_MLIN, IN_MLGB, IN_MLNW, IN_MLOUT,
       IN_RW, IN_RB, IN_EG, IN_EU, IN_ED, IN_SG, IN_SU, IN_SD, IN_FNW, N_IN };
struct Args { const float* in[N_IN]; float* out; unsigned char* ws; int ph_lo, ph_hi, li, pad; };

#define INP(i) ((const gf32*)F.a->in[i])
struct Frame {
    LAS unsigned char* lds;
    int tid, lane, wave, bid;
    const Args* a; gf32* out; gu8* ws;
};

__device__ __forceinline__ const gf32* mod_ptr(const Frame& F, int layer, int mr, int chunk) { return (const gf32*)(F.ws + WS_MOD) + ((size_t)(layer * 9 + mr) * ADA_N + (size_t)chunk * D); }
__device__ __forceinline__ int mod_row(int r) { return r < NCTX ? 8 : ((r - NCTX) >> 11); }

struct EpiConvIn {
    static constexpr bool PERM = true; static constexpr int MXE0 = 0, MXE1 = 0;
    gbf16* U; gbf16* BMt;
    __device__ __forceinline__ void operator()(const f32x4 (&acc)[2][2][4][2], const Unit& u, int wr, int wc, int fr, int fq) const {
        const int row0 = u.pm * 256 + wr * 64 + fr;
        if (u.pn < 16) {
            const int col = u.pn * 128 + wc * 32 + 8 * fq;
#pragma unroll
            for (int ai = 0; ai < 2; ++ai)
#pragma unroll
                for (int m = 0; m < 4; ++m) {
                    const f32x4 a0 = acc[ai][0][m][0] * acc[ai][1][m][0], a1 = acc[ai][0][m][1] * acc[ai][1][m][1];
                    u32x4 w; w.x = cvt_pk_bf16(a0[0], a0[1]); w.y = cvt_pk_bf16(a0[2], a0[3]); w.z = cvt_pk_bf16(a1[0], a1[1]); w.w = cvt_pk_bf16(a1[2], a1[3]);
                    *(gu32x4*)(U + (size_t)(row0 + ai * 128 + m * 16) * D + col) = w; }
        } else {
            const int col = (u.pn - 16) * 256 + wc * 32 + 8 * fq;
#pragma unroll
            for (int ai = 0; ai < 2; ++ai)
#pragma unroll
                for (int m = 0; m < 4; ++m)
#pragma unroll
                    for (int bj = 0; bj < 2; ++bj) {
                        const f32x4 a0 = acc[ai][bj][m][0], a1 = acc[ai][bj][m][1];
                        u32x4 w; w.x = cvt_pk_bf16(a0[0], a0[1]); w.y = cvt_pk_bf16(a0[2], a0[3]); w.z = cvt_pk_bf16(a1[0], a1[1]); w.w = cvt_pk_bf16(a1[2], a1[3]);
                        *(gu32x4*)(BMt + (size_t)(row0 + ai * 128 + m * 16) * D + col + bj * 128) = w; }
        }
    }
};
struct EpiResid {
    static constexpr bool PERM = false; static constexpr int MXE0 = 0, MXE1 = 0;
    const gf32* base_ctx; const gf32* base_lat; gf32* X; const gf32* gmod; int row_off;
    __device__ __forceinline__ void operator()(const f32x4 (&acc)[2][2][4][2], const Unit& u, int wr, int wc, int fr, int fq) const {
        const int R0 = row_off + u.pm * 256;
        const gf32* base = (R0 < NCTX) ? base_ctx + (size_t)R0 * D : base_lat + (size_t)(R0 - NCTX) * D;
        const gf32* g = gmod + (size_t)mod_row(R0) * ADA_N;
        gf32* o = X + (size_t)R0 * D;
        const int rl0 = wr * 64 + fr, col0 = u.pn * 256 + wc * 32 + 4 * fq;
        f32x4 gv[2][2];
#pragma unroll
        for (int bj = 0; bj < 2; ++bj)
#pragma unroll
            for (int n = 0; n < 2; ++n) gv[bj][n] = *(const gf32x4*)(g + col0 + bj * 128 + n * 16);
#pragma unroll
        for (int ah = 0; ah < 4; ++ah) { const int ai = ah >> 1, m0 = (ah & 1) * 2;
            f32x4 bv[2][2][2];
#pragma unroll
            for (int mm = 0; mm < 2; ++mm) { const size_t ro = (size_t)(rl0 + ai * 128 + (m0 + mm) * 16) * D + col0;
#pragma unroll
                for (int bj = 0; bj < 2; ++bj)
#pragma unroll
                    for (int n = 0; n < 2; ++n) bv[mm][bj][n] = *(const gf32x4*)(base + ro + bj * 128 + n * 16); }
#pragma unroll
            for (int mm = 0; mm < 2; ++mm) { const size_t ro = (size_t)(rl0 + ai * 128 + (m0 + mm) * 16) * D + col0;
#pragma unroll
                for (int bj = 0; bj < 2; ++bj)
#pragma unroll
                    for (int n = 0; n < 2; ++n) *(gf32x4*)(o + ro + bj * 128 + n * 16) = bv[mm][bj][n] + gv[bj][n] * acc[ai][bj][m0 + mm][n]; } }
    }
};
__device__ __forceinline__ float softcap_gate(float g) {
    const float e = fast_exp(-2.0f * g * (1.0f / 15.0f)); return 15.0f * (1.0f - e) / (1.0f + e);
}
__device__ __forceinline__ float log_sigmoid_(float g) { return fminf(g, 0.0f) - __logf(1.0f + fast_exp(-fabsf(g))); }
struct EpiMlstmIn {
    static constexpr bool PERM = true; static constexpr int MXE0 = 0, MXE1 = 0;
    gbf16 *Q, *Kb, *V, *O;
    __device__ __forceinline__ void operator()(const f32x4 (&acc)[2][2][4][2], const Unit& u, int wr, int wc, int fr, int fq) const {
        const int row0 = u.pm * 256 + wr * 64 + fr;
        {
            gbf16* dst; int ld, ct; float sc = 1.0f;
            if (u.pn < 4) { dst = Q; ld = 1024; ct = u.pn; } else if (u.pn < 8) { dst = Kb; ld = 1024; ct = u.pn - 4; sc = 0.08838834764831845f; }
            else if (u.pn < 16) { dst = V; ld = 2048; ct = u.pn - 8; } else { dst = O; ld = 2048; ct = u.pn - 16; }
            const int col = ct * 256 + wc * 32 + 8 * fq;
#pragma unroll
            for (int ai = 0; ai < 2; ++ai)
#pragma unroll
                for (int m = 0; m < 4; ++m)
#pragma unroll
                    for (int bj = 0; bj < 2; ++bj) {
                        const f32x4 a0 = acc[ai][bj][m][0] * sc, a1 = acc[ai][bj][m][1] * sc;
                        u32x4 w; w.x = cvt_pk_bf16(a0[0], a0[1]); w.y = cvt_pk_bf16(a0[2], a0[3]); w.z = cvt_pk_bf16(a1[0], a1[1]); w.w = cvt_pk_bf16(a1[2], a1[3]);
                        *(gu32x4*)(dst + (size_t)(row0 + ai * 128 + m * 16) * ld + col + bj * 128) = w; }
        }
    }
};
struct EpiSwiglu {
    static constexpr bool PERM = true;
    static constexpr int MXE0 = -6, MXE1 = -2;
    gu8* ACT;
    __device__ __forceinline__ void operator()(const f32x4 (&acc)[2][2][4][2], const Unit& u, int wr, int wc, int fr, int fq) const {
        const int row0 = u.row0 + wr * 64 + fr, col = u.pn * 128 + wc * 32 + 8 * fq;
#pragma unroll
        for (int ai = 0; ai < 2; ++ai)
#pragma unroll
            for (int m = 0; m < 4; ++m) {
                f32x4 a0, a1;
#pragma unroll
                for (int j = 0; j < 4; ++j) { a0[j] = siluf_(acc[ai][0][m][0][j]) * acc[ai][1][m][0][j]; a1[j] = siluf_(acc[ai][0][m][1][j]) * acc[ai][1][m][1][j]; }
                u32x2 w; w.x = pk4_fp8(a0); w.y = pk4_fp8(a1);
                *(gu32x2*)(ACT + (size_t)(row0 + ai * 128 + m * 16) * ED + col) = w; }
    }
};
struct EpiDown {
    static constexpr bool PERM = true;
    static constexpr int MXE0 = -9, MXE1 = -9;
    gu8* Y;
    __device__ __forceinline__ void operator()(const f32x4 (&acc)[2][2][4][2], const Unit& u, int wr, int wc, int fr, int fq) const {
        const int row0 = u.row0 + wr * 64 + fr, col = u.pn * 256 + wc * 64 + 16 * fq;
#pragma unroll
        for (int ai = 0; ai < 2; ++ai)
#pragma unroll
            for (int m = 0; m < 4; ++m) { const int slot = row0 + ai * 128 + m * 16;
                u32x4 w; w.x = pk4_fp8(acc[ai][0][m][0]); w.y = pk4_fp8(acc[ai][0][m][1]); w.z = pk4_fp8(acc[ai][1][m][0]); w.w = pk4_fp8(acc[ai][1][m][1]);
                *(gu32x4*)(Y + (size_t)slot * D + col) = w; }
    }
};

constexpr int LDS_UNITS = RING_BYTES;
struct ExpertOrder {
    const LAS i32x4* units; const gchar* A; const gchar* Bt; const gi32* tok_of; int K, erows;
    __device__ __forceinline__ bool next(int i, Unit& u) const {
        const i32x4 d = units[i];
        u.e = __builtin_amdgcn_readfirstlane(d.x); u.pm = __builtin_amdgcn_readfirstlane(d.y); u.pn = __builtin_amdgcn_readfirstlane(d.z); u.row0 = __builtin_amdgcn_readfirstlane(d.w);
        return u.e >= 0;
    }
    __device__ __forceinline__ const gchar* a_base(const Unit& u) const { return tok_of ? A : A + (size_t)u.row0 * K * 2; }
    __device__ __forceinline__ const gchar* b_base(const Unit& u) const { return Bt + ((size_t)u.e * erows + (size_t)u.pn * 256) * K * 2; }
    __device__ __forceinline__ int gather_row(const Unit& u, int r) const { return tok_of[u.row0 + r]; }
};
__device__ __forceinline__ const LAS i32x4* stage_units(Frame& F, const gi32x4* g, int n) {
    LAS i32x4* l = (LAS i32x4*)(F.lds + LDS_UNITS);
    if (F.tid < n) l[F.tid] = g[F.tid];
    __syncthreads();
    return l;
}
__device__ __forceinline__ bool class_unit(const LAS int* tot, const LAS int* pst, int x, int q, int npn, int shs, int shn, i32x4& d) {
#pragma unroll 1
    for (int kk = 0; kk < 8; ++kk) { const int e = x + 8 * kk; const int n = ((tot[e] + 255) >> 8) * npn;
        if (q < n) { const int mt = q / npn; d = (i32x4){e, mt, q - mt * npn, pst[e] + 256 * mt}; return true; } q -= n; }
    if (q < shn * npn) { const int mt = shs + q / npn; d = (i32x4){64, mt, q % npn, SH_BASE + 256 * mt}; return true; }
    d = (i32x4){-1, 0, 0, 0}; return false;
}
__device__ __forceinline__ void shared_share(const LAS int* rt, int S, int x, int& shs, int& shn) {
    int R = 0;
#pragma unroll
    for (int y = 0; y < 8; ++y) R += rt[y];
    int lv = (R + S + 7) >> 3;
#pragma unroll 1
    for (;;) { int cap = 0;
#pragma unroll
        for (int y = 0; y < 8; ++y) cap += max(0, lv - rt[y]);
        if (cap >= S) break; ++lv; }
    int left = S; shs = 0; shn = 0;
#pragma unroll
    for (int y = 0; y < 8; ++y) { const int n = min(max(0, lv - rt[y]), left); if (y == x) { shs = S - left; shn = n; } left -= n; }
}

__device__ __forceinline__ int down_row(int c) { return (c & ~255) + 128 * ((c >> 3) & 1) + 32 * ((c >> 6) & 3) + 8 * ((c >> 4) & 3) + (c & 7); }
__device__ __forceinline__ void tr_item(const gf32* __restrict__ W, int ldw, int K, gbf16* WT, int drow, int k0, int n0src, LAS float* scr, int lane, bool dperm = false, float fp8 = 0.f) {
    float tv[32];
    const gf32* wp = W + (size_t)(k0 + (lane >> 5)) * ldw + n0src + (lane & 31);
#pragma unroll
    for (int i = 0; i < 32; ++i) tv[i] = __builtin_nontemporal_load(wp + (size_t)(2 * i) * ldw);
#pragma unroll
    for (int i = 0; i < 32; ++i) scr[(2 * i + (lane >> 5)) * 33 + (lane & 31)] = tv[i];
    LDS_WAIT(); asm volatile("" ::: "memory");
    if (fp8 != 0.f) {
        const int c4 = lane & 3; gu8* W8 = (gu8*)WT;
#pragma unroll
        for (int j = 0; j < 2; ++j) { const int n = (lane >> 2) + 16 * j; const LAS float* s = scr + (16 * c4) * 33 + n; u32x4 o;
#pragma unroll
            for (int q = 0; q < 4; ++q) o[q] = pk4_fp8((f32x4){s[(4 * q) * 33], s[(4 * q + 1) * 33], s[(4 * q + 2) * 33], s[(4 * q + 3) * 33]} * fp8);
            *(gu32x4*)(W8 + (size_t)(dperm ? down_row(drow + n) : drow + n) * K + k0 + 16 * c4) = o; }
        LDS_WAIT(); asm volatile("" ::: "memory");
        return; }
    const int c = lane & 7;
#pragma unroll
    for (int j = 0; j < 4; ++j) { const int n = (lane >> 3) + 8 * j; const LAS float* s = scr + (8 * c) * 33 + n;
        u32x4 o; o.x = cvt_pk_bf16(s[0 * 33], s[1 * 33]); o.y = cvt_pk_bf16(s[2 * 33], s[3 * 33]); o.z = cvt_pk_bf16(s[4 * 33], s[5 * 33]); o.w = cvt_pk_bf16(s[6 * 33], s[7 * 33]);
        *(gu32x4*)(WT + (size_t)(dperm ? down_row(drow + n) : drow + n) * K + k0 + 8 * c) = o; }
    LDS_WAIT(); asm volatile("" ::: "memory");
}
__device__ __forceinline__ void tr_job(int r, const gf32* src, int ldw, int col0, int K, int N, size_t sbatch, gbf16* dst, size_t dbatch, int row_off, int seg, int segs, LAS float* scr, int lane, bool dperm = false, float fp8 = 0.f) {
    const int nblk = N >> 5, ipb = (K >> 6) * nblk;
    const int bt = r / ipb, rr = r - bt * ipb, kb = rr / nblk, nb = rr - kb * nblk, n0 = nb << 5;
    tr_item(src + (size_t)bt * sbatch, ldw, K, dst + (size_t)bt * dbatch, row_off + (n0 / seg) * segs + (n0 % seg), kb << 6, col0 + n0, scr, lane, dperm, fp8);
}
__device__ __forceinline__ void phase_prologue(Frame& F) {
    if (F.bid < 192) {
        LAS float* cond = (LAS float*)F.lds;
        LAS float* red = (LAS float*)(F.lds + 9 * 2048 * 4);
        for (int i = F.tid; i < 9 * 2048; i += NTHR) { const int r = i >> 11, k = i & 2047; const float v = (r < 8) ? INP(IN_C)[r * D + k] : INP(IN_CCTX)[k]; cond[i] = siluf_(v); }
        __syncthreads();
        const int l = F.bid / 96, col0 = (F.bid % 96) * 128, cg = F.tid & 31, kl = F.tid >> 5;
        const gf32* W = INP(IN_ADAW) + (size_t)l * D * ADA_N + col0 + 4 * cg;
        f32x4 acc[9];
#pragma unroll
        for (int r = 0; r < 9; ++r) acc[r] = (f32x4){0.f, 0.f, 0.f, 0.f};
#pragma unroll 8
        for (int k = kl; k < D; k += 16) { const f32x4 w4 = __builtin_nontemporal_load((const gf32x4*)(W + (size_t)k * ADA_N));
#pragma unroll
            for (int r = 0; r < 9; ++r) acc[r] += cond[r * 2048 + k] * w4; }
#pragma unroll
        for (int r = 0; r < 9; ++r) *(LAS f32x4*)(red + (kl * 9 + r) * 128 + 4 * cg) = acc[r];
        __syncthreads();
        gf32* mod = (gf32*)(F.ws + WS_MOD);
        for (int o = F.tid; o < 9 * 128; o += NTHR) { const int r = o >> 7, c = o & 127; float s = 0.f;
#pragma unroll
            for (int q = 0; q < 16; ++q) s += red[(q * 9 + r) * 128 + c];
            mod[(size_t)(l * 9 + r) * ADA_N + col0 + c] = s + INP(IN_ADAB)[l * ADA_N + col0 + c]; }
        __syncthreads();
    }
    LAS float* scr = (LAS float*)(F.lds + F.wave * 8704);
    const int gw = F.bid * NWAVES + F.wave, NGW = GRID * NWAVES;
    gbf16* convin_t = (gbf16*)(F.ws + WS_CONVIN_T); gbf16* convout_t = (gbf16*)(F.ws + WS_CONVOUT_T);
    gbf16* mlin_t = (gbf16*)(F.ws + WS_MLIN_T); gbf16* mlout_t = (gbf16*)(F.ws + WS_MLOUT_T);
    constexpr int I_SQ = 32 * 64, I_MLIN = 32 * 193, I_RT = 32 * 2, I_EGU = 64 * 32 * 16, I_EDN = 64 * 8 * 64, I_SGU = 32 * 16, I_SDN = 8 * 64;
    constexpr int I_MOE = I_RT + 2 * I_EGU + I_EDN + 2 * I_SGU + I_SDN;
    constexpr int NITEMS = 4 * I_SQ + I_MLIN + I_SQ + 2 * I_MOE;
    gi32* ctr = (gi32*)(F.ws + WS_CTL) + CW_P0CTR;
    (void)gw; (void)NGW;
    for (;;) {
        int base = 0; if (F.lane == 0) base = __hip_atomic_fetch_add(ctr, 16, __ATOMIC_RELAXED, __HIP_MEMORY_SCOPE_AGENT);
        base = __builtin_amdgcn_readfirstlane(base);
        if (base >= NITEMS) break;
        const int lim = (base + 16 < NITEMS) ? base + 16 : NITEMS;
      for (int it = base; it < lim; ++it) {
        int r = it;
        if (r < I_SQ) { tr_job(r, INP(IN_CONVIN), 3 * D, 2048, D, D, 0, convin_t, 0, 0, 128, 256, scr, F.lane); continue; } r -= I_SQ;
        if (r < I_SQ) { tr_job(r, INP(IN_CONVIN), 3 * D, 4096, D, D, 0, convin_t, 0, 128, 128, 256, scr, F.lane); continue; } r -= I_SQ;
        if (r < I_SQ) { tr_job(r, INP(IN_CONVIN), 3 * D, 0, D, D, 0, convin_t, 0, 4096, D, 0, scr, F.lane); continue; } r -= I_SQ;
        if (r < I_SQ) { tr_job(r, INP(IN_CONVOUT), D, 0, D, D, 0, convout_t, 0, 0, D, 0, scr, F.lane); continue; } r -= I_SQ;
        if (r < I_MLIN) { tr_job(r, INP(IN_MLIN), MLSTM_N, 0, D, MLSTM_N, 0, mlin_t, 0, 0, 8192, 0, scr, F.lane); continue; } r -= I_MLIN;
        if (r < I_SQ) { tr_job(r, INP(IN_MLOUT), D, 0, D, D, 0, mlout_t, 0, 0, D, 0, scr, F.lane); continue; } r -= I_SQ;
        const int l = r / I_MOE; r -= l * I_MOE;
        gu8* moe = F.ws + WS_MOE0 + (size_t)l * MOE_STRIDE;
        gbf16* gu_t = (gbf16*)(moe + MOE_GU); gbf16* dn_t = (gbf16*)(moe + MOE_DN); gbf16* rt_t = (gbf16*)(moe + MOE_RT);
        if (r < I_RT) { tr_job(r, INP(IN_RW) + (size_t)l * D * NE, NE, 0, D, NE, 0, rt_t, 0, 0, NE, 0, scr, F.lane); continue; } r -= I_RT;
        if (r < I_EGU) { tr_job(r, INP(IN_EG) + (size_t)l * NE * D * ED, ED, 0, D, ED, (size_t)D * ED, gu_t, (size_t)512 * D, 0, 128, 256, scr, F.lane, false, GU_WSCALE); continue; } r -= I_EGU;
        if (r < I_EGU) { tr_job(r, INP(IN_EU) + (size_t)l * NE * D * ED, ED, 0, D, ED, (size_t)D * ED, gu_t, (size_t)512 * D, 128, 128, 256, scr, F.lane, false, GU_WSCALE); continue; } r -= I_EGU;
        if (r < I_EDN) { tr_job(r, INP(IN_ED) + (size_t)l * NE * ED * D, D, 0, ED, D, (size_t)ED * D, dn_t, (size_t)D * ED / 2, 0, D, 0, scr, F.lane, true, DN_WSCALE); continue; } r -= I_EDN;
        if (r < I_SGU) { tr_job(r, INP(IN_SG) + (size_t)l * D * ED, ED, 0, D, ED, 0, gu_t + (size_t)64 * 512 * D, 0, 0, 128, 256, scr, F.lane, false, GU_WSCALE); continue; } r -= I_SGU;
        if (r < I_SGU) { tr_job(r, INP(IN_SU) + (size_t)l * D * ED, ED, 0, D, ED, 0, gu_t + (size_t)64 * 512 * D, 0, 128, 128, 256, scr, F.lane, false, GU_WSCALE); continue; } r -= I_SGU;
        tr_job(r, INP(IN_SD) + (size_t)l * ED * D, D, 0, ED, D, 0, dn_t + (size_t)64 * D * ED / 2, 0, 0, D, 0, scr, F.lane, true, DN_WSCALE);
      }
    }
    { gu32x4* z = (gu32x4*)(mlin_t + (size_t)MLSTM_N * D); const int n16 = (MLSTM_NP - MLSTM_N) * D * 2 / 16;
      for (int i = F.bid * NTHR + F.tid; i < n16; i += GRID * NTHR) z[i] = (u32x4){0u, 0u, 0u, 0u}; }
}

template <bool LB> __device__ __forceinline__ int col_of(int lane, int j) { return LB ? 16 * lane + 1024 * (j >> 2) + 4 * (j & 3) : 4 * lane + 256 * j; }
template <bool TO_LDS, bool LB = false>
__device__ __forceinline__ void norm_mod_store(const f32x4 (&v)[8], float rstd, const gf32* w, const gf32* shift, const gf32* scale, gbf16* orow, LAS bf16_t* lrow, int lane) {
#pragma unroll
    for (int j = 0; j < 8; ++j) { const int c = col_of<LB>(lane, j);
        const f32x4 w4 = *(const gf32x4*)(w + c), sc = *(const gf32x4*)(scale + c), sh = *(const gf32x4*)(shift + c);
        const f32x4 y = (v[j] * rstd) * w4 * (sc + 1.0f) + sh;
        u32x2 o; o.x = cvt_pk_bf16(y[0], y[1]); o.y = cvt_pk_bf16(y[2], y[3]);
        *(gu32x2*)(orow + c) = o;
        if (TO_LDS) *(LAS u32x2*)(lrow + c) = o; }
}
__device__ __forceinline__ float row_ssq(const f32x4 (&v)[8]) {
    float s = 0.f;
#pragma unroll
    for (int j = 0; j < 8; ++j) s += (v[j][0] * v[j][0] + v[j][1] * v[j][1]) + (v[j][2] * v[j][2] + v[j][3] * v[j][3]);
    return wave_sum(s);
}

__device__ __forceinline__ void phase_norm0(Frame& F) {
    gbf16* H = (gbf16*)(F.ws + WS_H);
    const int gw = F.bid * NWAVES + F.wave, NGW = GRID * NWAVES;
    for (int r = gw; r < NTOK; r += NGW) {
        const gf32* xr = (r < NCTX) ? INP(IN_CTX) + (size_t)r * D : INP(IN_X) + (size_t)(r - NCTX) * D;
        f32x4 v[8];
#pragma unroll
        for (int j = 0; j < 8; ++j) v[j] = *(const gf32x4*)(xr + 4 * F.lane + 256 * j);
        const float rstd = rsqrtf(row_ssq(v) * (1.0f / D) + EPS);
        const int mr = mod_row(r);
        norm_mod_store<false>(v, rstd, INP(IN_NMIXW), mod_ptr(F, 0, mr, 0), mod_ptr(F, 0, mr, 1), H + (size_t)r * D, (LAS bf16_t*)F.lds, F.lane);
    }
}

__device__ __forceinline__ void phase_conv(Frame& F) {
    const gbf16* U = (const gbf16*)(F.ws + WS_U); const gbf16* BMt = (const gbf16*)(F.ws + WS_BM); gbf16* Z = (gbf16*)(F.ws + WS_Z);
    const gf32* dw = INP(IN_CONVDW);
    const int total = NTOK * (D / 8);
    for (int i = F.bid * NTHR + F.tid; i < total; i += GRID * NTHR) {
        const int r = i >> 8, c = (i & 255) * 8;
        const int pos = (r < NCTX) ? (r & 255) : (r & 63), seglen = (r < NCTX) ? 256 : 64;
        const u32x4 z4 = (u32x4){0u, 0u, 0u, 0u};
        const u32x4 um = (pos > 0) ? *(const gu32x4*)(U + (size_t)(r - 1) * D + c) : z4;
        const u32x4 u0 = *(const gu32x4*)(U + (size_t)r * D + c);
        const u32x4 up = (pos < seglen - 1) ? *(const gu32x4*)(U + (size_t)(r + 1) * D + c) : z4;
        const u32x4 bb = *(const gu32x4*)(BMt + (size_t)r * D + c);
        float w0[8], w1[8], w2[8];
#pragma unroll
        for (int q = 0; q < 2; ++q) { const f32x4 a = *(const gf32x4*)(dw + c + 4 * q), b = *(const gf32x4*)(dw + D + c + 4 * q), d = *(const gf32x4*)(dw + 2 * D + c + 4 * q);
#pragma unroll
            for (int j = 0; j < 4; ++j) { w0[4 * q + j] = a[j]; w1[4 * q + j] = b[j]; w2[4 * q + j] = d[j]; } }
        u32x4 o;
#pragma unroll
        for (int q = 0; q < 4; ++q) {
            const float y0 = bf_lo(bb[q]) * (w0[2 * q] * bf_lo(um[q]) + w1[2 * q] * bf_lo(u0[q]) + w2[2 * q] * bf_lo(up[q]));
            const float y1 = bf_hi(bb[q]) * (w0[2 * q + 1] * bf_hi(um[q]) + w1[2 * q + 1] * bf_hi(u0[q]) + w2[2 * q + 1] * bf_hi(up[q]));
            o[q] = cvt_pk_bf16(y0, y1); }
        *(gu32x4*)(Z + (size_t)r * D + c) = o;
    }
}

constexpr int HS_PITCH = 2056;
constexpr int RL_HS = 0, RL_PART = 16 * HS_PITCH * 2, RL_LOGIT = RL_PART + 8 * 16 * 64 * 4, RL_IDX = RL_LOGIT + 16 * 64 * 4;
template <int NT>
__device__ __forceinline__ void tile16_mfma(const LAS bf16_t* hs, const gbf16* Wt, LAS float* part, int wave, int lane) {
    f32x4 acc[NT];
#pragma unroll
    for (int nt = 0; nt < NT; ++nt) acc[nt] = (f32x4){0.f, 0.f, 0.f, 0.f};
    const int fr = lane & 15, fq = lane >> 4;
#pragma unroll 4
    for (int ks = 0; ks < 8; ++ks) { const int k0 = 256 * wave + 32 * ks + 8 * fq;
        const bf16x8 a = *(const LAS bf16x8*)(hs + fr * HS_PITCH + k0);
#pragma unroll
        for (int nt = 0; nt < NT; ++nt) { const bf16x8 b = *(const gbf16x8*)(Wt + (size_t)(16 * nt + fr) * D + k0);
            acc[nt] = __builtin_amdgcn_mfma_f32_16x16x32_bf16(a, b, acc[nt], 0, 0, 0); } }
#pragma unroll
    for (int nt = 0; nt < NT; ++nt)
#pragma unroll
        for (int j = 0; j < 4; ++j) part[wave * (256 * NT) + (4 * fq + j) * (16 * NT) + 16 * nt + fr] = acc[nt][j];
}
constexpr int R_HS = 0, R_PART = 0, R_LOGIT = 32 * HS_PITCH * 2, R_VSEL = R_LOGIT + 8192, R_TSC = R_VSEL + 8192, R_BIDX = R_TSC + 1024, R_CNT = R_BIDX + 1728;
static_assert(R_CNT + 2048 <= LDSCTL_OFF, "router LDS map");
__device__ __forceinline__ void phase_router(Frame& F, int layer, int rowbase, int rpb) {
    const gf32* X = (const gf32*)(F.ws + WS_X); gu8* H8 = (gu8*)(F.ws + WS_H8);
    const gbf16* rt_t = (const gbf16*)(F.ws + WS_MOE0 + (size_t)layer * MOE_STRIDE + MOE_RT);
    gi32* sel_idx = (gi32*)(F.ws + RT_SELIDX); gf32* sel_gate = (gf32*)(F.ws + RT_SELGATE); gi32* sel_rank = (gi32*)(F.ws + RT_SELRANK); gi32* hist = (gi32*)(F.ws + RT_HIST);
    LAS bf16_t* hs = (LAS bf16_t*)(F.lds + R_HS); LAS float* part = (LAS float*)(F.lds + R_PART); LAS float* logit = (LAS float*)(F.lds + R_LOGIT);
    LAS float* vsel = (LAS float*)(F.lds + R_VSEL); LAS float* tsc = (LAS float*)(F.lds + R_TSC); LAS int* bidx = (LAS int*)(F.lds + R_BIDX); LAS int* wcnt = (LAS int*)(F.lds + R_CNT);
    const int r0 = rowbase + F.bid * rpb, ngroups = (rpb + 31) >> 5;
    const gf32* nw = INP(IN_NFFNW) + layer * D; const float bias = INP(IN_RB)[layer * NE + F.lane];
    const int fr = F.lane & 15, fq = F.lane >> 4;
#define RT_BAR() do { asm volatile("s_waitcnt lgkmcnt(0)" ::: "memory"); __builtin_amdgcn_s_barrier(); asm volatile("" ::: "memory"); } while (0)
    f32x4 cw[8], cs[8]; int cur_mr = -1;
    for (int g = 0; g < ngroups; ++g) {
#pragma unroll 1
        for (int pr = 0; pr < 2; ++pr) { const int lr = 4 * F.wave + 2 * pr, br = 32 * g + lr; LAS bf16_t* lrow = hs + lr * HS_PITCH;
            if (br < rpb) { const int r = r0 + br, mr = mod_row(r); const gf32* xr = X + (size_t)r * D; f32x4 va[8], vb[8];
#pragma unroll
                for (int j = 0; j < 8; ++j) { va[j] = *(const gf32x4*)(xr + 4 * F.lane + 256 * j); vb[j] = *(const gf32x4*)(xr + D + 4 * F.lane + 256 * j); }
                if (mr != cur_mr) { cur_mr = mr; const gf32* sc = mod_ptr(F, layer, mr, 4); const gf32* sh = mod_ptr(F, layer, mr, 3);
#pragma unroll
                    for (int j = 0; j < 8; ++j) { const int c = 4 * F.lane + 256 * j; cw[j] = *(const gf32x4*)(nw + c) * (*(const gf32x4*)(sc + c) + 1.0f); cs[j] = *(const gf32x4*)(sh + c); } }
                const float rstd0 = rsqrtf(row_ssq(va) * (1.0f / D) + EPS), rstd1 = rsqrtf(row_ssq(vb) * (1.0f / D) + EPS);
#pragma unroll
                for (int j = 0; j < 8; ++j) { const int c = 4 * F.lane + 256 * j;
                    const f32x4 y0 = (va[j] * rstd0) * cw[j] + cs[j], y1 = (vb[j] * rstd1) * cw[j] + cs[j];
                    u32x2 o0, o1; o0.x = cvt_pk_bf16(y0[0], y0[1]); o0.y = cvt_pk_bf16(y0[2], y0[3]); o1.x = cvt_pk_bf16(y1[0], y1[1]); o1.y = cvt_pk_bf16(y1[2], y1[3]);
                    *(GAS unsigned*)(H8 + (size_t)r * D + c) = pk4_fp8(y0); *(GAS unsigned*)(H8 + (size_t)(r + 1) * D + c) = pk4_fp8(y1);
                    *(LAS u32x2*)(lrow + c) = o0; *(LAS u32x2*)(lrow + HS_PITCH + c) = o1; }
            } else {
#pragma unroll
                for (int j = 0; j < 8; ++j) { *(LAS u32x2*)(lrow + 4 * F.lane + 256 * j) = (u32x2){0u, 0u}; *(LAS u32x2*)(lrow + HS_PITCH + 4 * F.lane + 256 * j) = (u32x2){0u, 0u}; } } }
        RT_BAR();
        f32x4 acc[2][4];
#pragma unroll
        for (int t = 0; t < 2; ++t)
#pragma unroll
            for (int nt = 0; nt < 4; ++nt) acc[t][nt] = (f32x4){0.f, 0.f, 0.f, 0.f};
#pragma unroll 4
        for (int ks = 0; ks < 8; ++ks) { const int k0 = 256 * F.wave + 32 * ks + 8 * fq;
            const bf16x8 a0 = *(const LAS bf16x8*)(hs + fr * HS_PITCH + k0), a1 = *(const LAS bf16x8*)(hs + (16 + fr) * HS_PITCH + k0);
#pragma unroll
            for (int nt = 0; nt < 4; ++nt) { const bf16x8 bfr = *(const gbf16x8*)(rt_t + (size_t)(16 * nt + fr) * D + k0);
                acc[0][nt] = __builtin_amdgcn_mfma_f32_16x16x32_bf16(a0, bfr, acc[0][nt], 0, 0, 0); acc[1][nt] = __builtin_amdgcn_mfma_f32_16x16x32_bf16(a1, bfr, acc[1][nt], 0, 0, 0); } }
        RT_BAR();
#pragma unroll
        for (int t = 0; t < 2; ++t)
#pragma unroll
            for (int nt = 0; nt < 4; ++nt)
#pragma unroll
                for (int j = 0; j < 4; ++j) part[F.wave * 2048 + (16 * t + 4 * fq + j) * 64 + 16 * nt + fr] = acc[t][nt][j];
        RT_BAR();
#pragma unroll
        for (int q = 0; q < 4; ++q) { const int o = F.tid + 512 * q; float s = 0.f;
#pragma unroll
            for (int w = 0; w < 8; ++w) s += part[w * 2048 + o];
            const float sc = sigmoidf_(s); logit[o] = sc; vsel[o] = sc + bias; }
        RT_BAR();
#pragma unroll 1
        for (int q = 0; q < 4; ++q) { const int lr = 4 * F.wave + q, br = 32 * g + lr;
            if (br < rpb) { const int r = r0 + br;
                const float myv = vsel[lr * 64 + F.lane], mysc = logit[lr * 64 + F.lane]; int rank = 0;
#pragma unroll 4
                for (int j4 = 0; j4 < 16; ++j4) { const f32x4 o = *(const LAS f32x4*)(vsel + lr * 64 + 4 * j4);
#pragma unroll
                    for (int t = 0; t < 4; ++t) rank += (o[t] > myv || (o[t] == myv && (4 * j4 + t) < F.lane)) ? 1 : 0; }
                const bool sel = rank < TOPK;
                if (sel) tsc[lr * 8 + rank] = mysc;
                asm volatile("s_waitcnt lgkmcnt(0)" ::: "memory");
                float ssum = 0.f;
#pragma unroll
                for (int k = 0; k < TOPK; ++k) ssum += tsc[lr * 8 + k];
                if (sel) { sel_idx[(size_t)r * TOPK + rank] = F.lane; sel_gate[(size_t)r * TOPK + rank] = mysc / ssum * 2.5f; bidx[br * TOPK + rank] = F.lane; } } }
    }
    __syncthreads();
    { const int rw = rpb >> 3, rb = F.wave * rw; int cnt = 0;
      for (int rr = rb; rr < rb + rw; ++rr) {
#pragma unroll
          for (int k = 0; k < TOPK; ++k) cnt += (bidx[rr * TOPK + k] == F.lane) ? 1 : 0; }
      wcnt[F.wave * 64 + F.lane] = cnt;
      __syncthreads();
      int base = 0, tot = 0;
#pragma unroll
      for (int w = 0; w < 8; ++w) { const int c = wcnt[w * 64 + F.lane]; base += (w < F.wave) ? c : 0; tot += c; }
      for (int rr = rb; rr < rb + rw; ++rr) {
#pragma unroll
          for (int k = 0; k < TOPK; ++k) { if (bidx[rr * TOPK + k] == F.lane) { sel_rank[(size_t)(r0 + rr) * TOPK + k] = base; ++base; } } }
      if (F.wave == 0) hist[F.bid * NE + F.lane] = tot; }
    __syncthreads();
#undef RT_BAR
}

__device__ __forceinline__ void phase_scatter(Frame& F, int rowbase, int rpb, int ntok) {
    const gi32* hist = (const gi32*)(F.ws + RT_HIST); gi32* einfo = (gi32*)(F.ws + RT_EINFO);
    const gi32* sel_idx = (const gi32*)(F.ws + RT_SELIDX); const gf32* sel_gate = (const gf32*)(F.ws + RT_SELGATE); const gi32* sel_rank = (const gi32*)(F.ws + RT_SELRANK);
    gi32* slot_of = (gi32*)(F.ws + RT_SLOTOF); gi32* tok_of = (gi32*)(F.ws + RT_TOKOF); gf32* gate_of = (gf32*)(F.ws + RT_GATEOF);
    LAS int* tot8 = (LAS int*)F.lds; LAS int* pre8 = tot8 + 512; LAS int* tot = pre8 + 512; LAS int* boff = tot + 64; LAS int* pst = boff + 64;
    { const int e = F.tid & 63, p = F.tid >> 6; int s = 0, pre = 0;
      for (int b = 32 * p; b < 32 * p + 32; ++b) { const int h = hist[b * NE + e]; s += h; pre += (b < F.bid) ? h : 0; }
      tot8[p * 64 + e] = s; pre8[p * 64 + e] = pre; }
    __syncthreads();
    if (F.tid < 64) { int s = 0, pre = 0;
#pragma unroll
        for (int p = 0; p < 8; ++p) { s += tot8[p * 64 + F.tid]; pre += pre8[p * 64 + F.tid]; }
        tot[F.tid] = s; boff[F.tid] = pre; }
    __syncthreads();
    LAS int* rtl = pst + 64;
    if (F.tid == 0) { int a = 0; for (int e = 0; e < NE; ++e) { pst[e] = a; a += (tot[e] + 255) & ~255; } }
    if (F.tid >= 64 && F.tid < 72) { const int x = F.tid - 64; int t = 0;
#pragma unroll
        for (int kk = 0; kk < 8; ++kk) t += (tot[x + 8 * kk] + 255) >> 8;
        rtl[x] = t; }
    __syncthreads();
    const int r0 = rowbase + F.bid * rpb;
    for (int a = F.tid; a < rpb * TOPK; a += NTHR) { const size_t ga = (size_t)r0 * TOPK + a; const int e = sel_idx[ga];
        const int slot = pst[e] + boff[e] + sel_rank[ga];
        tok_of[slot] = r0 + a / TOPK; gate_of[slot] = sel_gate[ga]; slot_of[ga] = slot; }
    for (int rr = F.tid; rr < rpb; rr += NTHR) { const int s = SH_BASE + (r0 - rowbase) + rr; tok_of[s] = r0 + rr; gate_of[s] = 1.0f; }
    if (F.bid < NE) { const int e = F.bid, lo = pst[e] + tot[e], hi = pst[e] + ((tot[e] + 255) & ~255);
        for (int s = lo + F.tid; s < hi; s += NTHR) { tok_of[s] = rowbase; gate_of[s] = 0.0f; } }
    if (F.bid == 0) {
        if (F.tid < NE) { einfo[F.tid] = tot[F.tid]; einfo[128 + F.tid] = pst[F.tid]; einfo[256 + F.tid] = (tot[F.tid] + 255) >> 8; }
        if (F.tid == NE) { einfo[NE] = ntok; einfo[128 + NE] = SH_BASE; einfo[256 + NE] = ntok >> 8; } }
    { const int x = F.bid & 7, j = F.bid >> 3;
      gi32x4* u1 = (gi32x4*)(F.ws + RT_UNITS1) + F.bid * MAXU1; gi32x4* u2 = (gi32x4*)(F.ws + RT_UNITS2) + F.bid * MAXU2;
      if (F.tid < 128 + MAXU2) { int shs, shn; shared_share(rtl, ntok >> 8, x, shs, shn);
        if (F.tid < MAXU1) { i32x4 d; class_unit(tot, pst, x, F.tid * 32 + j, 4, shs, shn, d); u1[F.tid] = d; }
        else if (F.tid >= 128) { const int i = F.tid - 128; i32x4 d; class_unit(tot, pst, x, i * 32 + j, 8, shs, shn, d); u2[i] = d; } } }
    __syncthreads();
}

template <int MODE>
__device__ __forceinline__ void phase_combine(Frame& F) {
    gf32* X = (gf32*)(F.ws + WS_X); gbf16* H = (gbf16*)(F.ws + WS_H); const gu8* Y = (const gu8*)(F.ws + WS_Y);
    const gi32* slot_of = (const gi32*)(F.ws + RT_SLOTOF);
    const int layer = MODE, rowbase = MODE ? NCTX : 0, nrows = MODE ? NLAT : NTOK;
    const int gw = F.bid * NWAVES + F.wave, NGW = GRID * NWAVES;
    const gf32* sel_gate = (const gf32*)(F.ws + RT_SELGATE);
    int sln[TOPK]; float gln[TOPK];
    if (gw < nrows) {
#pragma unroll
        for (int k = 0; k < TOPK; ++k) { sln[k] = slot_of[(size_t)(rowbase + gw) * TOPK + k]; gln[k] = sel_gate[(size_t)(rowbase + gw) * TOPK + k]; } }
    for (int rr = gw; rr < nrows; rr += NGW) { const int r = rowbase + rr;
        int sl[7]; float gk[7];
#pragma unroll
        for (int k = 0; k < TOPK; ++k) { sl[k] = __builtin_amdgcn_readfirstlane(sln[k]); gk[k] = __int_as_float(__builtin_amdgcn_readfirstlane(__float_as_int(gln[k]))); }
        if (rr + NGW < nrows) {
#pragma unroll
            for (int k = 0; k < TOPK; ++k) { sln[k] = slot_of[(size_t)(r + NGW) * TOPK + k]; gln[k] = sel_gate[(size_t)(r + NGW) * TOPK + k]; } }
        sl[6] = SH_BASE + rr; gk[6] = 1.0f;
        const int mr = mod_row(r); const gf32* g2 = mod_ptr(F, layer, mr, 5);
        f32x4 v[8];
#pragma unroll
        for (int hh = 0; hh < 2; ++hh) {
            f32x4 m[4];
#pragma unroll
            for (int q = 0; q < 4; ++q) m[q] = (f32x4){0.f, 0.f, 0.f, 0.f};
#pragma unroll
            for (int k = 0; k < 7; ++k) { const u32x4 y = *(const gu32x4*)(Y + (size_t)sl[k] * D + 16 * F.lane + 1024 * hh);
                acc4_fp8s(m[0], y.x, gk[k]); acc4_fp8s(m[1], y.y, gk[k]); acc4_fp8s(m[2], y.z, gk[k]); acc4_fp8s(m[3], y.w, gk[k]); }
#pragma unroll
            for (int q = 0; q < 4; ++q) { const int c = 16 * F.lane + 1024 * hh + 4 * q; v[4 * hh + q] = *(const gf32x4*)(X + (size_t)r * D + c) + *(const gf32x4*)(g2 + c) * m[q]; } }
        const float rstd = rsqrtf(row_ssq(v) * (1.0f / D) + EPS);
        if (MODE == 0) {
#pragma unroll
            for (int j = 0; j < 8; ++j) *(gf32x4*)(X + (size_t)r * D + col_of<true>(F.lane, j)) = v[j];
            norm_mod_store<false, true>(v, rstd, INP(IN_NMIXW) + D, mod_ptr(F, 1, mr, 0), mod_ptr(F, 1, mr, 1), H + (size_t)r * D, (LAS bf16_t*)F.lds, F.lane);
        } else {
#pragma unroll
            for (int j = 0; j < 8; ++j) { const int c = col_of<true>(F.lane, j); *(gf32x4*)(F.out + (size_t)rr * D + c) = (v[j] * rstd) * *(const gf32x4*)(INP(IN_FNW) + c); }
        }
    }
}

__device__ __forceinline__ void phase_combine0_gates(Frame& F) {
    gf32* X = (gf32*)(F.ws + WS_X); gbf16* H = (gbf16*)(F.ws + WS_H); const gu8* Y = (const gu8*)(F.ws + WS_Y);
    const gi32* slot_of = (const gi32*)(F.ws + RT_SLOTOF); gf32* G = (gf32*)(F.ws + WS_GATES);
    const gbf16* Wg = (const gbf16*)(F.ws + WS_MLIN_T) + (size_t)6144 * D;
    LAS bf16_t* hs = (LAS bf16_t*)(F.lds + R_HS); LAS float* part = (LAS float*)(F.lds + R_PART);
    constexpr int rpb = NTOK / GRID;
    const int r0 = F.bid * rpb, ngroups = (rpb + 31) >> 5;
    const int fr = F.lane & 15, fq = F.lane >> 4;
#define CG_BAR() do { asm volatile("s_waitcnt lgkmcnt(0)" ::: "memory"); __builtin_amdgcn_s_barrier(); asm volatile("" ::: "memory"); } while (0)
    f32x4 cw[8]; int cur_mr = -1;
    for (int g = 0; g < ngroups; ++g) {
        const int lr0 = 4 * F.wave, br0 = 32 * g + lr0;
        if (br0 < rpb) {
            const int slv = slot_of[(size_t)(r0 + br0) * TOPK + (F.lane < 24 ? F.lane : 0)];
            const int glv = __float_as_int(((const gf32*)(F.ws + RT_SELGATE))[(size_t)(r0 + br0) * TOPK + (F.lane < 24 ? F.lane : 0)]);
#pragma unroll 1
            for (int q = 0; q < 4; ++q) { const int r = r0 + br0 + q, mr = mod_row(r); LAS bf16_t* lrow = hs + (lr0 + q) * HS_PITCH;
                int sl[7]; float gk[7];
#pragma unroll
                for (int k = 0; k < TOPK; ++k) { sl[k] = __builtin_amdgcn_readlane(slv, 6 * q + k); gk[k] = __int_as_float(__builtin_amdgcn_readlane(glv, 6 * q + k)); }
                sl[6] = SH_BASE + r; gk[6] = 1.0f;
                const gf32* g2 = mod_ptr(F, 0, mr, 5); const gf32* sh = mod_ptr(F, 1, mr, 0);
                if (mr != cur_mr) { cur_mr = mr; const gf32* sc = mod_ptr(F, 1, mr, 1); const gf32* nw = INP(IN_NMIXW) + D;
#pragma unroll
                    for (int j = 0; j < 8; ++j) { const int c = col_of<true>(F.lane, j); cw[j] = *(const gf32x4*)(nw + c) * (*(const gf32x4*)(sc + c) + 1.0f); } }
                f32x4 v[8];
#pragma unroll
                for (int hh = 0; hh < 2; ++hh) {
                    f32x4 m[4];
#pragma unroll
                    for (int qq = 0; qq < 4; ++qq) m[qq] = (f32x4){0.f, 0.f, 0.f, 0.f};
#pragma unroll
                    for (int k = 0; k < 7; ++k) { const u32x4 y = *(const gu32x4*)(Y + (size_t)sl[k] * D + 16 * F.lane + 1024 * hh);
                        acc4_fp8s(m[0], y.x, gk[k]); acc4_fp8s(m[1], y.y, gk[k]); acc4_fp8s(m[2], y.z, gk[k]); acc4_fp8s(m[3], y.w, gk[k]); }
#pragma unroll
                    for (int qq = 0; qq < 4; ++qq) { const int c = 16 * F.lane + 1024 * hh + 4 * qq; v[4 * hh + qq] = *(const gf32x4*)(X + (size_t)r * D + c) + *(const gf32x4*)(g2 + c) * m[qq]; } }
                const float rstd = rsqrtf(row_ssq(v) * (1.0f / D) + EPS);
#pragma unroll
                for (int j = 0; j < 8; ++j) { const int c = col_of<true>(F.lane, j);
                    *(gf32x4*)(X + (size_t)r * D + c) = v[j];
                    const f32x4 y = (v[j] * rstd) * cw[j] + *(const gf32x4*)(sh + c);
                    u32x2 o; o.x = cvt_pk_bf16(y[0], y[1]); o.y = cvt_pk_bf16(y[2], y[3]);
                    *(gu32x2*)(H + (size_t)r * D + c) = o; *(LAS u32x2*)(lrow + c) = o; } }
        } else {
#pragma unroll
            for (int q = 0; q < 4; ++q)
#pragma unroll
                for (int j = 0; j < 8; ++j) *(LAS u32x2*)(hs + (lr0 + q) * HS_PITCH + 4 * F.lane + 256 * j) = (u32x2){0u, 0u}; }
        CG_BAR();
        f32x4 acc[2][2];
#pragma unroll
        for (int t = 0; t < 2; ++t)
#pragma unroll
            for (int nt = 0; nt < 2; ++nt) acc[t][nt] = (f32x4){0.f, 0.f, 0.f, 0.f};
#pragma unroll 4
        for (int ks = 0; ks < 8; ++ks) { const int k0 = 256 * F.wave + 32 * ks + 8 * fq;
            const bf16x8 a0 = *(const LAS bf16x8*)(hs + fr * HS_PITCH + k0), a1 = *(const LAS bf16x8*)(hs + (16 + fr) * HS_PITCH + k0);
#pragma unroll
            for (int nt = 0; nt < 2; ++nt) { const bf16x8 bfr = *(const gbf16x8*)(Wg + (size_t)(16 * nt + fr) * D + k0);
                acc[0][nt] = __builtin_amdgcn_mfma_f32_16x16x32_bf16(a0, bfr, acc[0][nt], 0, 0, 0); acc[1][nt] = __builtin_amdgcn_mfma_f32_16x16x32_bf16(a1, bfr, acc[1][nt], 0, 0, 0); } }
        CG_BAR();
#pragma unroll
        for (int t = 0; t < 2; ++t)
#pragma unroll
            for (int nt = 0; nt < 2; ++nt)
#pragma unroll
                for (int j = 0; j < 4; ++j) part[F.wave * 1024 + (16 * t + 4 * fq + j) * 32 + 16 * nt + fr] = acc[t][nt][j];
        CG_BAR();
#pragma unroll
        for (int q = 0; q < 2; ++q) { const int o = F.tid + 512 * q, row = o >> 5, cidx = o & 31, br = 32 * g + row; float sacc = 0.f;
#pragma unroll
            for (int w = 0; w < 8; ++w) sacc += part[w * 1024 + o];
            if (br < rpb) { float gt = softcap_gate(sacc + INP(IN_MLGB)[cidx]); if ((cidx >> 3) & 1) gt = log_sigmoid_(gt); G[(size_t)(r0 + br) * 32 + cidx] = gt; } }
        CG_BAR();
    }
#undef CG_BAR
}

__device__ __forceinline__ void phase_headnorm(Frame& F) {
    const gbf16* HF = (const gbf16*)(F.ws + WS_HF); const gbf16* HB = (const gbf16*)(F.ws + WS_HB); const gbf16* O = (const gbf16*)(F.ws + WS_O); gbf16* YIN = (gbf16*)(F.ws + WS_YIN);
    const gf32* nw = INP(IN_MLNW);
    const int gw = F.bid * NWAVES + F.wave, NGW = GRID * NWAVES;
    const int c0 = 32 * F.lane;
    f32x4 w4[8];
#pragma unroll
    for (int q = 0; q < 8; ++q) w4[q] = *(const gf32x4*)(nw + c0 + 4 * q);
    for (int rr = gw; rr < NLAT; rr += NGW) {
        u32x4 a[4], b[4], o[4];
#pragma unroll
        for (int q = 0; q < 4; ++q) { a[q] = *(const gu32x4*)(HF + (size_t)rr * D + c0 + 8 * q); b[q] = *(const gu32x4*)(HB + (size_t)rr * D + c0 + 8 * q); o[q] = *(const gu32x4*)(O + (size_t)(NCTX + rr) * D + c0 + 8 * q); }
        float h[32]; float ss = 0.f;
#pragma unroll
        for (int q = 0; q < 4; ++q)
#pragma unroll
            for (int e = 0; e < 4; ++e) { const float h0 = bf_lo(a[q][e]) + bf_lo(b[q][e]), h1 = bf_hi(a[q][e]) + bf_hi(b[q][e]); h[8 * q + 2 * e] = h0; h[8 * q + 2 * e + 1] = h1; ss += h0 * h0 + h1 * h1; }
        ss += dpp_mov<0xB1>(ss); ss += dpp_mov<0x4E>(ss); ss += dpp_mov<0x141>(ss);
        const float rstd = rsqrtf(ss * (1.0f / 256.0f) + EPS);
#pragma unroll
        for (int q = 0; q < 4; ++q) { u32x4 w;
#pragma unroll
            for (int e = 0; e < 4; ++e) { const int i0 = 8 * q + 2 * e;
                const float y0 = h[i0] * rstd * w4[i0 >> 2][i0 & 3] * sigmoidf_(bf_lo(o[q][e])), y1 = h[i0 + 1] * rstd * w4[(i0 + 1) >> 2][(i0 + 1) & 3] * sigmoidf_(bf_hi(o[q][e]));
                w[e] = cvt_pk_bf16(y0, y1); }
            *(gu32x4*)(YIN + (size_t)rr * D + c0 + 8 * q) = w; }
    }
}

constexpr int ML_Q = 0, ML_K = 16384, ML_V = 32768, ML_VW = 49152, ML_S = 65536, ML_CT = 74752, ML_F = 113920, ML_G = 118784;
constexpr int ML_SP = 144, ML_CTP = 272;
__device__ __forceinline__ unsigned off_b(unsigned row, unsigned ch) { return 256u * row + 16u * (ch ^ (((row & 3u) << 2) | ((row >> 2) & 3u))); }
__device__ __forceinline__ unsigned rowrd16(unsigned lane, unsigned rb, unsigned s) { return off_b((lane & 15u) + 16u * rb, 4u * s + (lane >> 4)); }
__device__ __forceinline__ unsigned trrd16(unsigned lane, unsigned c, unsigned ks, unsigned t) {
    const unsigned g = lane >> 4, q = (lane & 15u) >> 2, p = lane & 3u;
    return off_b(32u * ks + 8u * g + 4u * t + q, 2u * c + (p >> 1)) + 8u * (p & 1u);
}
__device__ __forceinline__ bf16x8 tr_frag(LAS unsigned char* img, unsigned lane, unsigned c, unsigned ks) {
    const s16x4 lo = __builtin_amdgcn_ds_read_tr16_b64_v4i16((LAS s16x4*)(img + trrd16(lane, c, ks, 0)));
    const s16x4 hi = __builtin_amdgcn_ds_read_tr16_b64_v4i16((LAS s16x4*)(img + trrd16(lane, c, ks, 1)));
    return (bf16x8){lo[0], lo[1], lo[2], lo[3], hi[0], hi[1], hi[2], hi[3]};
}
__device__ __forceinline__ int ml_row(int b, int dir, int p) {
    return (p < CTXL) ? b * CTXL + (dir ? (CTXL - 1 - p) : p) : NCTX + b * SEQ + (dir ? (SEQ - 1 - (p - CTXL)) : (p - CTXL));
}
__device__ __forceinline__ void phase_mlstm(Frame& F) {
    const gbf16* Qb = (const gbf16*)(F.ws + WS_Q); const gbf16* Kb = (const gbf16*)(F.ws + WS_K); const gbf16* Vb = (const gbf16*)(F.ws + WS_V);
    const gf32* G = (const gf32*)(F.ws + WS_GATES);
    const int wi = F.bid, b = wi >> 5, hd = (wi >> 2) & 7, dir = (wi >> 1) & 1, half = wi & 1;
    gbf16* HD = (gbf16*)(F.ws + (dir ? WS_HB : WS_HF));
    LAS unsigned char* L = F.lds;
    LAS float* fct = (LAS float*)(L + ML_F); LAS float* frs = fct + 64; LAS float* fwi = frs + 64; LAS float* fem = fwi + 64; LAS float* fsc = fem + 64;
    LAS bf16_t* wkb = (LAS bf16_t*)(fsc + 16); LAS float* fwk = (LAS float*)(wkb + 64);
    const unsigned lane = (unsigned)F.lane; const int w = F.wave, fr = F.lane & 15, fq = F.lane >> 4;
    for (int i = F.tid; i < 144 * ML_CTP / 16; i += NTHR) *(LAS u32x4*)(L + ML_CT + 16 * i) = (u32x4){0u, 0u, 0u, 0u};
    f32x4 cst[9];
#pragma unroll
    for (int v = 0; v < 9; ++v) cst[v] = (f32x4){0.f, 0.f, 0.f, 0.f};
    LAS float* BC = (LAS float*)(L + ML_G); LAS float* RS = BC + 2304; LAS float* CM = RS + 2304; LAS float* BL = CM + 2304; LAS float* CML = BL + 40; LAS float* MST = CML + 40; LAS float* MNW = MST + 40; LAS float* DEC = MNW + 40;
    for (int c = w; c < 36; c += 8) { const int p = 64 * c + F.lane; const size_t gr = (size_t)ml_row(b, dir, p);
        const float li = G[gr * 32 + (2 * dir) * 8 + hd], lf = G[gr * 32 + (2 * dir + 1) * 8 + hd];
        float bc = lf;
#pragma unroll
        for (int o = 1; o < 64; o <<= 1) { const float t = __shfl_up(bc, o); if (F.lane >= o) bc += t; }
        const float rsv = li - bc; float cm = rsv;
#pragma unroll
        for (int o = 1; o < 64; o <<= 1) { const float t = __shfl_up(cm, o); if (F.lane >= o) cm = fmaxf(cm, t); }
        BC[p] = bc; RS[p] = rsv; CM[p] = cm;
        if (F.lane == 63) { BL[c] = bc; CML[c] = cm; } }
    __syncthreads();
    if (F.tid == 0) { float m = -1.0e30f;
        for (int c = 0; c < 36; ++c) { const float bl = BL[c], mn = fmaxf(bl + m, bl + CML[c]); MST[c] = m; MNW[c] = mn; DEC[c] = fast_exp(bl + m - mn); m = mn; } }
    __syncthreads();
    u32x4 gq[2], gk[2], gv[2];
#define ML_LOAD_CHUNK(P0) do { _Pragma("unroll") for (int i = 0; i < 2; ++i) { const int cid = F.tid + 512 * i, row = cid >> 4, ch = cid & 15; const size_t gr = (size_t)ml_row(b, dir, (P0) + row); \
            gq[i] = *(const gu32x4*)(Qb + gr * 1024 + hd * 128 + 8 * ch); gk[i] = *(const gu32x4*)(Kb + gr * 1024 + hd * 128 + 8 * ch); \
            gv[i] = *(const gu32x4*)(Vb + gr * 2048 + hd * 256 + half * 128 + 8 * ch); } } while (0)
    ML_LOAD_CHUNK(0);
#define ML_BAR() do { asm volatile("s_waitcnt lgkmcnt(0)" ::: "memory"); __builtin_amdgcn_s_barrier(); asm volatile("" ::: "memory"); } while (0)
#pragma unroll 1
    for (int c = 0; c < 36; ++c) {
        const int p0 = 64 * c;
        if (F.tid < 64) { const float m_st = MST[c], mnew = MNW[c], bc = BC[p0 + F.tid], rsv = RS[p0 + F.tid], cm = CM[p0 + F.tid];
            const float mrow = bc + fmaxf(m_st, cm), wk = fast_exp(BL[c] + rsv - mnew);
            fct[F.tid] = bc - mrow; frs[F.tid] = rsv; fwi[F.tid] = fast_exp(bc + m_st - mrow); fem[F.tid] = fast_exp(-mrow); fwk[F.tid] = wk;
            if (F.tid == 0) { fsc[0] = DEC[c]; fsc[1] = mnew; } }
#pragma unroll
        for (int i = 0; i < 2; ++i) { const int cid = F.tid + 512 * i, row = cid >> 4, ch = cid & 15; const unsigned o = off_b(row, ch);
            *(LAS u32x4*)(L + ML_Q + o) = gq[i]; *(LAS u32x4*)(L + ML_K + o) = gk[i]; *(LAS u32x4*)(L + ML_V + o) = gv[i]; }
        if (c + 1 < 36) ML_LOAD_CHUNK(p0 + 64);
        ML_BAR();
        const float decay = fsc[0];
#pragma unroll
        for (int v = 0; v < 9; ++v) cst[v] *= decay;
#pragma unroll
        for (int ks = 0; ks < 2; ++ks) {
            const bf16x8 a0 = tr_frag(L + ML_K, lane, (unsigned)w, ks);
            const f32x4 wk0 = *(const LAS f32x4*)(fwk + 32 * ks + 8 * fq), wk1 = *(const LAS f32x4*)(fwk + 32 * ks + 8 * fq + 4);
            bf16x8 a;
            { const unsigned p0 = cvt_pk_bf16(__uint_as_float((unsigned)(unsigned short)a0[0] << 16) * wk0[0], __uint_as_float((unsigned)(unsigned short)a0[1] << 16) * wk0[1]);
              const unsigned p1 = cvt_pk_bf16(__uint_as_float((unsigned)(unsigned short)a0[2] << 16) * wk0[2], __uint_as_float((unsigned)(unsigned short)a0[3] << 16) * wk0[3]);
              const unsigned p2 = cvt_pk_bf16(__uint_as_float((unsigned)(unsigned short)a0[4] << 16) * wk1[0], __uint_as_float((unsigned)(unsigned short)a0[5] << 16) * wk1[1]);
              const unsigned p3 = cvt_pk_bf16(__uint_as_float((unsigned)(unsigned short)a0[6] << 16) * wk1[2], __uint_as_float((unsigned)(unsigned short)a0[7] << 16) * wk1[3]);
              a = __builtin_bit_cast(bf16x8, (u32x4){p0, p1, p2, p3}); }
#pragma unroll
            for (int v = 0; v < 8; ++v) { const bf16x8 bb = tr_frag(L + ML_V, lane, v, ks); cst[v] = __builtin_amdgcn_mfma_f32_16x16x32_bf16(a, bb, cst[v], 0, 0, 0); }
            const bf16x8 ba = (bf16x8){(short)0x3F80, (short)0x3F80, (short)0x3F80, (short)0x3F80, (short)0x3F80, (short)0x3F80, (short)0x3F80, (short)0x3F80};
            cst[8] = __builtin_amdgcn_mfma_f32_16x16x32_bf16(a, ba, cst[8], 0, 0, 0);
        }
        if (c >= 4) {
            const int tt = w >> 1;
            bf16x8 qf[4];
#pragma unroll
            for (int ks = 0; ks < 4; ++ks) qf[ks] = *(const LAS bf16x8*)(L + ML_Q + rowrd16(lane, tt, ks));
            const int t = 16 * tt + fr; const float ctt = fct[t];
#pragma unroll
            for (int si = 0; si < 2; ++si) { const int st = 2 * (w & 1) + si; f32x4 acc = (f32x4){0.f, 0.f, 0.f, 0.f};
                if (st <= tt)
#pragma unroll
                for (int ks = 0; ks < 4; ++ks) { const bf16x8 kf = *(const LAS bf16x8*)(L + ML_K + rowrd16(lane, st, ks)); acc = __builtin_amdgcn_mfma_f32_16x16x32_bf16(kf, qf[ks], acc, 0, 0, 0); }
                const int s0 = 16 * st + 4 * fq; float sv[4];
#pragma unroll
                for (int j = 0; j < 4; ++j) sv[j] = (s0 + j <= t) ? acc[j] * fast_exp(ctt + frs[s0 + j]) : 0.f;
                u32x2 o; o.x = cvt_pk_bf16(sv[0], sv[1]); o.y = cvt_pk_bf16(sv[2], sv[3]);
                *(LAS u32x2*)(L + ML_S + t * ML_SP + s0 * 2) = o; }
        }
        ML_BAR();
        if (c >= 4) {
            const int tt = w >> 1;
            f32x4 sv[5], qc[5];
#pragma unroll
            for (int i = 0; i < 5; ++i) { sv[i] = (f32x4){0.f, 0.f, 0.f, 0.f}; qc[i] = (f32x4){0.f, 0.f, 0.f, 0.f}; }
#pragma unroll
            for (int ks = 0; ks < 2; ++ks) { const bf16x8 a = *(const LAS bf16x8*)(L + ML_S + (fr + 16 * tt) * ML_SP + (32 * ks + 8 * fq) * 2);
#pragma unroll
                for (int i = 0; i < 4; ++i) { const bf16x8 bb = tr_frag(L + ML_V, lane, 4 * (w & 1) + i, ks); sv[i] = __builtin_amdgcn_mfma_f32_16x16x32_bf16(a, bb, sv[i], 0, 0, 0); }
                const bf16x8 bo = (bf16x8){(short)0x3F80, (short)0x3F80, (short)0x3F80, (short)0x3F80, (short)0x3F80, (short)0x3F80, (short)0x3F80, (short)0x3F80};
                sv[4] = __builtin_amdgcn_mfma_f32_16x16x32_bf16(a, bo, sv[4], 0, 0, 0); }
#pragma unroll
            for (int ks = 0; ks < 4; ++ks) { const bf16x8 a = *(const LAS bf16x8*)(L + ML_Q + rowrd16(lane, tt, ks));
#pragma unroll
                for (int i = 0; i < 5; ++i) { const int vt = (i < 4) ? 4 * (w & 1) + i : 8;
                    const bf16x8 bb = *(const LAS bf16x8*)(L + ML_CT + (fr + 16 * vt) * ML_CTP + (32 * ks + 8 * fq) * 2); qc[i] = __builtin_amdgcn_mfma_f32_16x16x32_bf16(a, bb, qc[i], 0, 0, 0); } }
#pragma unroll
            for (int j = 0; j < 4; ++j) { const int tl = 16 * tt + 4 * fq + j; const float wi_ = fwi[tl], em = fem[tl];
                const float den = sv[4][j] + wi_ * qc[4][j];
                const float inv = 1.0f / fmaxf(fabsf(den), em);
                LAS bf16_t* op = (LAS bf16_t*)(L + ML_VW) + tl * 128 + fr;
#pragma unroll
                for (int i = 0; i < 4; ++i) { const float h = (sv[i][j] + wi_ * qc[i][j]) * inv; op[16 * (4 * (w & 1) + i)] = (bf16_t)(cvt_pk_bf16(h, 0.f) & 0xffffu); } }
        }
        ML_BAR();
        if (c >= 4) {
#pragma unroll
            for (int i = 0; i < 2; ++i) { const int cid = F.tid + 512 * i, row = cid >> 4, ch = cid & 15; const size_t rr = (size_t)(ml_row(b, dir, p0 + row) - NCTX);
                *(gu32x4*)(HD + rr * D + hd * 256 + half * 128 + 8 * ch) = *(const LAS u32x4*)(L + ML_VW + row * 256 + 16 * ch); } }
#pragma unroll
        for (int v = 0; v < 9; ++v) { u32x2 o; o.x = cvt_pk_bf16(cst[v][0], cst[v][1]); o.y = cvt_pk_bf16(cst[v][2], cst[v][3]);
            *(LAS u32x2*)(L + ML_CT + (16 * v + fr) * ML_CTP + (16 * w + 4 * fq) * 2) = o; }
    }
    __syncthreads();
}

constexpr int N_PHASES = 19;
#ifndef PHASE_MASK
#define PHASE_MASK 0x7ffff
#endif
__global__ void __launch_bounds__(NTHR, 2) fwd(Args args) {
    extern __shared__ __attribute__((aligned(16))) unsigned char lds_raw[];
    if (threadIdx.x < 4) ((LAS unsigned*)((LAS unsigned char*)lds_raw + LDSCTL_OFF))[threadIdx.x] = 0u;
    __syncthreads();
#if !MK_PER_PHASE
    XcdBarrier bar = xcd_barrier_post((unsigned*)(args.ws + WS_CTL) + CW_BAR + args.li * 4096, (volatile LAS unsigned*)((LAS unsigned char*)lds_raw + LDSCTL_OFF));
#define SEAM(k) do { if (IN(k) && IN((k) + 1)) xcd_barrier(bar); } while (0)
#else
#define SEAM(k) do { } while (0)
#endif
    const int lo = args.ph_lo, hi = args.ph_hi;
#define IN(k) (((PHASE_MASK >> (k)) & 1) && lo <= (k) && (k) < hi)
#ifndef REPEAT_MASK
#define REPEAT_MASK 0
#endif
#ifndef REPEAT_N
#define REPEAT_N 1
#endif
#define REP(k) for (int rep_ = 0; rep_ < ((((REPEAT_MASK) >> (k)) & 1) ? (REPEAT_N) : 1); ++rep_, __syncthreads())
#define PHASE_FRAME() Frame F; gu8* ws; { gu8* w_ = (gu8*)args.ws; asm volatile("" : "+s"(w_)); int t_ = threadIdx.x; asm volatile("" : "+v"(t_)); ws = w_; \
        F.lds = (LAS unsigned char*)lds_raw; F.tid = t_; F.lane = t_ & 63; F.wave = __builtin_amdgcn_readfirstlane(t_ >> 6); F.bid = blockIdx.x; F.a = &args; F.out = (gf32*)args.out; F.ws = w_; }

    if (IN(0)) REP(0) { PHASE_FRAME(); (void)ws; phase_prologue(F); } SEAM(0);
    if (IN(1)) REP(1) { PHASE_FRAME(); (void)ws; phase_norm0(F); } SEAM(1);
    if (IN(2)) REP(2) { PHASE_FRAME(); pg8::DenseOrder S; S.init(ws + WS_H, ws + WS_CONVIN_T, NTOK, 3 * D, D, GRID, F.bid);
        EpiConvIn E{(gbf16*)(ws + WS_U), (gbf16*)(ws + WS_BM)};
        pg8::gemm_phase<EpiConvIn, pg8::DenseOrder, false>(F.lds, D, S, E); } SEAM(2);
    if (IN(3)) REP(3) { PHASE_FRAME(); (void)ws; phase_conv(F); } SEAM(3);
    if (IN(4)) REP(4) { PHASE_FRAME(); pg8::DenseOrder S; S.init(ws + WS_Z, ws + WS_CONVOUT_T, NTOK, D, D, GRID, F.bid);
        EpiResid E{INP(IN_CTX), INP(IN_X), (gf32*)(ws + WS_X), mod_ptr(F, 0, 0, 2), 0};
        pg8::gemm_phase<EpiResid, pg8::DenseOrder, false>(F.lds, D, S, E); } SEAM(4);
    if (IN(5)) REP(5) { PHASE_FRAME(); (void)ws; phase_router(F, 0, 0, NTOK / GRID); } SEAM(5);
    if (IN(6)) REP(6) { PHASE_FRAME(); (void)ws; phase_scatter(F, 0, NTOK / GRID, NTOK); } SEAM(6);
    if (IN(7)) REP(7) { PHASE_FRAME(); ExpertOrder S{stage_units(F, (const gi32x4*)(ws + RT_UNITS1) + F.bid * MAXU1, MAXU1), (const gchar*)(ws + WS_H8), (const gchar*)(ws + WS_MOE0 + MOE_GU), (const gi32*)(ws + RT_TOKOF), D / 2, 1024};
        EpiSwiglu E{(gu8*)(ws + WS_ACT)};
        pg8::gemm_phase<EpiSwiglu, ExpertOrder, true, true>(F.lds, D / 2, S, E); } SEAM(7);
    if (IN(8)) REP(8) { PHASE_FRAME(); ExpertOrder S{stage_units(F, (const gi32x4*)(ws + RT_UNITS2) + F.bid * MAXU2, MAXU2), (const gchar*)(ws + WS_ACT), (const gchar*)(ws + WS_MOE0 + MOE_DN), nullptr, ED / 2, 2048};
        EpiDown E{(gu8*)(ws + WS_Y)};
        pg8::gemm_phase<EpiDown, ExpertOrder, false, true>(F.lds, ED / 2, S, E); } SEAM(8);
    if (IN(9)) REP(9) { PHASE_FRAME(); (void)ws; phase_combine0_gates(F); } SEAM(9);
    if (IN(10)) REP(10) { PHASE_FRAME(); pg8::DenseOrder S; S.init(ws + WS_H, ws + WS_MLIN_T, NTOK, 3 * D, D, GRID, F.bid);
        EpiMlstmIn E{(gbf16*)(ws + WS_Q), (gbf16*)(ws + WS_K), (gbf16*)(ws + WS_V), (gbf16*)(ws + WS_O)};
        pg8::gemm_phase<EpiMlstmIn, pg8::DenseOrder, false>(F.lds, D, S, E); } SEAM(10);
    if (IN(11)) REP(11) { PHASE_FRAME(); (void)ws; phase_mlstm(F); } SEAM(11);
    if (IN(12)) REP(12) { PHASE_FRAME(); (void)ws; phase_headnorm(F); } SEAM(12);
    if (IN(13)) REP(13) { PHASE_FRAME(); pg8::DenseOrder S; S.init(ws + WS_YIN, ws + WS_MLOUT_T, NLAT, D, D, GRID, F.bid);
        gf32* X = (gf32*)(ws + WS_X);
        EpiResid E{X, X + (size_t)NCTX * D, X, mod_ptr(F, 1, 0, 2), NCTX};
        pg8::gemm_phase<EpiResid, pg8::DenseOrder, false>(F.lds, D, S, E); } SEAM(13);
    if (IN(14)) REP(14) { PHASE_FRAME(); (void)ws; phase_router(F, 1, NCTX, NLAT / GRID); } SEAM(14);
    if (IN(15)) REP(15) { PHASE_FRAME(); (void)ws; phase_scatter(F, NCTX, NLAT / GRID, NLAT); } SEAM(15);
    if (IN(16)) REP(16) { PHASE_FRAME(); ExpertOrder S{stage_units(F, (const gi32x4*)(ws + RT_UNITS1) + F.bid * MAXU1, MAXU1), (const gchar*)(ws + WS_H8), (const gchar*)(ws + WS_MOE0 + MOE_STRIDE + MOE_GU), (const gi32*)(ws + RT_TOKOF), D / 2, 1024};
        EpiSwiglu E{(gu8*)(ws + WS_ACT)};
        pg8::gemm_phase<EpiSwiglu, ExpertOrder, true, true>(F.lds, D / 2, S, E); } SEAM(16);
    if (IN(17)) REP(17) { PHASE_FRAME(); ExpertOrder S{stage_units(F, (const gi32x4*)(ws + RT_UNITS2) + F.bid * MAXU2, MAXU2), (const gchar*)(ws + WS_ACT), (const gchar*)(ws + WS_MOE0 + MOE_STRIDE + MOE_DN), nullptr, ED / 2, 2048};
        EpiDown E{(gu8*)(ws + WS_Y)};
        pg8::gemm_phase<EpiDown, ExpertOrder, false, true>(F.lds, ED / 2, S, E); } SEAM(17);
    if (IN(18)) REP(18) { PHASE_FRAME(); (void)ws; phase_combine<1>(F); }
#undef IN
#undef SEAM
}

extern "C" void kernel_launch(void* const* d_in, const int* in_sizes, int n_in, void* d_out, int out_size, void* d_ws, size_t ws_size, hipStream_t stream) {
    static int ready = 0;
    if (ready == 0) {
        if (n_in != N_IN || out_size != NLAT * D || ws_size < WS_END) { fprintf(stderr, "kernel_launch: unexpected problem shape (n_in %d, out %d, ws %zu)\n", n_in, out_size, ws_size); ready = -1; return; }
        if (hipFuncSetAttribute((const void*)fwd, hipFuncAttributeMaxDynamicSharedMemorySize, LDS_BYTES) != hipSuccess) { fprintf(stderr, "kernel_launch: hipFuncSetAttribute failed\n"); ready = -1; return; }
        int per_cu = 0;
        if (hipOccupancyMaxActiveBlocksPerMultiprocessor(&per_cu, (const void*)fwd, NTHR, LDS_BYTES) != hipSuccess || per_cu < 1) fprintf(stderr, "kernel_launch: note: occupancy query reports %d blocks per CU\n", per_cu);
        (void)hipGetLastError();
        ready = 1;
    }
    if (ready < 0) return;
    (void)hipMemsetAsync((char*)d_ws + WS_CTL, 0, CTL_BYTES, stream);
    Args a{};
    for (int i = 0; i < N_IN; ++i) a.in[i] = (const float*)d_in[i];
    a.out = (float*)d_out; a.ws = (unsigned char*)d_ws; a.pad = 0;
#if MK_PER_PHASE
    for (int p = 0; p < N_PHASES; ++p) { a.ph_lo = p; a.ph_hi = p + 1; a.li = 0; hipLaunchKernelGGL(fwd, dim3(GRID), dim3(NTHR), LDS_BYTES, stream, a); }
#else
    a.ph_lo = 0; a.ph_hi = N_PHASES; a.li = 0;
    hipLaunchKernelGGL(fwd, dim3(GRID), dim3(NTHR), LDS_BYTES, stream, a);
#endif
}
```

```cpp
#include <hip/hip_runtime.h>
#include <stdint.h>
#include <stdio.h>

#ifndef STAGGER_TICKS
#define STAGGER_TICKS 0
#endif
#ifndef MK_PER_PHASE
#define MK_PER_PHASE 0
#endif

#define GAS __attribute__((address_space(1)))
#define LAS __attribute__((address_space(3)))
typedef unsigned short bf16_t;
typedef short bf16x8 __attribute__((ext_vector_type(8)));
typedef short s16x4 __attribute__((ext_vector_type(4)));
typedef float f32x4 __attribute__((ext_vector_type(4)));
typedef float f32x2 __attribute__((ext_vector_type(2)));
typedef unsigned u32x4 __attribute__((ext_vector_type(4)));
typedef unsigned u32x2 __attribute__((ext_vector_type(2)));
typedef int i32x4 __attribute__((ext_vector_type(4)));
typedef long i64x2 __attribute__((ext_vector_type(2)));
typedef int i32x8 __attribute__((ext_vector_type(8)));
typedef GAS float gf32; typedef GAS bf16_t gbf16; typedef GAS int gi32; typedef GAS unsigned char gu8; typedef GAS char gchar;
typedef GAS f32x4 gf32x4; typedef GAS u32x4 gu32x4; typedef GAS u32x2 gu32x2; typedef GAS bf16x8 gbf16x8; typedef GAS i32x4 gi32x4;

constexpr int D = 2048, NBATCH = 8, SEQ = 2048, CTXL = 256;
constexpr int NCTX = NBATCH * CTXL;
constexpr int NLAT = NBATCH * SEQ;
constexpr int NTOK = NCTX + NLAT;
constexpr int NE = 64, TOPK = 6, ED = 512;
constexpr int ADA_N = 6 * D;
constexpr int MLSTM_N = 6176, MLSTM_NP = 6400;
constexpr int NWAVES = 8, NTHR = 512, GRID = 256;
constexpr int SH_BASE = 126976;
constexpr int NSLOT = SH_BASE + NTOK;
constexpr float EPS = 1e-6f;

constexpr size_t MiB = 1u << 20, KiB = 1024;
constexpr size_t WS_CTL = 0, CTL_BYTES = 64 * KiB;
constexpr size_t WS_MOD = 1 * MiB;
constexpr size_t WS_RT = 2 * MiB;
constexpr size_t RT_HIST = WS_RT;
constexpr size_t RT_EINFO = WS_RT + 64 * KiB;
constexpr size_t RT_SELIDX = WS_RT + 128 * KiB;
constexpr size_t RT_SELGATE = WS_RT + 640 * KiB;
constexpr size_t RT_SELRANK = WS_RT + 1152 * KiB;
constexpr size_t RT_SLOTOF = WS_RT + 1664 * KiB;
constexpr size_t RT_TOKOF = WS_RT + 2176 * KiB;
constexpr size_t RT_GATEOF = WS_RT + 2816 * KiB;
constexpr size_t RT_UNITS1 = WS_RT + 3584 * KiB;
constexpr size_t RT_UNITS2 = WS_RT + 3840 * KiB;
constexpr int MAXU1 = 64, MAXU2 = 128;
constexpr size_t WS_GATES = 10 * MiB;
constexpr size_t WS_CONVIN_T = 13 * MiB;
constexpr size_t WS_CONVOUT_T = 37 * MiB;
constexpr size_t WS_MLIN_T = 45 * MiB;
constexpr size_t WS_MLOUT_T = 70 * MiB;
constexpr size_t WS_MOE0 = 78 * MiB, MOE_STRIDE = 392 * MiB;
constexpr size_t MOE_GU = 0, MOE_DN = 260 * MiB, MOE_RT = 390 * MiB;
constexpr size_t WS_H = 862 * MiB;
constexpr size_t WS_X = 934 * MiB;
constexpr size_t WS_ACT = 1078 * MiB;
constexpr size_t WS_Y = 1220 * MiB;
constexpr size_t WS_U = WS_Y, WS_BM = WS_Y + 72 * MiB, WS_Z = WS_Y + 144 * MiB;
constexpr size_t WS_Q = WS_Y, WS_K = WS_Y + 36 * MiB, WS_V = WS_Y + 72 * MiB, WS_O = WS_Y + 144 * MiB;
constexpr size_t WS_HF = WS_Y + 216 * MiB, WS_HB = WS_Y + 280 * MiB, WS_YIN = WS_Y + 344 * MiB;
constexpr size_t WS_H8 = 1788 * MiB;
constexpr size_t WS_XB = 1824 * MiB;
constexpr size_t WS_END = 1888 * MiB;
constexpr float DN_WSCALE = 32.0f, ACT_SCALE = 16.0f;
constexpr float GU_WSCALE = 64.0f;
constexpr int CW_BAR = 4096;
constexpr int CW_P0CTR = 64;

constexpr int RING_BYTES = 131072;
constexpr int LDSCTL_OFF = 150 * 1024;
constexpr int LDS_BYTES = 151 * 1024;

#define LDS_WAIT() asm volatile("s_waitcnt lgkmcnt(0)" ::: "memory")
#define VM_WAIT() asm volatile("s_waitcnt vmcnt(0)" ::: "memory")
__device__ __forceinline__ unsigned cvt_pk_bf16(float lo, float hi) { unsigned r; asm volatile("v_cvt_pk_bf16_f32 %0, %1, %2" : "=v"(r) : "v"(lo), "v"(hi)); return r; }
__device__ __forceinline__ unsigned pk4_fp8(const f32x4 v) { int w = 0;
    w = __builtin_amdgcn_cvt_pk_fp8_f32(__builtin_amdgcn_fmed3f(v[0], -448.0f, 448.0f), __builtin_amdgcn_fmed3f(v[1], -448.0f, 448.0f), w, false);
    w = __builtin_amdgcn_cvt_pk_fp8_f32(__builtin_amdgcn_fmed3f(v[2], -448.0f, 448.0f), __builtin_amdgcn_fmed3f(v[3], -448.0f, 448.0f), w, true); return (unsigned)w; }
__device__ __forceinline__ void acc4_fp8(f32x4& m, unsigned w) { const f32x2 lo = __builtin_amdgcn_cvt_pk_f32_fp8((int)w, false), hi = __builtin_amdgcn_cvt_pk_f32_fp8((int)w, true); m[0] += lo[0]; m[1] += lo[1]; m[2] += hi[0]; m[3] += hi[1]; }
__device__ __forceinline__ void acc4_fp8s(f32x4& m, unsigned w, float g) { const f32x2 lo = __builtin_amdgcn_cvt_pk_f32_fp8((int)w, false), hi = __builtin_amdgcn_cvt_pk_f32_fp8((int)w, true); m[0] += g * lo[0]; m[1] += g * lo[1]; m[2] += g * hi[0]; m[3] += g * hi[1]; }
__device__ __forceinline__ float bf_lo(unsigned u) { return __uint_as_float(u << 16); }
__device__ __forceinline__ float bf_hi(unsigned u) { return __uint_as_float(u & 0xffff0000u); }
template <int CTRL> __device__ __forceinline__ float dpp_mov(float v) { return __int_as_float(__builtin_amdgcn_update_dpp(0, __float_as_int(v), CTRL, 0xf, 0xf, true)); }
__device__ __forceinline__ float wave_sum(float v) {
    v += dpp_mov<0xB1>(v); v += dpp_mov<0x4E>(v); v += dpp_mov<0x141>(v); v += dpp_mov<0x140>(v);
    const int b = __float_as_int(v);
    return (__int_as_float(__builtin_amdgcn_readlane(b, 0)) + __int_as_float(__builtin_amdgcn_readlane(b, 16))) + (__int_as_float(__builtin_amdgcn_readlane(b, 32)) + __int_as_float(__builtin_amdgcn_readlane(b, 48)));
}
__device__ __forceinline__ float fast_exp(float x) { return __builtin_amdgcn_exp2f(x * 1.44269504088896341f); }
__device__ __forceinline__ float sigmoidf_(float x) { return 1.0f / (1.0f + fast_exp(-x)); }
__device__ __forceinline__ float siluf_(float x) { return x / (1.0f + fast_exp(-x)); }

#define XB_TMO      128
#define XB_XCNT(j)  (256  + 64 * (j))
#define XB_XSUB(j)  (1280 + 64 * (j))
#define XB_XGEN(j)  (2304 + 64 * (j))
#define XB_TOP      3328
#define XB_TOPGEN   3392
#define XCD_BAR_WORDS 3456
#define XB_SPIN_CAP (1u << 22)

__device__ __forceinline__ unsigned xb_ld(unsigned* p)              { return __hip_atomic_load(p, __ATOMIC_RELAXED, __HIP_MEMORY_SCOPE_AGENT); }
__device__ __forceinline__ unsigned xb_add(unsigned* p, unsigned v) { return __hip_atomic_fetch_add(p, v, __ATOMIC_RELAXED, __HIP_MEMORY_SCOPE_AGENT); }
__device__ __forceinline__ unsigned xb_xcc_id() { return (unsigned)__builtin_amdgcn_s_getreg((3 << 11) | 20) & 0xFu; }
#define XB_SPIN(cond, bar) do { unsigned _sp = 0; while (cond) { __builtin_amdgcn_s_sleep(1); \
    if ((++_sp & 255u) == 0u) { if (xb_ld(&(bar)[XB_TMO])) break; if (_sp > XB_SPIN_CAP) { atomicAdd(&(bar)[XB_TMO], 1u); break; } } } } while (0)

struct XcdBarrier { unsigned* bar; unsigned x; volatile LAS unsigned* st; };

__device__ __forceinline__ XcdBarrier xcd_barrier_post(unsigned* bar, volatile LAS unsigned* st) {
    XcdBarrier b; b.bar = bar; b.x = xb_xcc_id(); b.st = st;
    if (threadIdx.x == 0) (void)xb_add(&bar[XB_XCNT(b.x)], 1u);
    return b;
}
__device__ __forceinline__ void xcd_barrier_complete(unsigned* bar, unsigned x, unsigned& nloc, unsigned& nx) {
    const unsigned G = gridDim.x * gridDim.y * gridDim.z;
    unsigned sum, cnt, mine, sp = 0u;
    for (;;) {
        sum = 0u; cnt = 0u; mine = 0u;
#pragma unroll
        for (unsigned j = 0; j < 16; ++j) { const unsigned c = xb_ld(&bar[XB_XCNT(j)]); sum += c; cnt += (c > 0u) ? 1u : 0u; mine = (j == x) ? c : mine; }
        if (sum == G) break;
        __builtin_amdgcn_s_sleep(1);
        if ((++sp & 255u) == 0u) { if (xb_ld(&bar[XB_TMO])) break; if (sp > XB_SPIN_CAP) { atomicAdd(&bar[XB_TMO], 1u); break; } }
    }
    nloc = mine > 0u ? mine : 1u; nx = cnt > 0u ? cnt : 1u;
}
__device__ __forceinline__ void xcd_barrier(const XcdBarrier& b) {
    asm volatile("s_waitcnt vmcnt(0)" ::: "memory");
    __syncthreads();
    if (threadIdx.x == 0) {
        unsigned* bar = b.bar;
        __builtin_amdgcn_s_waitcnt(0);
        unsigned nloc = b.st[0], nx = b.st[1];
        if (nloc == 0u) { xcd_barrier_complete(bar, b.x, nloc, nx); b.st[0] = nloc; b.st[1] = nx; }
        const unsigned old = xb_add(&bar[XB_XSUB(b.x)], 1u);
        const unsigned gen = old / nloc;
        if (old + 1u == (gen + 1u) * nloc) {
            __builtin_amdgcn_fence(__ATOMIC_RELEASE, "agent");
            asm volatile("s_waitcnt vmcnt(0)" ::: "memory");
            const unsigned og = xb_add(&bar[XB_TOP], 1u);
            const unsigned tg = og / nx;
            if (og + 1u == (tg + 1u) * nx) xb_add(&bar[XB_TOPGEN], 1u);
            else XB_SPIN(xb_ld(&bar[XB_TOPGEN]) == tg, bar);
            __builtin_amdgcn_fence(__ATOMIC_ACQUIRE, "agent");
            xb_add(&bar[XB_XGEN(b.x)], 1u);
            asm volatile("s_waitcnt vmcnt(0)" ::: "memory");
        } else {
            XB_SPIN(xb_ld(&bar[XB_XGEN(b.x)]) == gen, bar);
            __builtin_amdgcn_fence(__ATOMIC_ACQUIRE, "agent");
            asm volatile("s_waitcnt vmcnt(0)" ::: "memory");
        }
    }
    __syncthreads();
}

namespace pg8 {
constexpr int BM = 256, BK = 64, HALF = 128, HTB = HALF * BK * 2, STAGE_BYTES = 8 * HTB, NXCD = 8, WGM = 8;
__host__ __device__ __forceinline__ int lds_byte(int r, int c) { const int st = (r >> 4) * 2 + (c >> 5), rr = r & 15, cc = c & 31, ob = rr * 64 + cc * 2; return st * 1024 + (ob ^ (((ob >> 9) & 1) << 5)); }
__host__ __device__ __forceinline__ void stage_rc(int b, int& R, int& C) { const int st = b / 1024, sb = b % 1024, swz = sb ^ (((sb >> 9) & 1) << 5); R = (st >> 1) * 16 + swz / 64; C = (st & 1) * 32 + (swz % 64) / 2; }
__host__ __device__ __forceinline__ int perm32(int rho) { const int n = rho >> 4, i = rho & 15; return 8 * (i >> 2) + 4 * n + (i & 3); }

struct Unit { int pm, pn, e, row0; };

struct DenseOrder {
    int nM, nN, nwg, G, c; const gchar* A; const gchar* Bt; size_t tstep;
    __device__ void init(const GAS void* A_, const GAS void* Bt_, int M, int N, int K, int G_, int c_) { A = (const gchar*)A_; Bt = (const gchar*)Bt_; nM = M / BM; nN = N / BM; nwg = nM * nN; G = G_; c = c_; tstep = (size_t)BM * K * 2; }
    __device__ __forceinline__ bool next(int i, Unit& u) const {
        const long L = (long)i * G + c; if (L >= nwg) return false;
        int wgid = (int)L; { const int q = nwg / NXCD, r = nwg % NXCD, xcd = wgid % NXCD, off = wgid / NXCD; wgid = (xcd < r ? xcd * (q + 1) : r * (q + 1) + (xcd - r) * q) + off; }
        const int nig = WGM * nN, gid = wgid / nig, fm = gid * WGM, gsz = (nM - fm) < WGM ? (nM - fm) : WGM;
        u.pm = fm + ((wgid % nig) % gsz); u.pn = (wgid % nig) / gsz; u.e = 0; u.row0 = u.pm * BM; return true;
    }
    __device__ __forceinline__ const gchar* a_base(const Unit& u) const { return A + (size_t)u.pm * tstep; }
    __device__ __forceinline__ const gchar* b_base(const Unit& u) const { return Bt + (size_t)u.pn * tstep; }
    __device__ __forceinline__ int gather_row(const Unit&, int) const { return 0; }
};

template <class Epi, class Sched, bool GATHER, bool FP8 = false>
__device__ __forceinline__ void gemm_phase(LAS unsigned char* lds, const int K, const Sched& S, const Epi& E) {
    const int tid = threadIdx.x, wid = __builtin_amdgcn_readfirstlane(tid >> 6), lane = tid & 63, wr = wid >> 2, wc = wid & 3, fr = lane & 15, fq = lane >> 4;
    const int nt = K / BK;
    int Rst[2], Cst[2];
    unsigned voffA[2], voffB[2];
#pragma unroll
    for (int i = 0; i < 2; ++i) { int R, C; stage_rc(tid * 16 + i * 8192, R, C); const int Rb = Epi::PERM ? ((R & ~31) + perm32(R & 31)) : R;
        Rst[i] = R; Cst[i] = C; voffA[i] = (unsigned)(R * K + C) * 2u; voffB[i] = (unsigned)(Rb * K + C) * 2u; }
    const size_t kstep = (size_t)(BK * 2);
    const size_t hstep = (size_t)HALF * K * 2;
    const unsigned ldsw = (unsigned)wid * 1024u;
    const int aoff = lds_byte(wr * 64 + fr, fq * 8), boff = lds_byte(wc * 32 + fr, fq * 8);
#define PG8_SA(b, h) (((b) * 2 + (h)) * HTB)
#define PG8_SB(b, h) ((4 + (b) * 2 + (h)) * HTB)
#define PG8_STAGE(bufoff, gbase, voff) do { _Pragma("unroll") for (int _i = 0; _i < 2; ++_i) \
        __builtin_amdgcn_global_load_lds((const GAS unsigned*)((const gchar*)(gbase) + (voff)[_i]), (LAS unsigned*)(lds + (bufoff) + ldsw + _i * 8192), 16, 0, 0); } while (0)
#define PG8_LDA(dst, b, h) do { _Pragma("unroll") for (int m = 0; m < 4; ++m) _Pragma("unroll") for (int k = 0; k < 2; ++k) dst[m][k] = *(const LAS bf16x8*)(lds + PG8_SA(b, h) + aoff + m * 2048 + k * 1024); } while (0)
#define PG8_LDB(dst, b, h) do { _Pragma("unroll") for (int n = 0; n < 2; ++n) _Pragma("unroll") for (int k = 0; k < 2; ++k) dst[n][k] = *(const LAS bf16x8*)(lds + PG8_SB(b, h) + boff + n * 2048 + k * 1024); } while (0)
#define PG8_CAT(x) __builtin_shufflevector(__builtin_bit_cast(i32x4, (x)[0]), __builtin_bit_cast(i32x4, (x)[1]), 0, 1, 2, 3, 4, 5, 6, 7)
#define PG8_MMA(ai, bj, At, Bt) do { __builtin_amdgcn_s_setprio(1); \
        if constexpr (FP8) { i32x8 _a8[4], _b8[2]; _Pragma("unroll") for (int m = 0; m < 4; ++m) _a8[m] = PG8_CAT(At[m]); _Pragma("unroll") for (int n = 0; n < 2; ++n) _b8[n] = PG8_CAT(Bt[n]); \
            _Pragma("unroll") for (int m = 0; m < 4; ++m) _Pragma("unroll") for (int n = 0; n < 2; ++n) \
                asm volatile("v_mfma_scale_f32_16x16x128_f8f6f4 %0, %1, %2, %0, %3, %4 op_sel_hi:[0,0,0]" : "+v"(acc[ai][bj][m][n]) : "v"(_b8[n]), "v"(_a8[m]), "v"(mx_sc[bj]), "v"(mx_one)); } \
        else { _Pragma("unroll") for (int m = 0; m < 4; ++m) _Pragma("unroll") for (int n = 0; n < 2; ++n) _Pragma("unroll") for (int k = 0; k < 2; ++k) \
            acc[ai][bj][m][n] = __builtin_amdgcn_mfma_f32_16x16x32_bf16(Bt[n][k], At[m][k], acc[ai][bj][m][n], 0, 0, 0); } __builtin_amdgcn_s_setprio(0); } while (0)
#define PG8_MMAZ(ai, bj, At, Bt) do { __builtin_amdgcn_s_setprio(1); \
        if constexpr (FP8) { i32x8 _a8[4], _b8[2]; _Pragma("unroll") for (int m = 0; m < 4; ++m) _a8[m] = PG8_CAT(At[m]); _Pragma("unroll") for (int n = 0; n < 2; ++n) _b8[n] = PG8_CAT(Bt[n]); \
            _Pragma("unroll") for (int m = 0; m < 4; ++m) _Pragma("unroll") for (int n = 0; n < 2; ++n) \
                asm volatile("v_mfma_scale_f32_16x16x128_f8f6f4 %0, %1, %2, 0, %3, %4 op_sel_hi:[0,0,0]" : "=&v"(acc[ai][bj][m][n]) : "v"(_b8[n]), "v"(_a8[m]), "v"(mx_sc[bj]), "v"(mx_one)); } \
        else { _Pragma("unroll") for (int m = 0; m < 4; ++m) _Pragma("unroll") for (int n = 0; n < 2; ++n) { \
            acc[ai][bj][m][n] = __builtin_amdgcn_mfma_f32_16x16x32_bf16(Bt[n][0], At[m][0], (f32x4){0.f, 0.f, 0.f, 0.f}, 0, 0, 0); \
            acc[ai][bj][m][n] = __builtin_amdgcn_mfma_f32_16x16x32_bf16(Bt[n][1], At[m][1], acc[ai][bj][m][n], 0, 0, 0); } } __builtin_amdgcn_s_setprio(0); } while (0)
#define PG8_MMA1(ai, bj, At, Bt) do { if (FP8 && t == 0) PG8_MMAZ(ai, bj, At, Bt); else PG8_MMA(ai, bj, At, Bt); } while (0)
#define PG8_WAIT_V(n) asm volatile("s_waitcnt vmcnt(" #n ")" ::: "memory")
#define PG8_WAIT_L(n) asm volatile("s_waitcnt lgkmcnt(" #n ")" ::: "memory")
#define PG8_BAR __builtin_amdgcn_s_barrier()
#define PG8_SCHED __builtin_amdgcn_sched_barrier(0)
    Unit cur, nxt; int ui = 0;
    if (!S.next(0, cur)) return;
#if STAGGER_TICKS
    {
      const unsigned long long t0 = __builtin_amdgcn_s_memrealtime(); const unsigned long long dt = (unsigned long long)((blockIdx.x >> 3) & 3) * STAGGER_TICKS;
      while (__builtin_amdgcn_s_memrealtime() - t0 < dt) __builtin_amdgcn_s_sleep(8); }
#endif
    f32x4 acc[2][2][4][2];
#pragma unroll
    for (int a = 0; a < 2; ++a)
#pragma unroll
        for (int b = 0; b < 2; ++b)
#pragma unroll
            for (int m = 0; m < 4; ++m)
#pragma unroll
                for (int n = 0; n < 2; ++n) acc[a][b][m][n] = (f32x4){0.f, 0.f, 0.f, 0.f};
    bf16x8 At[4][2], B0[2][2], B1[2][2]; int mx_one = 0x7f7f7f7f; asm volatile("" : "+v"(mx_one));
    int mx_sc[2] = {0x7f7f7f7f, 0x7f7f7f7f};
    if constexpr (FP8) { mx_sc[0] = 0x01010101 * (127 + Epi::MXE0); mx_sc[1] = 0x01010101 * (127 + Epi::MXE1); asm volatile("" : "+v"(mx_sc[0]), "+v"(mx_sc[1])); }
    const gchar* cA = S.a_base(cur); const gchar* cB = S.b_base(cur);
    unsigned vc0[2], vc1[2], vn0[2], vn1[2];
    if constexpr (GATHER) {
#pragma unroll
        for (int i = 0; i < 2; ++i) { vc0[i] = ((unsigned)S.gather_row(cur, Rst[i]) * (unsigned)K + (unsigned)Cst[i]) * 2u; vc1[i] = ((unsigned)S.gather_row(cur, HALF + Rst[i]) * (unsigned)K + (unsigned)Cst[i]) * 2u; vn0[i] = vc0[i]; vn1[i] = vc1[i]; }
    } else {
#pragma unroll
        for (int i = 0; i < 2; ++i) { vc0[i] = voffA[i]; vc1[i] = voffA[i] + (unsigned)hstep; vn0[i] = vc0[i]; vn1[i] = vc1[i]; }
    }
    PG8_STAGE(PG8_SB(0, 0), cB, voffB); PG8_STAGE(PG8_SA(0, 0), cA, vc0); PG8_STAGE(PG8_SB(0, 1), cB + hstep, voffB); PG8_STAGE(PG8_SA(0, 1), cA, vc1);
    if (wr == 1) PG8_BAR;
    PG8_WAIT_V(4); PG8_BAR;
    PG8_STAGE(PG8_SB(1, 0), cB + kstep, voffB); PG8_STAGE(PG8_SA(1, 0), cA + kstep, vc0); PG8_STAGE(PG8_SB(1, 1), cB + hstep + kstep, voffB);
    PG8_WAIT_V(6); PG8_BAR;
    for (;;) {
        const bool has_next = S.next(ui + 1, nxt);
        const gchar* nA = has_next ? S.a_base(nxt) : cA; const gchar* nB = has_next ? S.b_base(nxt) : cB;
        for (int t = 0; t < nt; t += 2) {
            const bool last = (t == nt - 2);
            const gchar* a1 = cA + (size_t)(t + 1) * kstep;
            const gchar* a2 = last ? nA : cA + (size_t)(t + 2) * kstep; const gchar* b2 = last ? nB : cB + (size_t)(t + 2) * kstep;
            const gchar* a3 = a2 + kstep; const gchar* b3 = b2 + kstep;
            unsigned s0[2], s1[2];
            if constexpr (GATHER) {
                if (last && has_next) {
#pragma unroll
                    for (int i = 0; i < 2; ++i) { vn0[i] = ((unsigned)S.gather_row(nxt, Rst[i]) * (unsigned)K + (unsigned)Cst[i]) * 2u; vn1[i] = ((unsigned)S.gather_row(nxt, HALF + Rst[i]) * (unsigned)K + (unsigned)Cst[i]) * 2u; }
                }
#pragma unroll
                for (int i = 0; i < 2; ++i) { s0[i] = last ? vn0[i] : vc0[i]; s1[i] = last ? vn1[i] : vc1[i]; }
            } else {
#pragma unroll
                for (int i = 0; i < 2; ++i) { s0[i] = vc0[i]; s1[i] = vc1[i]; }
            }
            PG8_LDB(B0, 0, 0); PG8_SCHED; PG8_LDA(At, 0, 0); PG8_STAGE(PG8_SA(1, 1), a1, vc1);
            PG8_WAIT_L(8); PG8_BAR; PG8_WAIT_L(0); PG8_MMA1(0, 0, At, B0); PG8_BAR; PG8_SCHED;
            PG8_LDB(B1, 0, 1); PG8_STAGE(PG8_SB(0, 0), b2, voffB);
            PG8_BAR; PG8_WAIT_L(0); PG8_MMA1(0, 1, At, B1); PG8_BAR;
            PG8_LDA(At, 0, 1); PG8_STAGE(PG8_SA(0, 0), a2, s0);
            PG8_BAR; PG8_WAIT_L(0); PG8_MMA1(1, 0, At, B0); PG8_BAR; PG8_SCHED;
            PG8_STAGE(PG8_SB(0, 1), b2 + hstep, voffB);
            PG8_WAIT_V(6); PG8_BAR; PG8_MMA1(1, 1, At, B1); PG8_BAR;
            PG8_LDB(B0, 1, 0); PG8_SCHED; PG8_LDA(At, 1, 0); PG8_STAGE(PG8_SA(0, 1), a2, s1);
            PG8_WAIT_L(8); PG8_BAR; PG8_WAIT_L(0); PG8_MMA(0, 0, At, B0); PG8_BAR; PG8_SCHED;
            PG8_LDB(B1, 1, 1); PG8_STAGE(PG8_SB(1, 0), b3, voffB);
            PG8_BAR; PG8_WAIT_L(0); PG8_MMA(0, 1, At, B1); PG8_BAR;
            PG8_LDA(At, 1, 1); PG8_STAGE(PG8_SA(1, 0), a3, s0);
            PG8_BAR; PG8_WAIT_L(0); PG8_MMA(1, 0, At, B0); PG8_BAR; PG8_SCHED;
            PG8_STAGE(PG8_SB(1, 1), b3 + hstep, voffB);
            PG8_WAIT_V(6); PG8_BAR; PG8_MMA(1, 1, At, B1); PG8_BAR;
        }
        if constexpr (FP8) {
            asm volatile("s_nop 15\n\ts_nop 3" : "+v"(acc[1][1][0][0]), "+v"(acc[1][1][0][1]), "+v"(acc[1][1][1][0]), "+v"(acc[1][1][1][1]), "+v"(acc[1][1][2][0]), "+v"(acc[1][1][2][1]), "+v"(acc[1][1][3][0]), "+v"(acc[1][1][3][1])); }
        E(acc, cur, wr, wc, fr, fq);
        if (!has_next) break;
        if constexpr (!FP8) {
#pragma unroll
            for (int a = 0; a < 2; ++a)
#pragma unroll
                for (int b = 0; b < 2; ++b)
#pragma unroll
                    for (int m = 0; m < 4; ++m)
#pragma unroll
                        for (int n = 0; n < 2; ++n) acc[a][b][m][n] = (f32x4){0.f, 0.f, 0.f, 0.f}; }
        cur = nxt; cA = nA; cB = nB; ++ui;
#pragma unroll
        for (int i = 0; i < 2; ++i) { vc0[i] = vn0[i]; vc1[i] = vn1[i]; }
    }
    PG8_WAIT_V(0);
    if (wr == 0) PG8_BAR;
    PG8_BAR;
#undef PG8_SA
#undef PG8_SB
#undef PG8_STAGE
#undef PG8_LDA
#undef PG8_LDB
#undef PG8_MMA
#undef PG8_MMAZ
#undef PG8_MMA1
#undef PG8_CAT
#undef PG8_WAIT_V
#undef PG8_WAIT_L
#undef PG8_BAR
#undef PG8_SCHED
}
}
using pg8::Unit;

enum { IN_X = 0, IN_C, IN_CTX, IN_CCTX, IN_ADAW, IN_ADAB, IN_NMIXW, IN_NFFNW, IN_CONVIN, IN_CONVDW, IN_CONVOUT, IN_MLIN, IN_MLGB, IN_MLNW, IN_MLOUT,
       IN_RW, IN_RB, IN_EG, IN_EU, IN_ED, IN_SG, IN_SU, IN_SD, IN_FNW, N_IN };
struct Args { const float* in[N_IN]; float* out; unsigned char* ws; int ph_lo, ph_hi, li, pad; };

#define INP(i) ((const gf32*)F.a->in[i])
struct Frame {
    LAS unsigned char* lds;
    int tid, lane, wave, bid;
    const Args* a; gf32* out; gu8* ws;
};

__device__ __forceinline__ const gf32* mod_ptr(const Frame& F, int layer, int mr, int chunk) { return (const gf32*)(F.ws + WS_MOD) + ((size_t)(layer * 9 + mr) * ADA_N + (size_t)chunk * D); }
__device__ __forceinline__ int mod_row(int r) { return r < NCTX ? 8 : ((r - NCTX) >> 11); }

struct EpiConvIn {
    static constexpr bool PERM = true; static constexpr int MXE0 = 0, MXE1 = 0;
    gbf16* U; gbf16* BMt;
    __device__ __forceinline__ void operator()(const f32x4 (&acc)[2][2][4][2], const Unit& u, int wr, int wc, int fr, int fq) const {
        const int row0 = u.pm * 256 + wr * 64 + fr;
        if (u.pn < 16) {
            const int col = u.pn * 128 + wc * 32 + 8 * fq;
#pragma unroll
            for (int ai = 0; ai < 2; ++ai)
#pragma unroll
                for (int m = 0; m < 4; ++m) {
                    const f32x4 a0 = acc[ai][0][m][0] * acc[ai][1][m][0], a1 = acc[ai][0][m][1] * acc[ai][1][m][1];
                    u32x4 w; w.x = cvt_pk_bf16(a0[0], a0[1]); w.y = cvt_pk_bf16(a0[2], a0[3]); w.z = cvt_pk_bf16(a1[0], a1[1]); w.w = cvt_pk_bf16(a1[2], a1[3]);
                    *(gu32x4*)(U + (size_t)(row0 + ai * 128 + m * 16) * D + col) = w; }
        } else {
            const int col = (u.pn - 16) * 256 + wc * 32 + 8 * fq;
#pragma unroll
            for (int ai = 0; ai < 2; ++ai)
#pragma unroll
                for (int m = 0; m < 4; ++m)
#pragma unroll
                    for (int bj = 0; bj < 2; ++bj) {
                        const f32x4 a0 = acc[ai][bj][m][0], a1 = acc[ai][bj][m][1];
                        u32x4 w; w.x = cvt_pk_bf16(a0[0], a0[1]); w.y = cvt_pk_bf16(a0[2], a0[3]); w.z = cvt_pk_bf16(a1[0], a1[1]); w.w = cvt_pk_bf16(a1[2], a1[3]);
                        *(gu32x4*)(BMt + (size_t)(row0 + ai * 128 + m * 16) * D + col + bj * 128) = w; }
        }
    }
};
template <bool BB>
struct EpiResidT {
    static constexpr bool PERM = false; static constexpr int MXE0 = 0, MXE1 = 0;
    const gf32* base_ctx; const gf32* base_lat; gf32* X; const gf32* gmod; int row_off;
    __device__ __forceinline__ void operator()(const f32x4 (&acc)[2][2][4][2], const Unit& u, int wr, int wc, int fr, int fq) const {
        const int R0 = row_off + u.pm * 256;
        const gf32* base = (R0 < NCTX) ? base_ctx + (size_t)R0 * D : base_lat + (size_t)(R0 - NCTX) * D;
        const gf32* g = gmod + (size_t)mod_row(R0) * ADA_N;
        gf32* o = X + (size_t)R0 * D;
        const int rl0 = wr * 64 + fr, col0 = u.pn * 256 + wc * 32 + 4 * fq;
        f32x4 gv[2][2];
#pragma unroll
        for (int bj = 0; bj < 2; ++bj)
#pragma unroll
            for (int n = 0; n < 2; ++n) gv[bj][n] = *(const gf32x4*)(g + col0 + bj * 128 + n * 16);
#pragma unroll
        for (int ah = 0; ah < 4; ++ah) { const int ai = ah >> 1, m0 = (ah & 1) * 2;
            f32x4 bv[2][2][2];
#pragma unroll
            for (int mm = 0; mm < 2; ++mm) { const size_t ro = (size_t)(rl0 + ai * 128 + (m0 + mm) * 16) * D + col0;
#pragma unroll
                for (int bj = 0; bj < 2; ++bj)
#pragma unroll
                    for (int n = 0; n < 2; ++n) {
                        if constexpr (BB) { const u32x2 w = *(const gu32x2*)((const gbf16*)base_lat + (size_t)(R0 - NCTX) * D + ro + bj * 128 + n * 16); bv[mm][bj][n] = (f32x4){bf_lo(w.x), bf_hi(w.x), bf_lo(w.y), bf_hi(w.y)}; }
                        else bv[mm][bj][n] = *(const gf32x4*)(base + ro + bj * 128 + n * 16); } }
#pragma unroll
            for (int mm = 0; mm < 2; ++mm) { const size_t ro = (size_t)(rl0 + ai * 128 + (m0 + mm) * 16) * D + col0;
#pragma unroll
                for (int bj = 0; bj < 2; ++bj)
#pragma unroll
                    for (int n = 0; n < 2; ++n) *(gf32x4*)(o + ro + bj * 128 + n * 16) = bv[mm][bj][n] + gv[bj][n] * acc[ai][bj][m0 + mm][n]; } }
    }
};
using EpiResid = EpiResidT<false>;
__device__ __forceinline__ float softcap_gate(float g) {
    const float e = fast_exp(-2.0f * g * (1.0f / 15.0f)); return 15.0f * (1.0f - e) / (1.0f + e);
}
__device__ __forceinline__ float log_sigmoid_(float g) { return fminf(g, 0.0f) - __logf(1.0f + fast_exp(-fabsf(g))); }
struct EpiMlstmIn {
    static constexpr bool PERM = true; static constexpr int MXE0 = 0, MXE1 = 0;
    gbf16 *Q, *Kb, *V, *O;
    __device__ __forceinline__ void operator()(const f32x4 (&acc)[2][2][4][2], const Unit& u, int wr, int wc, int fr, int fq) const {
        const int row0 = u.pm * 256 + wr * 64 + fr;
        {
            gbf16* dst; int ld, ct; float sc = 1.0f;
            if (u.pn < 4) { dst = Q; ld = 1024; ct = u.pn; } else if (u.pn < 8) { dst = Kb; ld = 1024; ct = u.pn - 4; sc = 0.08838834764831845f; }
            else if (u.pn < 16) { dst = V; ld = 2048; ct = u.pn - 8; } else { dst = O; ld = 2048; ct = u.pn - 16; }
            const int col = ct * 256 + wc * 32 + 8 * fq;
#pragma unroll
            for (int ai = 0; ai < 2; ++ai)
#pragma unroll
                for (int m = 0; m < 4; ++m)
#pragma unroll
                    for (int bj = 0; bj < 2; ++bj) {
                        const f32x4 a0 = acc[ai][bj][m][0] * sc, a1 = acc[ai][bj][m][1] * sc;
                        u32x4 w; w.x = cvt_pk_bf16(a0[0], a0[1]); w.y = cvt_pk_bf16(a0[2], a0[3]); w.z = cvt_pk_bf16(a1[0], a1[1]); w.w = cvt_pk_bf16(a1[2], a1[3]);
                        *(gu32x4*)(dst + (size_t)(row0 + ai * 128 + m * 16) * ld + col + bj * 128) = w; }
        }
    }
};
struct EpiSwiglu {
    static constexpr bool PERM = true;
    static constexpr int MXE0 = -6, MXE1 = -2;
    gu8* ACT;
    __device__ __forceinline__ void operator()(const f32x4 (&acc)[2][2][4][2], const Unit& u, int wr, int wc, int fr, int fq) const {
        const int row0 = u.row0 + wr * 64 + fr, col = u.pn * 128 + wc * 32 + 8 * fq;
#pragma unroll
        for (int ai = 0; ai < 2; ++ai)
#pragma unroll
            for (int m = 0; m < 4; ++m) {
                f32x4 a0, a1;
#pragma unroll
                for (int j = 0; j < 4; ++j) { a0[j] = siluf_(acc[ai][0][m][0][j]) * acc[ai][1][m][0][j]; a1[j] = siluf_(acc[ai][0][m][1][j]) * acc[ai][1][m][1][j]; }
                u32x2 w; w.x = pk4_fp8(a0); w.y = pk4_fp8(a1);
                *(gu32x2*)(ACT + (size_t)(row0 + ai * 128 + m * 16) * ED + col) = w; }
    }
};
struct EpiDown {
    static constexpr bool PERM = true;
    static constexpr int MXE0 = -9, MXE1 = -9;
    gu8* Y;
    __device__ __forceinline__ void operator()(const f32x4 (&acc)[2][2][4][2], const Unit& u, int wr, int wc, int fr, int fq) const {
        const int row0 = u.row0 + wr * 64 + fr, col = u.pn * 256 + wc * 64 + 16 * fq;
#pragma unroll
        for (int ai = 0; ai < 2; ++ai)
#pragma unroll
            for (int m = 0; m < 4; ++m) { const int slot = row0 + ai * 128 + m * 16;
                u32x4 w; w.x = pk4_fp8(acc[ai][0][m][0]); w.y = pk4_fp8(acc[ai][0][m][1]); w.z = pk4_fp8(acc[ai][1][m][0]); w.w = pk4_fp8(acc[ai][1][m][1]);
                *(gu32x4*)(Y + (size_t)slot * D + col) = w; }
    }
};

constexpr int LDS_UNITS = RING_BYTES;
struct ExpertOrder {
    const LAS i32x4* units; const gchar* A; const gchar* Bt; const gi32* tok_of; int K, erows;
    __device__ __forceinline__ bool next(int i, Unit& u) const {
        const i32x4 d = units[i];
        u.e = __builtin_amdgcn_readfirstlane(d.x); u.pm = __builtin_amdgcn_readfirstlane(d.y); u.pn = __builtin_amdgcn_readfirstlane(d.z); u.row0 = __builtin_amdgcn_readfirstlane(d.w);
        return u.e >= 0;
    }
    __device__ __forceinline__ const gchar* a_base(const Unit& u) const { return tok_of ? A : A + (size_t)u.row0 * K * 2; }
    __device__ __forceinline__ const gchar* b_base(const Unit& u) const { return Bt + ((size_t)u.e * erows + (size_t)u.pn * 256) * K * 2; }
    __device__ __forceinline__ int gather_row(const Unit& u, int r) const { return tok_of[u.row0 + r]; }
};
__device__ __forceinline__ const LAS i32x4* stage_units(Frame& F, const gi32x4* g, int n) {
    LAS i32x4* l = (LAS i32x4*)(F.lds + LDS_UNITS);
    if (F.tid < n) l[F.tid] = g[F.tid];
    __syncthreads();
    return l;
}
__device__ __forceinline__ bool class_unit(const LAS int* tot, const LAS int* pst, int x, int q, int npn, int shs, int shn, i32x4& d) {
#pragma unroll 1
    for (int kk = 0; kk < 8; ++kk) { const int e = x + 8 * kk; const int n = ((tot[e] + 255) >> 8) * npn;
        if (q < n) { const int mt = q / npn; d = (i32x4){e, mt, q - mt * npn, pst[e] + 256 * mt}; return true; } q -= n; }
    if (q < shn * npn) { const int mt = shs + q / npn; d = (i32x4){64, mt, q % npn, SH_BASE + 256 * mt}; return true; }
    d = (i32x4){-1, 0, 0, 0}; return false;
}
__device__ __forceinline__ void shared_share(const LAS int* rt, int S, int x, int& shs, int& shn) {
    int R = 0;
#pragma unroll
    for (int y = 0; y < 8; ++y) R += rt[y];
    int lv = (R + S + 7) >> 3;
#pragma unroll 1
    for (;;) { int cap = 0;
#pragma unroll
        for (int y = 0; y < 8; ++y) cap += max(0, lv - rt[y]);
        if (cap >= S) break; ++lv; }
    int left = S; shs = 0; shn = 0;
#pragma unroll
    for (int y = 0; y < 8; ++y) { const int n = min(max(0, lv - rt[y]), left); if (y == x) { shs = S - left; shn = n; } left -= n; }
}

__device__ __forceinline__ int down_row(int c) { return (c & ~255) + 128 * ((c >> 3) & 1) + 32 * ((c >> 6) & 3) + 8 * ((c >> 4) & 3) + (c & 7); }
__device__ __forceinline__ void tr_item(const gf32* __restrict__ W, int ldw, int K, gbf16* WT, int drow, int k0, int n0src, LAS float* scr, int lane, bool dperm = false, float fp8 = 0.f) {
    float tv[32];
    const gf32* wp = W + (size_t)(k0 + (lane >> 5)) * ldw + n0src + (lane & 31);
#pragma unroll
    for (int i = 0; i < 32; ++i) tv[i] = __builtin_nontemporal_load(wp + (size_t)(2 * i) * ldw);
#pragma unroll
    for (int i = 0; i < 32; ++i) scr[(2 * i + (lane >> 5)) * 33 + (lane & 31)] = tv[i];
    LDS_WAIT(); asm volatile("" ::: "memory");
    if (fp8 != 0.f) {
        const int c4 = lane & 3; gu8* W8 = (gu8*)WT;
#pragma unroll
        for (int j = 0; j < 2; ++j) { const int n = (lane >> 2) + 16 * j; const LAS float* s = scr + (16 * c4) * 33 + n; u32x4 o;
#pragma unroll
            for (int q = 0; q < 4; ++q) o[q] = pk4_fp8((f32x4){s[(4 * q) * 33], s[(4 * q + 1) * 33], s[(4 * q + 2) * 33], s[(4 * q + 3) * 33]} * fp8);
            *(gu32x4*)(W8 + (size_t)(dperm ? down_row(drow + n) : drow + n) * K + k0 + 16 * c4) = o; }
        LDS_WAIT(); asm volatile("" ::: "memory");
        return; }
    const int c = lane & 7;
#pragma unroll
    for (int j = 0; j < 4; ++j) { const int n = (lane >> 3) + 8 * j; const LAS float* s = scr + (8 * c) * 33 + n;
        u32x4 o; o.x = cvt_pk_bf16(s[0 * 33], s[1 * 33]); o.y = cvt_pk_bf16(s[2 * 33], s[3 * 33]); o.z = cvt_pk_bf16(s[4 * 33], s[5 * 33]); o.w = cvt_pk_bf16(s[6 * 33], s[7 * 33]);
        *(gu32x4*)(WT + (size_t)(dperm ? down_row(drow + n) : drow + n) * K + k0 + 8 * c) = o; }
    LDS_WAIT(); asm volatile("" ::: "memory");
}
__device__ __forceinline__ void tr_job(int r, const gf32* src, int ldw, int col0, int K, int N, size_t sbatch, gbf16* dst, size_t dbatch, int row_off, int seg, int segs, LAS float* scr, int lane, bool dperm = false, float fp8 = 0.f) {
    const int nblk = N >> 5, ipb = (K >> 6) * nblk;
    const int bt = r / ipb, rr = r - bt * ipb, kb = rr / nblk, nb = rr - kb * nblk, n0 = nb << 5;
    tr_item(src + (size_t)bt * sbatch, ldw, K, dst + (size_t)bt * dbatch, row_off + (n0 / seg) * segs + (n0 % seg), kb << 6, col0 + n0, scr, lane, dperm, fp8);
}
__device__ __forceinline__ void phase_prologue(Frame& F) {
    if (F.bid < 192) {
        LAS float* cond = (LAS float*)F.lds;
        LAS float* red = (LAS float*)(F.lds + 9 * 2048 * 4);
        for (int i = F.tid; i < 9 * 2048; i += NTHR) { const int r = i >> 11, k = i & 2047; const float v = (r < 8) ? INP(IN_C)[r * D + k] : INP(IN_CCTX)[k]; cond[i] = siluf_(v); }
        __syncthreads();
        const int l = F.bid / 96, col0 = (F.bid % 96) * 128, cg = F.tid & 31, kl = F.tid >> 5;
        const gf32* W = INP(IN_ADAW) + (size_t)l * D * ADA_N + col0 + 4 * cg;
        f32x4 acc[9];
#pragma unroll
        for (int r = 0; r < 9; ++r) acc[r] = (f32x4){0.f, 0.f, 0.f, 0.f};
#pragma unroll 8
        for (int k = kl; k < D; k += 16) { const f32x4 w4 = __builtin_nontemporal_load((const gf32x4*)(W + (size_t)k * ADA_N));
#pragma unroll
            for (int r = 0; r < 9; ++r) acc[r] += cond[r * 2048 + k] * w4; }
#pragma unroll
        for (int r = 0; r < 9; ++r) *(LAS f32x4*)(red + (kl * 9 + r) * 128 + 4 * cg) = acc[r];
        __syncthreads();
        gf32* mod = (gf32*)(F.ws + WS_MOD);
        for (int o = F.tid; o < 9 * 128; o += NTHR) { const int r = o >> 7, c = o & 127; float s = 0.f;
#pragma unroll
            for (int q = 0; q < 16; ++q) s += red[(q * 9 + r) * 128 + c];
            mod[(size_t)(l * 9 + r) * ADA_N + col0 + c] = s + INP(IN_ADAB)[l * ADA_N + col0 + c]; }
        __syncthreads();
    }
    LAS float* scr = (LAS float*)(F.lds + F.wave * 8704);
    const int gw = F.bid * NWAVES + F.wave, NGW = GRID * NWAVES;
    gbf16* convin_t = (gbf16*)(F.ws + WS_CONVIN_T); gbf16* convout_t = (gbf16*)(F.ws + WS_CONVOUT_T);
    gbf16* mlin_t = (gbf16*)(F.ws + WS_MLIN_T); gbf16* mlout_t = (gbf16*)(F.ws + WS_MLOUT_T);
    constexpr int I_SQ = 32 * 64, I_MLIN = 32 * 193, I_RT = 32 * 2, I_EGU = 64 * 32 * 16, I_EDN = 64 * 8 * 64, I_SGU = 32 * 16, I_SDN = 8 * 64;
    constexpr int I_MOE = I_RT + 2 * I_EGU + I_EDN + 2 * I_SGU + I_SDN;
    constexpr int NITEMS = 4 * I_SQ + I_MLIN + I_SQ + 2 * I_MOE;
    gi32* ctr = (gi32*)(F.ws + WS_CTL) + CW_P0CTR;
    (void)gw; (void)NGW;
    for (;;) {
        int base = 0; if (F.lane == 0) base = __hip_atomic_fetch_add(ctr, 16, __ATOMIC_RELAXED, __HIP_MEMORY_SCOPE_AGENT);
        base = __builtin_amdgcn_readfirstlane(base);
        if (base >= NITEMS) break;
        const int lim = (base + 16 < NITEMS) ? base + 16 : NITEMS;
      for (int it = base; it < lim; ++it) {
        int r = it;
        if (r < I_SQ) { tr_job(r, INP(IN_CONVIN), 3 * D, 2048, D, D, 0, convin_t, 0, 0, 128, 256, scr, F.lane); continue; } r -= I_SQ;
        if (r < I_SQ) { tr_job(r, INP(IN_CONVIN), 3 * D, 4096, D, D, 0, convin_t, 0, 128, 128, 256, scr, F.lane); continue; } r -= I_SQ;
        if (r < I_SQ) { tr_job(r, INP(IN_CONVIN), 3 * D, 0, D, D, 0, convin_t, 0, 4096, D, 0, scr, F.lane); continue; } r -= I_SQ;
        if (r < I_SQ) { tr_job(r, INP(IN_CONVOUT), D, 0, D, D, 0, convout_t, 0, 0, D, 0, scr, F.lane); continue; } r -= I_SQ;
        if (r < I_MLIN) { tr_job(r, INP(IN_MLIN), MLSTM_N, 0, D, MLSTM_N, 0, mlin_t, 0, 0, 8192, 0, scr, F.lane); continue; } r -= I_MLIN;
        if (r < I_SQ) { tr_job(r, INP(IN_MLOUT), D, 0, D, D, 0, mlout_t, 0, 0, D, 0, scr, F.lane); continue; } r -= I_SQ;
        const int l = r / I_MOE; r -= l * I_MOE;
        gu8* moe = F.ws + WS_MOE0 + (size_t)l * MOE_STRIDE;
        gbf16* gu_t = (gbf16*)(moe + MOE_GU); gbf16* dn_t = (gbf16*)(moe + MOE_DN); gbf16* rt_t = (gbf16*)(moe + MOE_RT);
        if (r < I_RT) { tr_job(r, INP(IN_RW) + (size_t)l * D * NE, NE, 0, D, NE, 0, rt_t, 0, 0, NE, 0, scr, F.lane); continue; } r -= I_RT;
        if (r < I_EGU) { tr_job(r, INP(IN_EG) + (size_t)l * NE * D * ED, ED, 0, D, ED, (size_t)D * ED, gu_t, (size_t)512 * D, 0, 128, 256, scr, F.lane, false, GU_WSCALE); continue; } r -= I_EGU;
        if (r < I_EGU) { tr_job(r, INP(IN_EU) + (size_t)l * NE * D * ED, ED, 0, D, ED, (size_t)D * ED, gu_t, (size_t)512 * D, 128, 128, 256, scr, F.lane, false, GU_WSCALE); continue; } r -= I_EGU;
        if (r < I_EDN) { tr_job(r, INP(IN_ED) + (size_t)l * NE * ED * D, D, 0, ED, D, (size_t)ED * D, dn_t, (size_t)D * ED / 2, 0, D, 0, scr, F.lane, true, DN_WSCALE); continue; } r -= I_EDN;
        if (r < I_SGU) { tr_job(r, INP(IN_SG) + (size_t)l * D * ED, ED, 0, D, ED, 0, gu_t + (size_t)64 * 512 * D, 0, 0, 128, 256, scr, F.lane, false, GU_WSCALE); continue; } r -= I_SGU;
        if (r < I_SGU) { tr_job(r, INP(IN_SU) + (size_t)l * D * ED, ED, 0, D, ED, 0, gu_t + (size_t)64 * 512 * D, 0, 128, 128, 256, scr, F.lane, false, GU_WSCALE); continue; } r -= I_SGU;
        tr_job(r, INP(IN_SD) + (size_t)l * ED * D, D, 0, ED, D, 0, dn_t + (size_t)64 * D * ED / 2, 0, 0, D, 0, scr, F.lane, true, DN_WSCALE);
      }
    }
    { gu32x4* z = (gu32x4*)(mlin_t + (size_t)MLSTM_N * D); const int n16 = (MLSTM_NP - MLSTM_N) * D * 2 / 16;
      for (int i = F.bid * NTHR + F.tid; i < n16; i += GRID * NTHR) z[i] = (u32x4){0u, 0u, 0u, 0u}; }
}

template <bool LB> __device__ __forceinline__ int col_of(int lane, int j) { return LB ? 16 * lane + 1024 * (j >> 2) + 4 * (j & 3) : 4 * lane + 256 * j; }
template <bool TO_LDS, bool LB = false>
__device__ __forceinline__ void norm_mod_store(const f32x4 (&v)[8], float rstd, const gf32* w, const gf32* shift, const gf32* scale, gbf16* orow, LAS bf16_t* lrow, int lane) {
#pragma unroll
    for (int j = 0; j < 8; ++j) { const int c = col_of<LB>(lane, j);
        const f32x4 w4 = *(const gf32x4*)(w + c), sc = *(const gf32x4*)(scale + c), sh = *(const gf32x4*)(shift + c);
        const f32x4 y = (v[j] * rstd) * w4 * (sc + 1.0f) + sh;
        u32x2 o; o.x = cvt_pk_bf16(y[0], y[1]); o.y = cvt_pk_bf16(y[2], y[3]);
        *(gu32x2*)(orow + c) = o;
        if (TO_LDS) *(LAS u32x2*)(lrow + c) = o; }
}
__device__ __forceinline__ float row_ssq(const f32x4 (&v)[8]) {
    float s = 0.f;
#pragma unroll
    for (int j = 0; j < 8; ++j) s += (v[j][0] * v[j][0] + v[j][1] * v[j][1]) + (v[j][2] * v[j][2] + v[j][3] * v[j][3]);
    return wave_sum(s);
}

__device__ __forceinline__ void phase_norm0(Frame& F) {
    gbf16* H = (gbf16*)(F.ws + WS_H);
    const int gw = F.bid * NWAVES + F.wave, NGW = GRID * NWAVES;
    for (int r = gw; r < NTOK; r += NGW) {
        const gf32* xr = (r < NCTX) ? INP(IN_CTX) + (size_t)r * D : INP(IN_X) + (size_t)(r - NCTX) * D;
        f32x4 v[8];
#pragma unroll
        for (int j = 0; j < 8; ++j) v[j] = *(const gf32x4*)(xr + 4 * F.lane + 256 * j);
        const float rstd = rsqrtf(row_ssq(v) * (1.0f / D) + EPS);
        const int mr = mod_row(r);
        norm_mod_store<false>(v, rstd, INP(IN_NMIXW), mod_ptr(F, 0, mr, 0), mod_ptr(F, 0, mr, 1), H + (size_t)r * D, (LAS bf16_t*)F.lds, F.lane);
    }
}

__device__ __forceinline__ void phase_conv(Frame& F) {
    const gbf16* U = (const gbf16*)(F.ws + WS_U); const gbf16* BMt = (const gbf16*)(F.ws + WS_BM); gbf16* Z = (gbf16*)(F.ws + WS_Z);
    const gf32* dw = INP(IN_CONVDW);
    const int total = NTOK * (D / 8);
    for (int i = F.bid * NTHR + F.tid; i < total; i += GRID * NTHR) {
        const int r = i >> 8, c = (i & 255) * 8;
        const int pos = (r < NCTX) ? (r & 255) : (r & 63), seglen = (r < NCTX) ? 256 : 64;
        const u32x4 z4 = (u32x4){0u, 0u, 0u, 0u};
        const u32x4 um = (pos > 0) ? *(const gu32x4*)(U + (size_t)(r - 1) * D + c) : z4;
        const u32x4 u0 = *(const gu32x4*)(U + (size_t)r * D + c);
        const u32x4 up = (pos < seglen - 1) ? *(const gu32x4*)(U + (size_t)(r + 1) * D + c) : z4;
        const u32x4 bb = *(const gu32x4*)(BMt + (size_t)r * D + c);
        float w0[8], w1[8], w2[8];
#pragma unroll
        for (int q = 0; q < 2; ++q) { const f32x4 a = *(const gf32x4*)(dw + c + 4 * q), b = *(const gf32x4*)(dw + D + c + 4 * q), d = *(const gf32x4*)(dw + 2 * D + c + 4 * q);
#pragma unroll
            for (int j = 0; j < 4; ++j) { w0[4 * q + j] = a[j]; w1[4 * q + j] = b[j]; w2[4 * q + j] = d[j]; } }
        u32x4 o;
#pragma unroll
        for (int q = 0; q < 4; ++q) {
            const float y0 = bf_lo(bb[q]) * (w0[2 * q] * bf_lo(um[q]) + w1[2 * q] * bf_lo(u0[q]) + w2[2 * q] * bf_lo(up[q]));
            const float y1 = bf_hi(bb[q]) * (w0[2 * q + 1] * bf_hi(um[q]) + w1[2 * q + 1] * bf_hi(u0[q]) + w2[2 * q + 1] * bf_hi(up[q]));
            o[q] = cvt_pk_bf16(y0, y1); }
        *(gu32x4*)(Z + (size_t)r * D + c) = o;
    }
}

constexpr int HS_PITCH = 2056;
constexpr int RL_HS = 0, RL_PART = 16 * HS_PITCH * 2, RL_LOGIT = RL_PART + 8 * 16 * 64 * 4, RL_IDX = RL_LOGIT + 16 * 64 * 4;
template <int NT>
__device__ __forceinline__ void tile16_mfma(const LAS bf16_t* hs, const gbf16* Wt, LAS float* part, int wave, int lane) {
    f32x4 acc[NT];
#pragma unroll
    for (int nt = 0; nt < NT; ++nt) acc[nt] = (f32x4){0.f, 0.f, 0.f, 0.f};
    const int fr = lane & 15, fq = lane >> 4;
#pragma unroll 4
    for (int ks = 0; ks < 8; ++ks) { const int k0 = 256 * wave + 32 * ks + 8 * fq;
        const bf16x8 a = *(const LAS bf16x8*)(hs + fr * HS_PITCH + k0);
#pragma unroll
        for (int nt = 0; nt < NT; ++nt) { const bf16x8 b = *(const gbf16x8*)(Wt + (size_t)(16 * nt + fr) * D + k0);
            acc[nt] = __builtin_amdgcn_mfma_f32_16x16x32_bf16(a, b, acc[nt], 0, 0, 0); } }
#pragma unroll
    for (int nt = 0; nt < NT; ++nt)
#pragma unroll
        for (int j = 0; j < 4; ++j) part[wave * (256 * NT) + (4 * fq + j) * (16 * NT) + 16 * nt + fr] = acc[nt][j];
}
constexpr int R_HS = 0, R_PART = 0, R_LOGIT = 32 * HS_PITCH * 2, R_VSEL = R_LOGIT + 8192, R_TSC = R_VSEL + 8192, R_BIDX = R_TSC + 1024, R_CNT = R_BIDX + 1728;
static_assert(R_CNT + 2048 <= LDSCTL_OFF, "router LDS map");
__device__ __forceinline__ void phase_router(Frame& F, int layer, int rowbase, int rpb) {
    const gf32* X = (const gf32*)(F.ws + WS_X); gu8* H8 = (gu8*)(F.ws + WS_H8);
    const gbf16* rt_t = (const gbf16*)(F.ws + WS_MOE0 + (size_t)layer * MOE_STRIDE + MOE_RT);
    gi32* sel_idx = (gi32*)(F.ws + RT_SELIDX); gf32* sel_gate = (gf32*)(F.ws + RT_SELGATE); gi32* sel_rank = (gi32*)(F.ws + RT_SELRANK); gi32* hist = (gi32*)(F.ws + RT_HIST);
    LAS bf16_t* hs = (LAS bf16_t*)(F.lds + R_HS); LAS float* part = (LAS float*)(F.lds + R_PART); LAS float* logit = (LAS float*)(F.lds + R_LOGIT);
    LAS float* vsel = (LAS float*)(F.lds + R_VSEL); LAS float* tsc = (LAS float*)(F.lds + R_TSC); LAS int* bidx = (LAS int*)(F.lds + R_BIDX); LAS int* wcnt = (LAS int*)(F.lds + R_CNT);
    const int r0 = rowbase + F.bid * rpb, ngroups = (rpb + 31) >> 5;
    const gf32* nw = INP(IN_NFFNW) + layer * D; const float bias = INP(IN_RB)[layer * NE + F.lane];
    const int fr = F.lane & 15, fq = F.lane >> 4;
#define RT_BAR() do { asm volatile("s_waitcnt lgkmcnt(0)" ::: "memory"); __builtin_amdgcn_s_barrier(); asm volatile("" ::: "memory"); } while (0)
    f32x4 cw[8], cs[8]; int cur_mr = -1;
    for (int g = 0; g < ngroups; ++g) {
#pragma unroll 1
        for (int pr = 0; pr < 2; ++pr) { const int lr = 4 * F.wave + 2 * pr, br = 32 * g + lr; LAS bf16_t* lrow = hs + lr * HS_PITCH;
            if (br < rpb) { const int r = r0 + br, mr = mod_row(r); const gf32* xr = X + (size_t)r * D; f32x4 va[8], vb[8];
#pragma unroll
                for (int j = 0; j < 8; ++j) { va[j] = *(const gf32x4*)(xr + 4 * F.lane + 256 * j); vb[j] = *(const gf32x4*)(xr + D + 4 * F.lane + 256 * j); }
                if (mr != cur_mr) { cur_mr = mr; const gf32* sc = mod_ptr(F, layer, mr, 4); const gf32* sh = mod_ptr(F, layer, mr, 3);
#pragma unroll
                    for (int j = 0; j < 8; ++j) { const int c = 4 * F.lane + 256 * j; cw[j] = *(const gf32x4*)(nw + c) * (*(const gf32x4*)(sc + c) + 1.0f); cs[j] = *(const gf32x4*)(sh + c); } }
                const float rstd0 = rsqrtf(row_ssq(va) * (1.0f / D) + EPS), rstd1 = rsqrtf(row_ssq(vb) * (1.0f / D) + EPS);
#pragma unroll
                for (int j = 0; j < 8; ++j) { const int c = 4 * F.lane + 256 * j;
                    const f32x4 y0 = (va[j] * rstd0) * cw[j] + cs[j], y1 = (vb[j] * rstd1) * cw[j] + cs[j];
                    u32x2 o0, o1; o0.x = cvt_pk_bf16(y0[0], y0[1]); o0.y = cvt_pk_bf16(y0[2], y0[3]); o1.x = cvt_pk_bf16(y1[0], y1[1]); o1.y = cvt_pk_bf16(y1[2], y1[3]);
                    *(GAS unsigned*)(H8 + (size_t)r * D + c) = pk4_fp8(y0); *(GAS unsigned*)(H8 + (size_t)(r + 1) * D + c) = pk4_fp8(y1);
                    *(LAS u32x2*)(lrow + c) = o0; *(LAS u32x2*)(lrow + HS_PITCH + c) = o1; }
            } else {
#pragma unroll
                for (int j = 0; j < 8; ++j) { *(LAS u32x2*)(lrow + 4 * F.lane + 256 * j) = (u32x2){0u, 0u}; *(LAS u32x2*)(lrow + HS_PITCH + 4 * F.lane + 256 * j) = (u32x2){0u, 0u}; } } }
        RT_BAR();
        f32x4 acc[2][4];
#pragma unroll
        for (int t = 0; t < 2; ++t)
#pragma unroll
            for (int nt = 0; nt < 4; ++nt) acc[t][nt] = (f32x4){0.f, 0.f, 0.f, 0.f};
#pragma unroll 4
        for (int ks = 0; ks < 8; ++ks) { const int k0 = 256 * F.wave + 32 * ks + 8 * fq;
            const bf16x8 a0 = *(const LAS bf16x8*)(hs + fr * HS_PITCH + k0), a1 = *(const LAS bf16x8*)(hs + (16 + fr) * HS_PITCH + k0);
#pragma unroll
            for (int nt = 0; nt < 4; ++nt) { const bf16x8 bfr = *(const gbf16x8*)(rt_t + (size_t)(16 * nt + fr) * D + k0);
                acc[0][nt] = __builtin_amdgcn_mfma_f32_16x16x32_bf16(a0, bfr, acc[0][nt], 0, 0, 0); acc[1][nt] = __builtin_amdgcn_mfma_f32_16x16x32_bf16(a1, bfr, acc[1][nt], 0, 0, 0); } }
        RT_BAR();
#pragma unroll
        for (int t = 0; t < 2; ++t)
#pragma unroll
            for (int nt = 0; nt < 4; ++nt)
#pragma unroll
                for (int j = 0; j < 4; ++j) part[F.wave * 2048 + (16 * t + 4 * fq + j) * 64 + 16 * nt + fr] = acc[t][nt][j];
        RT_BAR();
#pragma unroll
        for (int q = 0; q < 4; ++q) { const int o = F.tid + 512 * q; float s = 0.f;
#pragma unroll
            for (int w = 0; w < 8; ++w) s += part[w * 2048 + o];
            const float sc = sigmoidf_(s); logit[o] = sc; vsel[o] = sc + bias; }
        RT_BAR();
#pragma unroll 1
        for (int q = 0; q < 4; ++q) { const int lr = 4 * F.wave + q, br = 32 * g + lr;
            if (br < rpb) { const int r = r0 + br;
                const float myv = vsel[lr * 64 + F.lane], mysc = logit[lr * 64 + F.lane]; int rank = 0;
#pragma unroll 4
                for (int j4 = 0; j4 < 16; ++j4) { const f32x4 o = *(const LAS f32x4*)(vsel + lr * 64 + 4 * j4);
#pragma unroll
                    for (int t = 0; t < 4; ++t) rank += (o[t] > myv || (o[t] == myv && (4 * j4 + t) < F.lane)) ? 1 : 0; }
                const bool sel = rank < TOPK;
                if (sel) tsc[lr * 8 + rank] = mysc;
                asm volatile("s_waitcnt lgkmcnt(0)" ::: "memory");
                float ssum = 0.f;
#pragma unroll
                for (int k = 0; k < TOPK; ++k) ssum += tsc[lr * 8 + k];
                if (sel) { sel_idx[(size_t)r * TOPK + rank] = F.lane; sel_gate[(size_t)r * TOPK + rank] = mysc / ssum * 2.5f; bidx[br * TOPK + rank] = F.lane; } } }
    }
    __syncthreads();
    { const int rw = rpb >> 3, rb = F.wave * rw; int cnt = 0;
      for (int rr = rb; rr < rb + rw; ++rr) {
#pragma unroll
          for (int k = 0; k < TOPK; ++k) cnt += (bidx[rr * TOPK + k] == F.lane) ? 1 : 0; }
      wcnt[F.wave * 64 + F.lane] = cnt;
      __syncthreads();
      int base = 0, tot = 0;
#pragma unroll
      for (int w = 0; w < 8; ++w) { const int c = wcnt[w * 64 + F.lane]; base += (w < F.wave) ? c : 0; tot += c; }
      for (int rr = rb; rr < rb + rw; ++rr) {
#pragma unroll
          for (int k = 0; k < TOPK; ++k) { if (bidx[rr * TOPK + k] == F.lane) { sel_rank[(size_t)(r0 + rr) * TOPK + k] = base; ++base; } } }
      if (F.wave == 0) hist[F.bid * NE + F.lane] = tot; }
    __syncthreads();
#undef RT_BAR
}

__device__ __forceinline__ void phase_scatter(Frame& F, int rowbase, int rpb, int ntok) {
    const gi32* hist = (const gi32*)(F.ws + RT_HIST); gi32* einfo = (gi32*)(F.ws + RT_EINFO);
    const gi32* sel_idx = (const gi32*)(F.ws + RT_SELIDX); const gf32* sel_gate = (const gf32*)(F.ws + RT_SELGATE); const gi32* sel_rank = (const gi32*)(F.ws + RT_SELRANK);
    gi32* slot_of = (gi32*)(F.ws + RT_SLOTOF); gi32* tok_of = (gi32*)(F.ws + RT_TOKOF); gf32* gate_of = (gf32*)(F.ws + RT_GATEOF);
    LAS int* tot8 = (LAS int*)F.lds; LAS int* pre8 = tot8 + 512; LAS int* tot = pre8 + 512; LAS int* boff = tot + 64; LAS int* pst = boff + 64;
    { const int e = F.tid & 63, p = F.tid >> 6; int s = 0, pre = 0;
      for (int b = 32 * p; b < 32 * p + 32; ++b) { const int h = hist[b * NE + e]; s += h; pre += (b < F.bid) ? h : 0; }
      tot8[p * 64 + e] = s; pre8[p * 64 + e] = pre; }
    __syncthreads();
    if (F.tid < 64) { int s = 0, pre = 0;
#pragma unroll
        for (int p = 0; p < 8; ++p) { s += tot8[p * 64 + F.tid]; pre += pre8[p * 64 + F.tid]; }
        tot[F.tid] = s; boff[F.tid] = pre; }
    __syncthreads();
    LAS int* rtl = pst + 64;
    if (F.tid == 0) { int a = 0; for (int e = 0; e < NE; ++e) { pst[e] = a; a += (tot[e] + 255) & ~255; } }
    if (F.tid >= 64 && F.tid < 72) { const int x = F.tid - 64; int t = 0;
#pragma unroll
        for (int kk = 0; kk < 8; ++kk) t += (tot[x + 8 * kk] + 255) >> 8;
        rtl[x] = t; }
    __syncthreads();
    const int r0 = rowbase + F.bid * rpb;
    for (int a = F.tid; a < rpb * TOPK; a += NTHR) { const size_t ga = (size_t)r0 * TOPK + a; const int e = sel_idx[ga];
        const int slot = pst[e] + boff[e] + sel_rank[ga];
        tok_of[slot] = r0 + a / TOPK; gate_of[slot] = sel_gate[ga]; slot_of[ga] = slot; }
    for (int rr = F.tid; rr < rpb; rr += NTHR) { const int s = SH_BASE + (r0 - rowbase) + rr; tok_of[s] = r0 + rr; gate_of[s] = 1.0f; }
    if (F.bid < NE) { const int e = F.bid, lo = pst[e] + tot[e], hi = pst[e] + ((tot[e] + 255) & ~255);
        for (int s = lo + F.tid; s < hi; s += NTHR) { tok_of[s] = rowbase; gate_of[s] = 0.0f; } }
    if (F.bid == 0) {
        if (F.tid < NE) { einfo[F.tid] = tot[F.tid]; einfo[128 + F.tid] = pst[F.tid]; einfo[256 + F.tid] = (tot[F.tid] + 255) >> 8; }
        if (F.tid == NE) { einfo[NE] = ntok; einfo[128 + NE] = SH_BASE; einfo[256 + NE] = ntok >> 8; } }
    { const int x = F.bid & 7, j = F.bid >> 3;
      gi32x4* u1 = (gi32x4*)(F.ws + RT_UNITS1) + F.bid * MAXU1; gi32x4* u2 = (gi32x4*)(F.ws + RT_UNITS2) + F.bid * MAXU2;
      if (F.tid < 128 + MAXU2) { int shs, shn; shared_share(rtl, ntok >> 8, x, shs, shn);
        if (F.tid < MAXU1) { i32x4 d; class_unit(tot, pst, x, F.tid * 32 + j, 4, shs, shn, d); u1[F.tid] = d; }
        else if (F.tid >= 128) { const int i = F.tid - 128; i32x4 d; class_unit(tot, pst, x, i * 32 + j, 8, shs, shn, d); u2[i] = d; } } }
    __syncthreads();
}

template <int MODE>
__device__ __forceinline__ void phase_combine(Frame& F) {
    gf32* X = (gf32*)(F.ws + WS_X); gbf16* H = (gbf16*)(F.ws + WS_H); const gu8* Y = (const gu8*)(F.ws + WS_Y);
    const gi32* slot_of = (const gi32*)(F.ws + RT_SLOTOF);
    const int layer = MODE, rowbase = MODE ? NCTX : 0, nrows = MODE ? NLAT : NTOK;
    const int gw = F.bid * NWAVES + F.wave, NGW = GRID * NWAVES;
    const gf32* sel_gate = (const gf32*)(F.ws + RT_SELGATE);
    int sln[TOPK]; float gln[TOPK];
    if (gw < nrows) {
#pragma unroll
        for (int k = 0; k < TOPK; ++k) { sln[k] = slot_of[(size_t)(rowbase + gw) * TOPK + k]; gln[k] = sel_gate[(size_t)(rowbase + gw) * TOPK + k]; } }
    for (int rr = gw; rr < nrows; rr += NGW) { const int r = rowbase + rr;
        int sl[7]; float gk[7];
#pragma unroll
        for (int k = 0; k < TOPK; ++k) { sl[k] = __builtin_amdgcn_readfirstlane(sln[k]); gk[k] = __int_as_float(__builtin_amdgcn_readfirstlane(__float_as_int(gln[k]))); }
        if (rr + NGW < nrows) {
#pragma unroll
            for (int k = 0; k < TOPK; ++k) { sln[k] = slot_of[(size_t)(r + NGW) * TOPK + k]; gln[k] = sel_gate[(size_t)(r + NGW) * TOPK + k]; } }
        sl[6] = SH_BASE + rr; gk[6] = 1.0f;
        const int mr = mod_row(r); const gf32* g2 = mod_ptr(F, layer, mr, 5);
        f32x4 v[8];
#pragma unroll
        for (int hh = 0; hh < 2; ++hh) {
            f32x4 m[4];
#pragma unroll
            for (int q = 0; q < 4; ++q) m[q] = (f32x4){0.f, 0.f, 0.f, 0.f};
#pragma unroll
            for (int k = 0; k < 7; ++k) { const u32x4 y = *(const gu32x4*)(Y + (size_t)sl[k] * D + 16 * F.lane + 1024 * hh);
                acc4_fp8s(m[0], y.x, gk[k]); acc4_fp8s(m[1], y.y, gk[k]); acc4_fp8s(m[2], y.z, gk[k]); acc4_fp8s(m[3], y.w, gk[k]); }
#pragma unroll
            for (int q = 0; q < 4; ++q) { const int c = 16 * F.lane + 1024 * hh + 4 * q; v[4 * hh + q] = *(const gf32x4*)(X + (size_t)r * D + c) + *(const gf32x4*)(g2 + c) * m[q]; } }
        const float rstd = rsqrtf(row_ssq(v) * (1.0f / D) + EPS);
        if (MODE == 0) {
#pragma unroll
            for (int j = 0; j < 8; ++j) *(gf32x4*)(X + (size_t)r * D + col_of<true>(F.lane, j)) = v[j];
            norm_mod_store<false, true>(v, rstd, INP(IN_NMIXW) + D, mod_ptr(F, 1, mr, 0), mod_ptr(F, 1, mr, 1), H + (size_t)r * D, (LAS bf16_t*)F.lds, F.lane);
        } else {
#pragma unroll
            for (int j = 0; j < 8; ++j) { const int c = col_of<true>(F.lane, j); *(gf32x4*)(F.out + (size_t)rr * D + c) = (v[j] * rstd) * *(const gf32x4*)(INP(IN_FNW) + c); }
        }
    }
}

__device__ __forceinline__ void phase_combine0_gates(Frame& F) {
    gf32* X = (gf32*)(F.ws + WS_X); gbf16* H = (gbf16*)(F.ws + WS_H); const gu8* Y = (const gu8*)(F.ws + WS_Y);
    const gi32* slot_of = (const gi32*)(F.ws + RT_SLOTOF); gf32* G = (gf32*)(F.ws + WS_GATES);
    const gbf16* Wg = (const gbf16*)(F.ws + WS_MLIN_T) + (size_t)6144 * D;
    LAS bf16_t* hs = (LAS bf16_t*)(F.lds + R_HS); LAS float* part = (LAS float*)(F.lds + R_PART);
    constexpr int rpb = NTOK / GRID;
    const int r0 = F.bid * rpb, ngroups = (rpb + 31) >> 5;
    const int fr = F.lane & 15, fq = F.lane >> 4;
#define CG_BAR() do { asm volatile("s_waitcnt lgkmcnt(0)" ::: "memory"); __builtin_amdgcn_s_barrier(); asm volatile("" ::: "memory"); } while (0)
    f32x4 cw[8]; int cur_mr = -1;
    for (int g = 0; g < ngroups; ++g) {
        const int lr0 = 4 * F.wave, br0 = 32 * g + lr0;
        if (br0 < rpb) {
            const int slv = slot_of[(size_t)(r0 + br0) * TOPK + (F.lane < 24 ? F.lane : 0)];
            const int glv = __float_as_int(((const gf32*)(F.ws + RT_SELGATE))[(size_t)(r0 + br0) * TOPK + (F.lane < 24 ? F.lane : 0)]);
#pragma unroll 1
            for (int q = 0; q < 4; ++q) { const int r = r0 + br0 + q, mr = mod_row(r); LAS bf16_t* lrow = hs + (lr0 + q) * HS_PITCH;
                int sl[7]; float gk[7];
#pragma unroll
                for (int k = 0; k < TOPK; ++k) { sl[k] = __builtin_amdgcn_readlane(slv, 6 * q + k); gk[k] = __int_as_float(__builtin_amdgcn_readlane(glv, 6 * q + k)); }
                sl[6] = SH_BASE + r; gk[6] = 1.0f;
                const gf32* g2 = mod_ptr(F, 0, mr, 5); const gf32* sh = mod_ptr(F, 1, mr, 0);
                if (mr != cur_mr) { cur_mr = mr; const gf32* sc = mod_ptr(F, 1, mr, 1); const gf32* nw = INP(IN_NMIXW) + D;
#pragma unroll
                    for (int j = 0; j < 8; ++j) { const int c = col_of<true>(F.lane, j); cw[j] = *(const gf32x4*)(nw + c) * (*(const gf32x4*)(sc + c) + 1.0f); } }
                f32x4 v[8];
#pragma unroll
                for (int hh = 0; hh < 2; ++hh) {
                    f32x4 m[4];
#pragma unroll
                    for (int qq = 0; qq < 4; ++qq) m[qq] = (f32x4){0.f, 0.f, 0.f, 0.f};
#pragma unroll
                    for (int k = 0; k < 7; ++k) { const u32x4 y = *(const gu32x4*)(Y + (size_t)sl[k] * D + 16 * F.lane + 1024 * hh);
                        acc4_fp8s(m[0], y.x, gk[k]); acc4_fp8s(m[1], y.y, gk[k]); acc4_fp8s(m[2], y.z, gk[k]); acc4_fp8s(m[3], y.w, gk[k]); }
#pragma unroll
                    for (int qq = 0; qq < 4; ++qq) { const int c = 16 * F.lane + 1024 * hh + 4 * qq; v[4 * hh + qq] = *(const gf32x4*)(X + (size_t)r * D + c) + *(const gf32x4*)(g2 + c) * m[qq]; } }
                const float rstd = rsqrtf(row_ssq(v) * (1.0f / D) + EPS);
                if (r >= NCTX) {
                    gbf16* xb = (gbf16*)(F.ws + WS_XB) + (size_t)(r - NCTX) * D;
#pragma unroll
                    for (int hh = 0; hh < 2; ++hh) {
                        u32x4 w0, w1;
                        w0.x = cvt_pk_bf16(v[4 * hh][0], v[4 * hh][1]); w0.y = cvt_pk_bf16(v[4 * hh][2], v[4 * hh][3]); w0.z = cvt_pk_bf16(v[4 * hh + 1][0], v[4 * hh + 1][1]); w0.w = cvt_pk_bf16(v[4 * hh + 1][2], v[4 * hh + 1][3]);
                        w1.x = cvt_pk_bf16(v[4 * hh + 2][0], v[4 * hh + 2][1]); w1.y = cvt_pk_bf16(v[4 * hh + 2][2], v[4 * hh + 2][3]); w1.z = cvt_pk_bf16(v[4 * hh + 3][0], v[4 * hh + 3][1]); w1.w = cvt_pk_bf16(v[4 * hh + 3][2], v[4 * hh + 3][3]);
                        *(gu32x4*)(xb + 16 * F.lane + 1024 * hh) = w0; *(gu32x4*)(xb + 16 * F.lane + 1024 * hh + 8) = w1; } }
#pragma unroll
                for (int j = 0; j < 8; ++j) { const int c = col_of<true>(F.lane, j);
                    const f32x4 y = (v[j] * rstd) * cw[j] + *(const gf32x4*)(sh + c);
                    u32x2 o; o.x = cvt_pk_bf16(y[0], y[1]); o.y = cvt_pk_bf16(y[2], y[3]);
                    *(gu32x2*)(H + (size_t)r * D + c) = o; *(LAS u32x2*)(lrow + c) = o; } }
        } else {
#pragma unroll
            for (int q = 0; q < 4; ++q)
#pragma unroll
                for (int j = 0; j < 8; ++j) *(LAS u32x2*)(hs + (lr0 + q) * HS_PITCH + 4 * F.lane + 256 * j) = (u32x2){0u, 0u}; }
        CG_BAR();
        f32x4 acc[2][2];
#pragma unroll
        for (int t = 0; t < 2; ++t)
#pragma unroll
            for (int nt = 0; nt < 2; ++nt) acc[t][nt] = (f32x4){0.f, 0.f, 0.f, 0.f};
#pragma unroll 4
        for (int ks = 0; ks < 8; ++ks) { const int k0 = 256 * F.wave + 32 * ks + 8 * fq;
            const bf16x8 a0 = *(const LAS bf16x8*)(hs + fr * HS_PITCH + k0), a1 = *(const LAS bf16x8*)(hs + (16 + fr) * HS_PITCH + k0);
#pragma unroll
            for (int nt = 0; nt < 2; ++nt) { const bf16x8 bfr = *(const gbf16x8*)(Wg + (size_t)(16 * nt + fr) * D + k0);
                acc[0][nt] = __builtin_amdgcn_mfma_f32_16x16x32_bf16(a0, bfr, acc[0][nt], 0, 0, 0); acc[1][nt] = __builtin_amdgcn_mfma_f32_16x16x32_bf16(a1, bfr, acc[1][nt], 0, 0, 0); } }
        CG_BAR();
#pragma unroll
        for (int t = 0; t < 2; ++t)
#pragma unroll
            for (int nt = 0; nt < 2; ++nt)
#pragma unroll
                for (int j = 0; j < 4; ++j) part[F.wave * 1024 + (16 * t + 4 * fq + j) * 32 + 16 * nt + fr] = acc[t][nt][j];
        CG_BAR();
#pragma unroll
        for (int q = 0; q < 2; ++q) { const int o = F.tid + 512 * q, row = o >> 5, cidx = o & 31, br = 32 * g + row; float sacc = 0.f;
#pragma unroll
            for (int w = 0; w < 8; ++w) sacc += part[w * 1024 + o];
            if (br < rpb) { float gt = softcap_gate(sacc + INP(IN_MLGB)[cidx]); if ((cidx >> 3) & 1) gt = log_sigmoid_(gt); G[(size_t)(r0 + br) * 32 + cidx] = gt; } }
        CG_BAR();
    }
#undef CG_BAR
}

__device__ __forceinline__ void phase_headnorm(Frame& F) {
    const gbf16* HF = (const gbf16*)(F.ws + WS_HF); const gbf16* HB = (const gbf16*)(F.ws + WS_HB); const gbf16* O = (const gbf16*)(F.ws + WS_O); gbf16* YIN = (gbf16*)(F.ws + WS_YIN);
    const gf32* nw = INP(IN_MLNW);
    const int gw = F.bid * NWAVES + F.wave, NGW = GRID * NWAVES;
    const int c0 = 32 * F.lane;
    f32x4 w4[8];
#pragma unroll
    for (int q = 0; q < 8; ++q) w4[q] = *(const gf32x4*)(nw + c0 + 4 * q);
    for (int rr = gw; rr < NLAT; rr += NGW) {
        u32x4 a[4], b[4], o[4];
#pragma unroll
        for (int q = 0; q < 4; ++q) { a[q] = *(const gu32x4*)(HF + (size_t)rr * D + c0 + 8 * q); b[q] = *(const gu32x4*)(HB + (size_t)rr * D + c0 + 8 * q); o[q] = *(const gu32x4*)(O + (size_t)(NCTX + rr) * D + c0 + 8 * q); }
        float h[32]; float ss = 0.f;
#pragma unroll
        for (int q = 0; q < 4; ++q)
#pragma unroll
            for (int e = 0; e < 4; ++e) { const float h0 = bf_lo(a[q][e]) + bf_lo(b[q][e]), h1 = bf_hi(a[q][e]) + bf_hi(b[q][e]); h[8 * q + 2 * e] = h0; h[8 * q + 2 * e + 1] = h1; ss += h0 * h0 + h1 * h1; }
        ss += dpp_mov<0xB1>(ss); ss += dpp_mov<0x4E>(ss); ss += dpp_mov<0x141>(ss);
        const float rstd = rsqrtf(ss * (1.0f / 256.0f) + EPS);
#pragma unroll
        for (int q = 0; q < 4; ++q) { u32x4 w;
#pragma unroll
            for (int e = 0; e < 4; ++e) { const int i0 = 8 * q + 2 * e;
                const float y0 = h[i0] * rstd * w4[i0 >> 2][i0 & 3] * sigmoidf_(bf_lo(o[q][e])), y1 = h[i0 + 1] * rstd * w4[(i0 + 1) >> 2][(i0 + 1) & 3] * sigmoidf_(bf_hi(o[q][e]));
                w[e] = cvt_pk_bf16(y0, y1); }
            *(gu32x4*)(YIN + (size_t)rr * D + c0 + 8 * q) = w; }
    }
}

constexpr int ML_Q = 0, ML_K = 16384, ML_V = 32768, ML_VW = 49152, ML_S = 65536, ML_CT = 74752, ML_F = 113920, ML_G = 118784;
constexpr int ML_SP = 144, ML_CTP = 272;
__device__ __forceinline__ unsigned off_b(unsigned row, unsigned ch) { return 256u * row + 16u * (ch ^ (((row & 3u) << 2) | ((row >> 2) & 3u))); }
__device__ __forceinline__ unsigned rowrd16(unsigned lane, unsigned rb, unsigned s) { return off_b((lane & 15u) + 16u * rb, 4u * s + (lane >> 4)); }
__device__ __forceinline__ unsigned trrd16(unsigned lane, unsigned c, unsigned ks, unsigned t) {
    const unsigned g = lane >> 4, q = (lane & 15u) >> 2, p = lane & 3u;
    return off_b(32u * ks + 8u * g + 4u * t + q, 2u * c + (p >> 1)) + 8u * (p & 1u);
}
__device__ __forceinline__ bf16x8 tr_frag(LAS unsigned char* img, unsigned lane, unsigned c, unsigned ks) {
    const s16x4 lo = __builtin_amdgcn_ds_read_tr16_b64_v4i16((LAS s16x4*)(img + trrd16(lane, c, ks, 0)));
    const s16x4 hi = __builtin_amdgcn_ds_read_tr16_b64_v4i16((LAS s16x4*)(img + trrd16(lane, c, ks, 1)));
    return (bf16x8){lo[0], lo[1], lo[2], lo[3], hi[0], hi[1], hi[2], hi[3]};
}
__device__ __forceinline__ int ml_row(int b, int dir, int p) {
    return (p < CTXL) ? b * CTXL + (dir ? (CTXL - 1 - p) : p) : NCTX + b * SEQ + (dir ? (SEQ - 1 - (p - CTXL)) : (p - CTXL));
}
__device__ __forceinline__ void phase_mlstm(Frame& F) {
    const gbf16* Qb = (const gbf16*)(F.ws + WS_Q); const gbf16* Kb = (const gbf16*)(F.ws + WS_K); const gbf16* Vb = (const gbf16*)(F.ws + WS_V);
    const gf32* G = (const gf32*)(F.ws + WS_GATES);
    const int wi = F.bid, b = wi >> 5, hd = (wi >> 2) & 7, dir = (wi >> 1) & 1, half = wi & 1;
    gbf16* HD = (gbf16*)(F.ws + (dir ? WS_HB : WS_HF));
    LAS unsigned char* L = F.lds;
    LAS float* fct = (LAS float*)(L + ML_F); LAS float* frs = fct + 64; LAS float* fwi = frs + 64; LAS float* fem = fwi + 64; LAS float* fsc = fem + 64;
    LAS bf16_t* wkb = (LAS bf16_t*)(fsc + 16); LAS float* fwk = (LAS float*)(wkb + 64);
    const unsigned lane = (unsigned)F.lane; const int w = F.wave, fr = F.lane & 15, fq = F.lane >> 4;
    for (int i = F.tid; i < 144 * ML_CTP / 16; i += NTHR) *(LAS u32x4*)(L + ML_CT + 16 * i) = (u32x4){0u, 0u, 0u, 0u};
    f32x4 cst[9];
#pragma unroll
    for (int v = 0; v < 9; ++v) cst[v] = (f32x4){0.f, 0.f, 0.f, 0.f};
    LAS float* BC = (LAS float*)(L + ML_G); LAS float* RS = BC + 2304; LAS float* CM = RS + 2304; LAS float* BL = CM + 2304; LAS float* CML = BL + 40; LAS float* MST = CML + 40; LAS float* MNW = MST + 40; LAS float* DEC = MNW + 40;
    for (int c = w; c < 36; c += 8) { const int p = 64 * c + F.lane; const size_t gr = (size_t)ml_row(b, dir, p);
        const float li = G[gr * 32 + (2 * dir) * 8 + hd], lf = G[gr * 32 + (2 * dir + 1) * 8 + hd];
        float bc = lf;
#pragma unroll
        for (int o = 1; o < 64; o <<= 1) { const float t = __shfl_up(bc, o); if (F.lane >= o) bc += t; }
        const float rsv = li - bc; float cm = rsv;
#pragma unroll
        for (int o = 1; o < 64; o <<= 1) { const float t = __shfl_up(cm, o); if (F.lane >= o) cm = fmaxf(cm, t); }
        BC[p] = bc; RS[p] = rsv; CM[p] = cm;
        if (F.lane == 63) { BL[c] = bc; CML[c] = cm; } }
    __syncthreads();
    if (F.tid == 0) { float m = -1.0e30f;
        for (int c = 0; c < 36; ++c) { const float bl = BL[c], mn = fmaxf(bl + m, bl + CML[c]); MST[c] = m; MNW[c] = mn; DEC[c] = fast_exp(bl + m - mn); m = mn; } }
    __syncthreads();
    u32x4 gq[2], gk[2], gv[2];
#define ML_LOAD_CHUNK(P0) do { _Pragma("unroll") for (int i = 0; i < 2; ++i) { const int cid = F.tid + 512 * i, row = cid >> 4, ch = cid & 15; const size_t gr = (size_t)ml_row(b, dir, (P0) + row); \
            gq[i] = *(const gu32x4*)(Qb + gr * 1024 + hd * 128 + 8 * ch); gk[i] = *(const gu32x4*)(Kb + gr * 1024 + hd * 128 + 8 * ch); \
            gv[i] = *(const gu32x4*)(Vb + gr * 2048 + hd * 256 + half * 128 + 8 * ch); } } while (0)
    ML_LOAD_CHUNK(0);
#define ML_BAR() do { asm volatile("s_waitcnt lgkmcnt(0)" ::: "memory"); __builtin_amdgcn_s_barrier(); asm volatile("" ::: "memory"); } while (0)
#pragma unroll 1
    for (int c = 0; c < 36; ++c) {
        const int p0 = 64 * c;
        if (F.tid < 64) { const float m_st = MST[c], mnew = MNW[c], bc = BC[p0 + F.tid], rsv = RS[p0 + F.tid], cm = CM[p0 + F.tid];
            const float mrow = bc + fmaxf(m_st, cm), wk = fast_exp(BL[c] + rsv - mnew);
            fct[F.tid] = bc - mrow; frs[F.tid] = rsv; fwi[F.tid] = fast_exp(bc + m_st - mrow); fem[F.tid] = fast_exp(-mrow); fwk[F.tid] = wk;
            if (F.tid == 0) { fsc[0] = DEC[c]; fsc[1] = mnew; } }
#pragma unroll
        for (int i = 0; i < 2; ++i) { const int cid = F.tid + 512 * i, row = cid >> 4, ch = cid & 15; const unsigned o = off_b(row, ch);
            *(LAS u32x4*)(L + ML_Q + o) = gq[i]; *(LAS u32x4*)(L + ML_K + o) = gk[i]; *(LAS u32x4*)(L + ML_V + o) = gv[i]; }
        if (c + 1 < 36) ML_LOAD_CHUNK(p0 + 64);
        ML_BAR();
        const float decay = fsc[0];
#pragma unroll
        for (int v = 0; v < 9; ++v) cst[v] *= decay;
#pragma unroll
        for (int ks = 0; ks < 2; ++ks) {
            const bf16x8 a0 = tr_frag(L + ML_K, lane, (unsigned)w, ks);
            const f32x4 wk0 = *(const LAS f32x4*)(fwk + 32 * ks + 8 * fq), wk1 = *(const LAS f32x4*)(fwk + 32 * ks + 8 * fq + 4);
            bf16x8 a;
            { const unsigned p0 = cvt_pk_bf16(__uint_as_float((unsigned)(unsigned short)a0[0] << 16) * wk0[0], __uint_as_float((unsigned)(unsigned short)a0[1] << 16) * wk0[1]);
              const unsigned p1 = cvt_pk_bf16(__uint_as_float((unsigned)(unsigned short)a0[2] << 16) * wk0[2], __uint_as_float((unsigned)(unsigned short)a0[3] << 16) * wk0[3]);
              const unsigned p2 = cvt_pk_bf16(__uint_as_float((unsigned)(unsigned short)a0[4] << 16) * wk1[0], __uint_as_float((unsigned)(unsigned short)a0[5] << 16) * wk1[1]);
              const unsigned p3 = cvt_pk_bf16(__uint_as_float((unsigned)(unsigned short)a0[6] << 16) * wk1[2], __uint_as_float((unsigned)(unsigned short)a0[7] << 16) * wk1[3]);
              a = __builtin_bit_cast(bf16x8, (u32x4){p0, p1, p2, p3}); }
#pragma unroll
            for (int v = 0; v < 8; ++v) { const bf16x8 bb = tr_frag(L + ML_V, lane, v, ks); cst[v] = __builtin_amdgcn_mfma_f32_16x16x32_bf16(a, bb, cst[v], 0, 0, 0); }
            const bf16x8 ba = (bf16x8){(short)0x3F80, (short)0x3F80, (short)0x3F80, (short)0x3F80, (short)0x3F80, (short)0x3F80, (short)0x3F80, (short)0x3F80};
            cst[8] = __builtin_amdgcn_mfma_f32_16x16x32_bf16(a, ba, cst[8], 0, 0, 0);
        }
        if (c >= 4) {
            const int tt = w >> 1;
            bf16x8 qf[4];
#pragma unroll
            for (int ks = 0; ks < 4; ++ks) qf[ks] = *(const LAS bf16x8*)(L + ML_Q + rowrd16(lane, tt, ks));
            const int t = 16 * tt + fr; const float ctt = fct[t];
#pragma unroll
            for (int si = 0; si < 2; ++si) { const int st = 2 * (w & 1) + si; f32x4 acc = (f32x4){0.f, 0.f, 0.f, 0.f};
                if (st <= tt)
#pragma unroll
                for (int ks = 0; ks < 4; ++ks) { const bf16x8 kf = *(const LAS bf16x8*)(L + ML_K + rowrd16(lane, st, ks)); acc = __builtin_amdgcn_mfma_f32_16x16x32_bf16(kf, qf[ks], acc, 0, 0, 0); }
                const int s0 = 16 * st + 4 * fq; float sv[4];
#pragma unroll
                for (int j = 0; j < 4; ++j) sv[j] = (s0 + j <= t) ? acc[j] * fast_exp(ctt + frs[s0 + j]) : 0.f;
                u32x2 o; o.x = cvt_pk_bf16(sv[0], sv[1]); o.y = cvt_pk_bf16(sv[2], sv[3]);
                *(LAS u32x2*)(L + ML_S + t * ML_SP + s0 * 2) = o; }
        }
        ML_BAR();
        if (c >= 4) {
            const int tt = w >> 1;
            f32x4 sv[5], qc[5];
#pragma unroll
            for (int i = 0; i < 5; ++i) { sv[i] = (f32x4){0.f, 0.f, 0.f, 0.f}; qc[i] = (f32x4){0.f, 0.f, 0.f, 0.f}; }
#pragma unroll
            for (int ks = 0; ks < 2; ++ks) { const bf16x8 a = *(const LAS bf16x8*)(L + ML_S + (fr + 16 * tt) * ML_SP + (32 * ks + 8 * fq) * 2);
#pragma unroll
                for (int i = 0; i < 4; ++i) { const bf16x8 bb = tr_frag(L + ML_V, lane, 4 * (w & 1) + i, ks); sv[i] = __builtin_amdgcn_mfma_f32_16x16x32_bf16(a, bb, sv[i], 0, 0, 0); }
                const bf16x8 bo = (bf16x8){(short)0x3F80, (short)0x3F80, (short)0x3F80, (short)0x3F80, (short)0x3F80, (short)0x3F80, (short)0x3F80, (short)0x3F80};
                sv[4] = __builtin_amdgcn_mfma_f32_16x16x32_bf16(a, bo, sv[4], 0, 0, 0); }
#pragma unroll
            for (int ks = 0; ks < 4; ++ks) { const bf16x8 a = *(const LAS bf16x8*)(L + ML_Q + rowrd16(lane, tt, ks));
#pragma unroll
                for (int i = 0; i < 5; ++i) { const int vt = (i < 4) ? 4 * (w & 1) + i : 8;
                    const bf16x8 bb = *(const LAS bf16x8*)(L + ML_CT + (fr + 16 * vt) * ML_CTP + (32 * ks + 8 * fq) * 2); qc[i] = __builtin_amdgcn_mfma_f32_16x16x32_bf16(a, bb, qc[i], 0, 0, 0); } }
#pragma unroll
            for (int j = 0; j < 4; ++j) { const int tl = 16 * tt + 4 * fq + j; const float wi_ = fwi[tl], em = fem[tl];
                const float den = sv[4][j] + wi_ * qc[4][j];
                const float inv = 1.0f / fmaxf(fabsf(den), em);
                LAS bf16_t* op = (LAS bf16_t*)(L + ML_VW) + tl * 128 + fr;
#pragma unroll
                for (int i = 0; i < 4; ++i) { const float h = (sv[i][j] + wi_ * qc[i][j]) * inv; op[16 * (4 * (w & 1) + i)] = (bf16_t)(cvt_pk_bf16(h, 0.f) & 0xffffu); } }
        }
        ML_BAR();
        if (c >= 4) {
#pragma unroll
            for (int i = 0; i < 2; ++i) { const int cid = F.tid + 512 * i, row = cid >> 4, ch = cid & 15; const size_t rr = (size_t)(ml_row(b, dir, p0 + row) - NCTX);
                *(gu32x4*)(HD + rr * D + hd * 256 + half * 128 + 8 * ch) = *(const LAS u32x4*)(L + ML_VW + row * 256 + 16 * ch); } }
#pragma unroll
        for (int v = 0; v < 9; ++v) { u32x2 o; o.x = cvt_pk_bf16(cst[v][0], cst[v][1]); o.y = cvt_pk_bf16(cst[v][2], cst[v][3]);
            *(LAS u32x2*)(L + ML_CT + (16 * v + fr) * ML_CTP + (16 * w + 4 * fq) * 2) = o; }
    }
    __syncthreads();
}

constexpr int N_PHASES = 19;
#ifndef PHASE_MASK
#define PHASE_MASK 0x7ffff
#endif
__global__ void __launch_bounds__(NTHR, 2) fwd(Args args) {
    extern __shared__ __attribute__((aligned(16))) unsigned char lds_raw[];
    if (threadIdx.x < 4) ((LAS unsigned*)((LAS unsigned char*)lds_raw + LDSCTL_OFF))[threadIdx.x] = 0u;
    __syncthreads();
#if !MK_PER_PHASE
    XcdBarrier bar = xcd_barrier_post((unsigned*)(args.ws + WS_CTL) + CW_BAR + args.li * 4096, (volatile LAS unsigned*)((LAS unsigned char*)lds_raw + LDSCTL_OFF));
#define SEAM(k) do { if (IN(k) && IN((k) + 1)) xcd_barrier(bar); } while (0)
#else
#define SEAM(k) do { } while (0)
#endif
    const int lo = args.ph_lo, hi = args.ph_hi;
#define IN(k) (((PHASE_MASK >> (k)) & 1) && lo <= (k) && (k) < hi)
#ifndef REPEAT_MASK
#define REPEAT_MASK 0
#endif
#ifndef REPEAT_N
#define REPEAT_N 1
#endif
#define REP(k) for (int rep_ = 0; rep_ < ((((REPEAT_MASK) >> (k)) & 1) ? (REPEAT_N) : 1); ++rep_, __syncthreads())
#define PHASE_FRAME() Frame F; gu8* ws; { gu8* w_ = (gu8*)args.ws; asm volatile("" : "+s"(w_)); int t_ = threadIdx.x; asm volatile("" : "+v"(t_)); ws = w_; \
        F.lds = (LAS unsigned char*)lds_raw; F.tid = t_; F.lane = t_ & 63; F.wave = __builtin_amdgcn_readfirstlane(t_ >> 6); F.bid = blockIdx.x; F.a = &args; F.out = (gf32*)args.out; F.ws = w_; }

    if (IN(0)) REP(0) { PHASE_FRAME(); (void)ws; phase_prologue(F); } SEAM(0);
    if (IN(1)) REP(1) { PHASE_FRAME(); (void)ws; phase_norm0(F); } SEAM(1);
    if (IN(2)) REP(2) { PHASE_FRAME(); pg8::DenseOrder S; S.init(ws + WS_H, ws + WS_CONVIN_T, NTOK, 3 * D, D, GRID, F.bid);
        EpiConvIn E{(gbf16*)(ws + WS_U), (gbf16*)(ws + WS_BM)};
        pg8::gemm_phase<EpiConvIn, pg8::DenseOrder, false>(F.lds, D, S, E); } SEAM(2);
    if (IN(3)) REP(3) { PHASE_FRAME(); (void)ws; phase_conv(F); } SEAM(3);
    if (IN(4)) REP(4) { PHASE_FRAME(); pg8::DenseOrder S; S.init(ws + WS_Z, ws + WS_CONVOUT_T, NTOK, D, D, GRID, F.bid);
        EpiResid E{INP(IN_CTX), INP(IN_X), (gf32*)(ws + WS_X), mod_ptr(F, 0, 0, 2), 0};
        pg8::gemm_phase<EpiResid, pg8::DenseOrder, false>(F.lds, D, S, E); } SEAM(4);
    if (IN(5)) REP(5) { PHASE_FRAME(); (void)ws; phase_router(F, 0, 0, NTOK / GRID); } SEAM(5);
    if (IN(6)) REP(6) { PHASE_FRAME(); (void)ws; phase_scatter(F, 0, NTOK / GRID, NTOK); } SEAM(6);
    if (IN(7)) REP(7) { PHASE_FRAME(); ExpertOrder S{stage_units(F, (const gi32x4*)(ws + RT_UNITS1) + F.bid * MAXU1, MAXU1), (const gchar*)(ws + WS_H8), (const gchar*)(ws + WS_MOE0 + MOE_GU), (const gi32*)(ws + RT_TOKOF), D / 2, 1024};
        EpiSwiglu E{(gu8*)(ws + WS_ACT)};
        pg8::gemm_phase<EpiSwiglu, ExpertOrder, true, true>(F.lds, D / 2, S, E); } SEAM(7);
    if (IN(8)) REP(8) { PHASE_FRAME(); ExpertOrder S{stage_units(F, (const gi32x4*)(ws + RT_UNITS2) + F.bid * MAXU2, MAXU2), (const gchar*)(ws + WS_ACT), (const gchar*)(ws + WS_MOE0 + MOE_DN), nullptr, ED / 2, 2048};
        EpiDown E{(gu8*)(ws + WS_Y)};
        pg8::gemm_phase<EpiDown, ExpertOrder, false, true>(F.lds, ED / 2, S, E); } SEAM(8);
    if (IN(9)) REP(9) { PHASE_FRAME(); (void)ws; phase_combine0_gates(F); } SEAM(9);
    if (IN(10)) REP(10) { PHASE_FRAME(); pg8::DenseOrder S; S.init(ws + WS_H, ws + WS_MLIN_T, NTOK, 3 * D, D, GRID, F.bid);
        EpiMlstmIn E{(gbf16*)(ws + WS_Q), (gbf16*)(ws + WS_K), (gbf16*)(ws + WS_V), (gbf16*)(ws + WS_O)};
        pg8::gemm_phase<EpiMlstmIn, pg8::DenseOrder, false>(F.lds, D, S, E); } SEAM(10);
    if (IN(11)) REP(11) { PHASE_FRAME(); (void)ws; phase_mlstm(F); } SEAM(11);
    if (IN(12)) REP(12) { PHASE_FRAME(); (void)ws; phase_headnorm(F); } SEAM(12);
    if (IN(13)) REP(13) { PHASE_FRAME(); pg8::DenseOrder S; S.init(ws + WS_YIN, ws + WS_MLOUT_T, NLAT, D, D, GRID, F.bid);
        gf32* X = (gf32*)(ws + WS_X);
        EpiResidT<true> E{X, (const gf32*)(ws + WS_XB), X, mod_ptr(F, 1, 0, 2), NCTX};
        pg8::gemm_phase<EpiResidT<true>, pg8::DenseOrder, false>(F.lds, D, S, E); } SEAM(13);
    if (IN(14)) REP(14) { PHASE_FRAME(); (void)ws; phase_router(F, 1, NCTX, NLAT / GRID); } SEAM(14);
    if (IN(15)) REP(15) { PHASE_FRAME(); (void)ws; phase_scatter(F, NCTX, NLAT / GRID, NLAT); } SEAM(15);
    if (IN(16)) REP(16) { PHASE_FRAME(); ExpertOrder S{stage_units(F, (const gi32x4*)(ws + RT_UNITS1) + F.bid * MAXU1, MAXU1), (const gchar*)(ws + WS_H8), (const gchar*)(ws + WS_MOE0 + MOE_STRIDE + MOE_GU), (const gi32*)(ws + RT_TOKOF), D / 2, 1024};
        EpiSwiglu E{(gu8*)(ws + WS_ACT)};
        pg8::gemm_phase<EpiSwiglu, ExpertOrder, true, true>(F.lds, D / 2, S, E); } SEAM(16);
    if (IN(17)) REP(17) { PHASE_FRAME(); ExpertOrder S{stage_units(F, (const gi32x4*)(ws + RT_UNITS2) + F.bid * MAXU2, MAXU2), (const gchar*)(ws + WS_ACT), (const gchar*)(ws + WS_MOE0 + MOE_STRIDE + MOE_DN), nullptr, ED / 2, 2048};
        EpiDown E{(gu8*)(ws + WS_Y)};
        pg8::gemm_phase<EpiDown, ExpertOrder, false, true>(F.lds, ED / 2, S, E); } SEAM(17);
    if (IN(18)) REP(18) { PHASE_FRAME(); (void)ws; phase_combine<1>(F); }
#undef IN
#undef SEAM
}

extern "C" void kernel_launch(void* const* d_in, const int* in_sizes, int n_in, void* d_out, int out_size, void* d_ws, size_t ws_size, hipStream_t stream) {
    static int ready = 0;
    if (ready == 0) {
        if (n_in != N_IN || out_size != NLAT * D || ws_size < WS_END) { fprintf(stderr, "kernel_launch: unexpected problem shape (n_in %d, out %d, ws %zu)\n", n_in, out_size, ws_size); ready = -1; return; }
        if (hipFuncSetAttribute((const void*)fwd, hipFuncAttributeMaxDynamicSharedMemorySize, LDS_BYTES) != hipSuccess) { fprintf(stderr, "kernel_launch: hipFuncSetAttribute failed\n"); ready = -1; return; }
        int per_cu = 0;
        if (hipOccupancyMaxActiveBlocksPerMultiprocessor(&per_cu, (const void*)fwd, NTHR, LDS_BYTES) != hipSuccess || per_cu < 1) fprintf(stderr, "kernel_launch: note: occupancy query reports %d blocks per CU\n", per_cu);
        (void)hipGetLastError();
        ready = 1;
    }
    if (ready < 0) return;
    (void)hipMemsetAsync((char*)d_ws + WS_CTL, 0, CTL_BYTES, stream);
    Args a{};
    for (int i = 0; i < N_IN; ++i) a.in[i] = (const float*)d_in[i];
    a.out = (float*)d_out; a.ws = (unsigned char*)d_ws; a.pad = 0;
#if MK_PER_PHASE
    for (int p = 0; p < N_PHASES; ++p) { a.ph_lo = p; a.ph_hi = p + 1; a.li = 0; hipLaunchKernelGGL(fwd, dim3(GRID), dim3(NTHR), LDS_BYTES, stream, a); }
#else
    a.ph_lo = 0; a.ph_hi = N_PHASES; a.li = 0;
    hipLaunchKernelGGL(fwd, dim3(GRID), dim3(NTHR), LDS_BYTES, stream, a);
#endif
}
```

```cpp
#include <hip/hip_runtime.h>
#include <stdint.h>
#include <stdio.h>

#ifndef STAGGER_TICKS
#define STAGGER_TICKS 0
#endif
#ifndef MK_PER_PHASE
#define MK_PER_PHASE 0
#endif

#define GAS __attribute__((address_space(1)))
#define LAS __attribute__((address_space(3)))
typedef unsigned short bf16_t;
typedef short bf16x8 __attribute__((ext_vector_type(8)));
typedef short s16x4 __attribute__((ext_vector_type(4)));
typedef float f32x4 __attribute__((ext_vector_type(4)));
typedef float f32x2 __attribute__((ext_vector_type(2)));
typedef unsigned u32x4 __attribute__((ext_vector_type(4)));
typedef unsigned u32x2 __attribute__((ext_vector_type(2)));
typedef int i32x4 __attribute__((ext_vector_type(4)));
typedef long i64x2 __attribute__((ext_vector_type(2)));
typedef int i32x8 __attribute__((ext_vector_type(8)));
typedef GAS float gf32; typedef GAS bf16_t gbf16; typedef GAS int gi32; typedef GAS unsigned char gu8; typedef GAS char gchar;
typedef GAS f32x4 gf32x4; typedef GAS u32x4 gu32x4; typedef GAS u32x2 gu32x2; typedef GAS bf16x8 gbf16x8; typedef GAS i32x4 gi32x4;

constexpr int D = 2048, NBATCH = 8, SEQ = 2048, CTXL = 256;
constexpr int NCTX = NBATCH * CTXL;
constexpr int NLAT = NBATCH * SEQ;
constexpr int NTOK = NCTX + NLAT;
constexpr int NE = 64, TOPK = 6, ED = 512;
constexpr int ADA_N = 6 * D;
constexpr int MLSTM_N = 6176, MLSTM_NP = 6400;
constexpr int NWAVES = 8, NTHR = 512, GRID = 256;
constexpr int SH_BASE = 126976;
constexpr int NSLOT = SH_BASE + NTOK;
constexpr float EPS = 1e-6f;

constexpr size_t MiB = 1u << 20, KiB = 1024;
constexpr size_t WS_CTL = 0, CTL_BYTES = 64 * KiB;
constexpr size_t WS_MOD = 1 * MiB;
constexpr size_t WS_RT = 2 * MiB;
constexpr size_t RT_HIST = WS_RT;
constexpr size_t RT_EINFO = WS_RT + 64 * KiB;
constexpr size_t RT_SELIDX = WS_RT + 128 * KiB;
constexpr size_t RT_SELGATE = WS_RT + 640 * KiB;
constexpr size_t RT_SELRANK = WS_RT + 1152 * KiB;
constexpr size_t RT_SLOTOF = WS_RT + 1664 * KiB;
constexpr size_t RT_TOKOF = WS_RT + 2176 * KiB;
constexpr size_t RT_GATEOF = WS_RT + 2816 * KiB;
constexpr size_t RT_UNITS1 = WS_RT + 3584 * KiB;
constexpr size_t RT_UNITS2 = WS_RT + 3840 * KiB;
constexpr int MAXU1 = 64, MAXU2 = 128;
constexpr size_t WS_GATES = 10 * MiB;
constexpr size_t WS_CONVIN_T = 13 * MiB;
constexpr size_t WS_CONVOUT_T = 37 * MiB;
constexpr size_t WS_MLIN_T = 45 * MiB;
constexpr size_t WS_MLOUT_T = 70 * MiB;
constexpr size_t WS_MOE0 = 78 * MiB, MOE_STRIDE = 392 * MiB;
constexpr size_t MOE_GU = 0, MOE_DN = 260 * MiB, MOE_RT = 390 * MiB;
constexpr size_t WS_H = 862 * MiB;
constexpr size_t WS_X = 934 * MiB;
constexpr size_t WS_ACT = 1078 * MiB;
constexpr size_t WS_Y = 1220 * MiB;
constexpr size_t WS_U = WS_Y, WS_BM = WS_Y + 72 * MiB, WS_Z = WS_Y + 144 * MiB;
constexpr size_t WS_Q = WS_Y, WS_K = WS_Y + 36 * MiB, WS_V = WS_Y + 72 * MiB, WS_O = WS_Y + 144 * MiB;
constexpr size_t WS_HF = WS_Y + 216 * MiB, WS_HB = WS_Y + 280 * MiB, WS_YIN = WS_Y + 344 * MiB;
constexpr size_t WS_H8 = 1788 * MiB;
constexpr size_t WS_XB = 1824 * MiB;
constexpr size_t WS_END = 1888 * MiB;
constexpr float DN_WSCALE = 32.0f, ACT_SCALE = 16.0f;
constexpr float GU_WSCALE = 64.0f;
constexpr int CW_BAR = 4096;
constexpr int CW_P0CTR = 64;

constexpr int RING_BYTES = 131072;
constexpr int LDSCTL_OFF = 150 * 1024;
constexpr int LDS_BYTES = 151 * 1024;

#define LDS_WAIT() asm volatile("s_waitcnt lgkmcnt(0)" ::: "memory")
#define VM_WAIT() asm volatile("s_waitcnt vmcnt(0)" ::: "memory")
__device__ __forceinline__ unsigned cvt_pk_bf16(float lo, float hi) { unsigned r; asm volatile("v_cvt_pk_bf16_f32 %0, %1, %2" : "=v"(r) : "v"(lo), "v"(hi)); return r; }
__device__ __forceinline__ unsigned pk4_fp8(const f32x4 v) { int w = 0;
    w = __builtin_amdgcn_cvt_pk_fp8_f32(__builtin_amdgcn_fmed3f(v[0], -448.0f, 448.0f), __builtin_amdgcn_fmed3f(v[1], -448.0f, 448.0f), w, false);
    w = __builtin_amdgcn_cvt_pk_fp8_f32(__builtin_amdgcn_fmed3f(v[2], -448.0f, 448.0f), __builtin_amdgcn_fmed3f(v[3], -448.0f, 448.0f), w, true); return (unsigned)w; }
__device__ __forceinline__ void acc4_fp8(f32x4& m, unsigned w) { const f32x2 lo = __builtin_amdgcn_cvt_pk_f32_fp8((int)w, false), hi = __builtin_amdgcn_cvt_pk_f32_fp8((int)w, true); m[0] += lo[0]; m[1] += lo[1]; m[2] += hi[0]; m[3] += hi[1]; }
__device__ __forceinline__ void acc4_fp8s(f32x4& m, unsigned w, float g) { const f32x2 lo = __builtin_amdgcn_cvt_pk_f32_fp8((int)w, false), hi = __builtin_amdgcn_cvt_pk_f32_fp8((int)w, true); m[0] += g * lo[0]; m[1] += g * lo[1]; m[2] += g * hi[0]; m[3] += g * hi[1]; }
__device__ __forceinline__ float bf_lo(unsigned u) { return __uint_as_float(u << 16); }
__device__ __forceinline__ float bf_hi(unsigned u) { return __uint_as_float(u & 0xffff0000u); }
template <int CTRL> __device__ __forceinline__ float dpp_mov(float v) { return __int_as_float(__builtin_amdgcn_update_dpp(0, __float_as_int(v), CTRL, 0xf, 0xf, true)); }
__device__ __forceinline__ float wave_sum(float v) {
    v += dpp_mov<0xB1>(v); v += dpp_mov<0x4E>(v); v += dpp_mov<0x141>(v); v += dpp_mov<0x140>(v);
    const int b = __float_as_int(v);
    return (__int_as_float(__builtin_amdgcn_readlane(b, 0)) + __int_as_float(__builtin_amdgcn_readlane(b, 16))) + (__int_as_float(__builtin_amdgcn_readlane(b, 32)) + __int_as_float(__builtin_amdgcn_readlane(b, 48)));
}
__device__ __forceinline__ float fast_exp(float x) { return __builtin_amdgcn_exp2f(x * 1.44269504088896341f); }
__device__ __forceinline__ float sigmoidf_(float x) { return 1.0f / (1.0f + fast_exp(-x)); }
__device__ __forceinline__ float siluf_(float x) { return x / (1.0f + fast_exp(-x)); }

#define XB_TMO      128
#define XB_XCNT(j)  (256  + 64 * (j))
#define XB_XSUB(j)  (1280 + 64 * (j))
#define XB_XGEN(j)  (2304 + 64 * (j))
#define XB_TOP      3328
#define XB_TOPGEN   3392
#define XCD_BAR_WORDS 3456
#define XB_SPIN_CAP (1u << 22)

__device__ __forceinline__ unsigned xb_ld(unsigned* p)              { return __hip_atomic_load(p, __ATOMIC_RELAXED, __HIP_MEMORY_SCOPE_AGENT); }
__device__ __forceinline__ unsigned xb_add(unsigned* p, unsigned v) { return __hip_atomic_fetch_add(p, v, __ATOMIC_RELAXED, __HIP_MEMORY_SCOPE_AGENT); }
__device__ __forceinline__ unsigned xb_xcc_id() { return (unsigned)__builtin_amdgcn_s_getreg((3 << 11) | 20) & 0xFu; }
#define XB_SPIN(cond, bar) do { unsigned _sp = 0; while (cond) { __builtin_amdgcn_s_sleep(1); \
    if ((++_sp & 255u) == 0u) { if (xb_ld(&(bar)[XB_TMO])) break; if (_sp > XB_SPIN_CAP) { atomicAdd(&(bar)[XB_TMO], 1u); break; } } } } while (0)

struct XcdBarrier { unsigned* bar; unsigned x; volatile LAS unsigned* st; };

__device__ __forceinline__ XcdBarrier xcd_barrier_post(unsigned* bar, volatile LAS unsigned* st) {
    XcdBarrier b; b.bar = bar; b.x = xb_xcc_id(); b.st = st;
    if (threadIdx.x == 0) (void)xb_add(&bar[XB_XCNT(b.x)], 1u);
    return b;
}
__device__ __forceinline__ void xcd_barrier_complete(unsigned* bar, unsigned x, unsigned& nloc, unsigned& nx) {
    const unsigned G = gridDim.x * gridDim.y * gridDim.z;
    unsigned sum, cnt, mine, sp = 0u;
    for (;;) {
        sum = 0u; cnt = 0u; mine = 0u;
#pragma unroll
        for (unsigned j = 0; j < 16; ++j) { const unsigned c = xb_ld(&bar[XB_XCNT(j)]); sum += c; cnt += (c > 0u) ? 1u : 0u; mine = (j == x) ? c : mine; }
        if (sum == G) break;
        __builtin_amdgcn_s_sleep(1);
        if ((++sp & 255u) == 0u) { if (xb_ld(&bar[XB_TMO])) break; if (sp > XB_SPIN_CAP) { atomicAdd(&bar[XB_TMO], 1u); break; } }
    }
    nloc = mine > 0u ? mine : 1u; nx = cnt > 0u ? cnt : 1u;
}
__device__ __forceinline__ void xcd_barrier(const XcdBarrier& b) {
    asm volatile("s_waitcnt vmcnt(0)" ::: "memory");
    __syncthreads();
    if (threadIdx.x == 0) {
        unsigned* bar = b.bar;
        __builtin_amdgcn_s_waitcnt(0);
        unsigned nloc = b.st[0], nx = b.st[1];
        if (nloc == 0u) { xcd_barrier_complete(bar, b.x, nloc, nx); b.st[0] = nloc; b.st[1] = nx; }
        const unsigned old = xb_add(&bar[XB_XSUB(b.x)], 1u);
        const unsigned gen = old / nloc;
        if (old + 1u == (gen + 1u) * nloc) {
            __builtin_amdgcn_fence(__ATOMIC_RELEASE, "agent");
            asm volatile("s_waitcnt vmcnt(0)" ::: "memory");
            const unsigned og = xb_add(&bar[XB_TOP], 1u);
            const unsigned tg = og / nx;
            if (og + 1u == (tg + 1u) * nx) xb_add(&bar[XB_TOPGEN], 1u);
            else XB_SPIN(xb_ld(&bar[XB_TOPGEN]) == tg, bar);
            __builtin_amdgcn_fence(__ATOMIC_ACQUIRE, "agent");
            xb_add(&bar[XB_XGEN(b.x)], 1u);
            asm volatile("s_waitcnt vmcnt(0)" ::: "memory");
        } else {
            XB_SPIN(xb_ld(&bar[XB_XGEN(b.x)]) == gen, bar);
            __builtin_amdgcn_fence(__ATOMIC_ACQUIRE, "agent");
            asm volatile("s_waitcnt vmcnt(0)" ::: "memory");
        }
    }
    __syncthreads();
}

namespace pg8 {
constexpr int BM = 256, BK = 64, HALF = 128, HTB = HALF * BK * 2, STAGE_BYTES = 8 * HTB, NXCD = 8, WGM = 8;
__host__ __device__ __forceinline__ int lds_byte(int r, int c) { const int st = (r >> 4) * 2 + (c >> 5), rr = r & 15, cc = c & 31, ob = rr * 64 + cc * 2; return st * 1024 + (ob ^ (((ob >> 9) & 1) << 5)); }
__host__ __device__ __forceinline__ void stage_rc(int b, int& R, int& C) { const int st = b / 1024, sb = b % 1024, swz = sb ^ (((sb >> 9) & 1) << 5); R = (st >> 1) * 16 + swz / 64; C = (st & 1) * 32 + (swz % 64) / 2; }
__host__ __device__ __forceinline__ int perm32(int rho) { const int n = rho >> 4, i = rho & 15; return 8 * (i >> 2) + 4 * n + (i & 3); }

struct Unit { int pm, pn, e, row0; };

struct DenseOrder {
    int nM, nN, nwg, G, c; const gchar* A; const gchar* Bt; size_t tstep;
    __device__ void init(const GAS void* A_, const GAS void* Bt_, int M, int N, int K, int G_, int c_) { A = (const gchar*)A_; Bt = (const gchar*)Bt_; nM = M / BM; nN = N / BM; nwg = nM * nN; G = G_; c = c_; tstep = (size_t)BM * K * 2; }
    __device__ __forceinline__ bool next(int i, Unit& u) const {
        const long L = (long)i * G + c; if (L >= nwg) return false;
        int wgid = (int)L; { const int q = nwg / NXCD, r = nwg % NXCD, xcd = wgid % NXCD, off = wgid / NXCD; wgid = (xcd < r ? xcd * (q + 1) : r * (q + 1) + (xcd - r) * q) + off; }
        const int nig = WGM * nN, gid = wgid / nig, fm = gid * WGM, gsz = (nM - fm) < WGM ? (nM - fm) : WGM;
        u.pm = fm + ((wgid % nig) % gsz); u.pn = (wgid % nig) / gsz; u.e = 0; u.row0 = u.pm * BM; return true;
    }
    __device__ __forceinline__ const gchar* a_base(const Unit& u) const { return A + (size_t)u.pm * tstep; }
    __device__ __forceinline__ const gchar* b_base(const Unit& u) const { return Bt + (size_t)u.pn * tstep; }
    __device__ __forceinline__ int gather_row(const Unit&, int) const { return 0; }
};

template <class Epi, class Sched, bool GATHER, bool FP8 = false>
__device__ __forceinline__ void gemm_phase(LAS unsigned char* lds, const int K, const Sched& S, const Epi& E) {
    const int tid = threadIdx.x, wid = __builtin_amdgcn_readfirstlane(tid >> 6), lane = tid & 63, wr = wid >> 2, wc = wid & 3, fr = lane & 15, fq = lane >> 4;
    const int nt = K / BK;
    int Rst[2], Cst[2];
    unsigned voffA[2], voffB[2];
#pragma unroll
    for (int i = 0; i < 2; ++i) { int R, C; stage_rc(tid * 16 + i * 8192, R, C); const int Rb = Epi::PERM ? ((R & ~31) + perm32(R & 31)) : R;
        Rst[i] = R; Cst[i] = C; voffA[i] = (unsigned)(R * K + C) * 2u; voffB[i] = (unsigned)(Rb * K + C) * 2u; }
    const size_t kstep = (size_t)(BK * 2);
    const size_t hstep = (size_t)HALF * K * 2;
    const unsigned ldsw = (unsigned)wid * 1024u;
    const int aoff = lds_byte(wr * 64 + fr, fq * 8), boff = lds_byte(wc * 32 + fr, fq * 8);
#define PG8_SA(b, h) (((b) * 2 + (h)) * HTB)
#define PG8_SB(b, h) ((4 + (b) * 2 + (h)) * HTB)
#define PG8_STAGE(bufoff, gbase, voff) do { _Pragma("unroll") for (int _i = 0; _i < 2; ++_i) \
        __builtin_amdgcn_global_load_lds((const GAS unsigned*)((const gchar*)(gbase) + (voff)[_i]), (LAS unsigned*)(lds + (bufoff) + ldsw + _i * 8192), 16, 0, 0); } while (0)
#define PG8_LDA(dst, b, h) do { _Pragma("unroll") for (int m = 0; m < 4; ++m) _Pragma("unroll") for (int k = 0; k < 2; ++k) dst[m][k] = *(const LAS bf16x8*)(lds + PG8_SA(b, h) + aoff + m * 2048 + k * 1024); } while (0)
#define PG8_LDB(dst, b, h) do { _Pragma("unroll") for (int n = 0; n < 2; ++n) _Pragma("unroll") for (int k = 0; k < 2; ++k) dst[n][k] = *(const LAS bf16x8*)(lds + PG8_SB(b, h) + boff + n * 2048 + k * 1024); } while (0)
#define PG8_CAT(x) __builtin_shufflevector(__builtin_bit_cast(i32x4, (x)[0]), __builtin_bit_cast(i32x4, (x)[1]), 0, 1, 2, 3, 4, 5, 6, 7)
#define PG8_MMA(ai, bj, At, Bt) do { __builtin_amdgcn_s_setprio(1); \
        if constexpr (FP8) { i32x8 _a8[4], _b8[2]; _Pragma("unroll") for (int m = 0; m < 4; ++m) _a8[m] = PG8_CAT(At[m]); _Pragma("unroll") for (int n = 0; n < 2; ++n) _b8[n] = PG8_CAT(Bt[n]); \
            _Pragma("unroll") for (int m = 0; m < 4; ++m) _Pragma("unroll") for (int n = 0; n < 2; ++n) \
                asm volatile("v_mfma_scale_f32_16x16x128_f8f6f4 %0, %1, %2, %0, %3, %4 op_sel_hi:[0,0,0]" : "+v"(acc[ai][bj][m][n]) : "v"(_b8[n]), "v"(_a8[m]), "v"(mx_sc[bj]), "v"(mx_one)); } \
        else { _Pragma("unroll") for (int m = 0; m < 4; ++m) _Pragma("unroll") for (int n = 0; n < 2; ++n) _Pragma("unroll") for (int k = 0; k < 2; ++k) \
            acc[ai][bj][m][n] = __builtin_amdgcn_mfma_f32_16x16x32_bf16(Bt[n][k], At[m][k], acc[ai][bj][m][n], 0, 0, 0); } __builtin_amdgcn_s_setprio(0); } while (0)
#define PG8_MMAZ(ai, bj, At, Bt) do { __builtin_amdgcn_s_setprio(1); \
        if constexpr (FP8) { i32x8 _a8[4], _b8[2]; _Pragma("unroll") for (int m = 0; m < 4; ++m) _a8[m] = PG8_CAT(At[m]); _Pragma("unroll") for (int n = 0; n < 2; ++n) _b8[n] = PG8_CAT(Bt[n]); \
            _Pragma("unroll") for (int m = 0; m < 4; ++m) _Pragma("unroll") for (int n = 0; n < 2; ++n) \
                asm volatile("v_mfma_scale_f32_16x16x128_f8f6f4 %0, %1, %2, 0, %3, %4 op_sel_hi:[0,0,0]" : "=&v"(acc[ai][bj][m][n]) : "v"(_b8[n]), "v"(_a8[m]), "v"(mx_sc[bj]), "v"(mx_one)); } \
        else { _Pragma("unroll") for (int m = 0; m < 4; ++m) _Pragma("unroll") for (int n = 0; n < 2; ++n) { \
            acc[ai][bj][m][n] = __builtin_amdgcn_mfma_f32_16x16x32_bf16(Bt[n][0], At[m][0], (f32x4){0.f, 0.f, 0.f, 0.f}, 0, 0, 0); \
            acc[ai][bj][m][n] = __builtin_amdgcn_mfma_f32_16x16x32_bf16(Bt[n][1], At[m][1], acc[ai][bj][m][n], 0, 0, 0); } } __builtin_amdgcn_s_setprio(0); } while (0)
#define PG8_MMA1(ai, bj, At, Bt) do { if (FP8 && t == 0) PG8_MMAZ(ai, bj, At, Bt); else PG8_MMA(ai, bj, At, Bt); } while (0)
#define PG8_WAIT_V(n) asm volatile("s_waitcnt vmcnt(" #n ")" ::: "memory")
#define PG8_WAIT_L(n) asm volatile("s_waitcnt lgkmcnt(" #n ")" ::: "memory")
#define PG8_BAR __builtin_amdgcn_s_barrier()
#define PG8_SCHED __builtin_amdgcn_sched_barrier(0)
    Unit cur, nxt; int ui = 0;
    if (!S.next(0, cur)) return;
#if STAGGER_TICKS
    {
      const unsigned long long t0 = __builtin_amdgcn_s_memrealtime(); const unsigned long long dt = (unsigned long long)((blockIdx.x >> 3) & 3) * STAGGER_TICKS;
      while (__builtin_amdgcn_s_memrealtime() - t0 < dt) __builtin_amdgcn_s_sleep(8); }
#endif
    f32x4 acc[2][2][4][2];
#pragma unroll
    for (int a = 0; a < 2; ++a)
#pragma unroll
        for (int b = 0; b < 2; ++b)
#pragma unroll
            for (int m = 0; m < 4; ++m)
#pragma unroll
                for (int n = 0; n < 2; ++n) acc[a][b][m][n] = (f32x4){0.f, 0.f, 0.f, 0.f};
    bf16x8 At[4][2], B0[2][2], B1[2][2]; int mx_one = 0x7f7f7f7f; asm volatile("" : "+v"(mx_one));
    int mx_sc[2] = {0x7f7f7f7f, 0x7f7f7f7f};
    if constexpr (FP8) { mx_sc[0] = 0x01010101 * (127 + Epi::MXE0); mx_sc[1] = 0x01010101 * (127 + Epi::MXE1); asm volatile("" : "+v"(mx_sc[0]), "+v"(mx_sc[1])); }
    const gchar* cA = S.a_base(cur); const gchar* cB = S.b_base(cur);
    unsigned vc0[2], vc1[2], vn0[2], vn1[2];
    if constexpr (GATHER) {
#pragma unroll
        for (int i = 0; i < 2; ++i) { vc0[i] = ((unsigned)S.gather_row(cur, Rst[i]) * (unsigned)K + (unsigned)Cst[i]) * 2u; vc1[i] = ((unsigned)S.gather_row(cur, HALF + Rst[i]) * (unsigned)K + (unsigned)Cst[i]) * 2u; vn0[i] = vc0[i]; vn1[i] = vc1[i]; }
    } else {
#pragma unroll
        for (int i = 0; i < 2; ++i) { vc0[i] = voffA[i]; vc1[i] = voffA[i] + (unsigned)hstep; vn0[i] = vc0[i]; vn1[i] = vc1[i]; }
    }
    PG8_STAGE(PG8_SB(0, 0), cB, voffB); PG8_STAGE(PG8_SA(0, 0), cA, vc0); PG8_STAGE(PG8_SB(0, 1), cB + hstep, voffB); PG8_STAGE(PG8_SA(0, 1), cA, vc1);
    if (wr == 1) PG8_BAR;
    PG8_WAIT_V(4); PG8_BAR;
    PG8_STAGE(PG8_SB(1, 0), cB + kstep, voffB); PG8_STAGE(PG8_SA(1, 0), cA + kstep, vc0); PG8_STAGE(PG8_SB(1, 1), cB + hstep + kstep, voffB);
    PG8_WAIT_V(6); PG8_BAR;
    for (;;) {
        const bool has_next = S.next(ui + 1, nxt);
        const gchar* nA = has_next ? S.a_base(nxt) : cA; const gchar* nB = has_next ? S.b_base(nxt) : cB;
        for (int t = 0; t < nt; t += 2) {
            const bool last = (t == nt - 2);
            const gchar* a1 = cA + (size_t)(t + 1) * kstep;
            const gchar* a2 = last ? nA : cA + (size_t)(t + 2) * kstep; const gchar* b2 = last ? nB : cB + (size_t)(t + 2) * kstep;
            const gchar* a3 = a2 + kstep; const gchar* b3 = b2 + kstep;
            unsigned s0[2], s1[2];
            if constexpr (GATHER) {
                if (last && has_next) {
#pragma unroll
                    for (int i = 0; i < 2; ++i) { vn0[i] = ((unsigned)S.gather_row(nxt, Rst[i]) * (unsigned)K + (unsigned)Cst[i]) * 2u; vn1[i] = ((unsigned)S.gather_row(nxt, HALF + Rst[i]) * (unsigned)K + (unsigned)Cst[i]) * 2u; }
                }
#pragma unroll
                for (int i = 0; i < 2; ++i) { s0[i] = last ? vn0[i] : vc0[i]; s1[i] = last ? vn1[i] : vc1[i]; }
            } else {
#pragma unroll
                for (int i = 0; i < 2; ++i) { s0[i] = vc0[i]; s1[i] = vc1[i]; }
            }
            PG8_LDB(B0, 0, 0); PG8_SCHED; PG8_LDA(At, 0, 0); PG8_STAGE(PG8_SA(1, 1), a1, vc1);
            PG8_WAIT_L(8); PG8_BAR; PG8_WAIT_L(0); PG8_MMA1(0, 0, At, B0); PG8_BAR; PG8_SCHED;
            PG8_LDB(B1, 0, 1); PG8_STAGE(PG8_SB(0, 0), b2, voffB);
            PG8_BAR; PG8_WAIT_L(0); PG8_MMA1(0, 1, At, B1); PG8_BAR;
            PG8_LDA(At, 0, 1); PG8_STAGE(PG8_SA(0, 0), a2, s0);
            PG8_BAR; PG8_WAIT_L(0); PG8_MMA1(1, 0, At, B0); PG8_BAR; PG8_SCHED;
            PG8_STAGE(PG8_SB(0, 1), b2 + hstep, voffB);
            PG8_WAIT_V(6); PG8_BAR; PG8_MMA1(1, 1, At, B1); PG8_BAR;
            PG8_LDB(B0, 1, 0); PG8_SCHED; PG8_LDA(At, 1, 0); PG8_STAGE(PG8_SA(0, 1), a2, s1);
            PG8_WAIT_L(8); PG8_BAR; PG8_WAIT_L(0); PG8_MMA(0, 0, At, B0); PG8_BAR; PG8_SCHED;
            PG8_LDB(B1, 1, 1); PG8_STAGE(PG8_SB(1, 0), b3, voffB);
            PG8_BAR; PG8_WAIT_L(0); PG8_MMA(0, 1, At, B1); PG8_BAR;
            PG8_LDA(At, 1, 1); PG8_STAGE(PG8_SA(1, 0), a3, s0);
            PG8_BAR; PG8_WAIT_L(0); PG8_MMA(1, 0, At, B0); PG8_BAR; PG8_SCHED;
            PG8_STAGE(PG8_SB(1, 1), b3 + hstep, voffB);
            PG8_WAIT_V(6); PG8_BAR; PG8_MMA(1, 1, At, B1); PG8_BAR;
        }
        if constexpr (FP8) {
            asm volatile("s_nop 15\n\ts_nop 3" : "+v"(acc[1][1][0][0]), "+v"(acc[1][1][0][1]), "+v"(acc[1][1][1][0]), "+v"(acc[1][1][1][1]), "+v"(acc[1][1][2][0]), "+v"(acc[1][1][2][1]), "+v"(acc[1][1][3][0]), "+v"(acc[1][1][3][1])); }
        E(acc, cur, wr, wc, fr, fq);
        if (!has_next) break;
        if constexpr (!FP8) {
#pragma unroll
            for (int a = 0; a < 2; ++a)
#pragma unroll
                for (int b = 0; b < 2; ++b)
#pragma unroll
                    for (int m = 0; m < 4; ++m)
#pragma unroll
                        for (int n = 0; n < 2; ++n) acc[a][b][m][n] = (f32x4){0.f, 0.f, 0.f, 0.f}; }
        cur = nxt; cA = nA; cB = nB; ++ui;
#pragma unroll
        for (int i = 0; i < 2; ++i) { vc0[i] = vn0[i]; vc1[i] = vn1[i]; }
    }
    PG8_WAIT_V(0);
    if (wr == 0) PG8_BAR;
    PG8_BAR;
#undef PG8_SA
#undef PG8_SB
#undef PG8_STAGE
#undef PG8_LDA
#undef PG8_LDB
#undef PG8_MMA
#undef PG8_MMAZ
#undef PG8_MMA1
#undef PG8_CAT
#undef PG8_WAIT_V
#undef PG8_WAIT_L
#undef PG8_BAR
#undef PG8_SCHED
}
}
using pg8::Unit;

enum { IN_X = 0, IN_C, IN_CTX, IN_CCTX, IN_ADAW, IN_ADAB, IN_NMIXW, IN_NFFNW, IN_CONVIN, IN_CONVDW, IN_CONVOUT, IN_MLIN, IN_MLGB, IN_MLNW, IN_MLOUT,
       IN_RW, IN_RB, IN_EG, IN_EU, IN_ED, IN_SG, IN_SU, IN_SD, IN_FNW, N_IN };
struct Args { const float* in[N_IN]; float* out; unsigned char* ws; int ph_lo, ph_hi, li, pad; };

#define INP(i) ((const gf32*)F.a->in[i])
struct Frame {
    LAS unsigned char* lds;
    int tid, lane, wave, bid;
    const Args* a; gf32* out; gu8* ws;
};

__device__ __forceinline__ const gf32* mod_ptr(const Frame& F, int layer, int mr, int chunk) { return (const gf32*)(F.ws + WS_MOD) + ((size_t)(layer * 9 + mr) * ADA_N + (size_t)chunk * D); }
__device__ __forceinline__ int mod_row(int r) { return r < NCTX ? 8 : ((r - NCTX) >> 11); }

struct EpiConvIn {
    static constexpr bool PERM = true; static constexpr int MXE0 = 0, MXE1 = 0;
    gbf16* U; gbf16* BMt;
    __device__ __forceinline__ void operator()(const f32x4 (&acc)[2][2][4][2], const Unit& u, int wr, int wc, int fr, int fq) const {
        const int row0 = u.pm * 256 + wr * 64 + fr;
        if (u.pn < 16) {
            const int col = u.pn * 128 + wc * 32 + 8 * fq;
#pragma unroll
            for (int ai = 0; ai < 2; ++ai)
#pragma unroll
                for (int m = 0; m < 4; ++m) {
                    const f32x4 a0 = acc[ai][0][m][0] * acc[ai][1][m][0], a1 = acc[ai][0][m][1] * acc[ai][1][m][1];
                    u32x4 w; w.x = cvt_pk_bf16(a0[0], a0[1]); w.y = cvt_pk_bf16(a0[2], a0[3]); w.z = cvt_pk_bf16(a1[0], a1[1]); w.w = cvt_pk_bf16(a1[2], a1[3]);
                    *(gu32x4*)(U + (size_t)(row0 + ai * 128 + m * 16) * D + col) = w; }
        } else {
            const int col = (u.pn - 16) * 256 + wc * 32 + 8 * fq;
#pragma unroll
            for (int ai = 0; ai < 2; ++ai)
#pragma unroll
                for (int m = 0; m < 4; ++m)
#pragma unroll
                    for (int bj = 0; bj < 2; ++bj) {
                        const f32x4 a0 = acc[ai][bj][m][0], a1 = acc[ai][bj][m][1];
                        u32x4 w; w.x = cvt_pk_bf16(a0[0], a0[1]); w.y = cvt_pk_bf16(a0[2], a0[3]); w.z = cvt_pk_bf16(a1[0], a1[1]); w.w = cvt_pk_bf16(a1[2], a1[3]);
                        *(gu32x4*)(BMt + (size_t)(row0 + ai * 128 + m * 16) * D + col + bj * 128) = w; }
        }
    }
};
template <bool BB>
struct EpiResidT {
    static constexpr bool PERM = false; static constexpr int MXE0 = 0, MXE1 = 0;
    const gf32* base_ctx; const gf32* base_lat; gf32* X; const gf32* gmod; int row_off;
    __device__ __forceinline__ void operator()(const f32x4 (&acc)[2][2][4][2], const Unit& u, int wr, int wc, int fr, int fq) const {
        const int R0 = row_off + u.pm * 256;
        const gf32* base = (R0 < NCTX) ? base_ctx + (size_t)R0 * D : base_lat + (size_t)(R0 - NCTX) * D;
        const gf32* g = gmod + (size_t)mod_row(R0) * ADA_N;
        gf32* o = X + (size_t)R0 * D;
        const int rl0 = wr * 64 + fr, col0 = u.pn * 256 + wc * 32 + 4 * fq;
        f32x4 gv[2][2];
#pragma unroll
        for (int bj = 0; bj < 2; ++bj)
#pragma unroll
            for (int n = 0; n < 2; ++n) gv[bj][n] = *(const gf32x4*)(g + col0 + bj * 128 + n * 16);
#pragma unroll
        for (int ah = 0; ah < 4; ++ah) { const int ai = ah >> 1, m0 = (ah & 1) * 2;
            f32x4 bv[2][2][2];
#pragma unroll
            for (int mm = 0; mm < 2; ++mm) { const size_t ro = (size_t)(rl0 + ai * 128 + (m0 + mm) * 16) * D + col0;
#pragma unroll
                for (int bj = 0; bj < 2; ++bj)
#pragma unroll
                    for (int n = 0; n < 2; ++n) {
                        if constexpr (BB) { const u32x2 w = *(const gu32x2*)((const gbf16*)base_lat + (size_t)(R0 - NCTX) * D + ro + bj * 128 + n * 16); bv[mm][bj][n] = (f32x4){bf_lo(w.x), bf_hi(w.x), bf_lo(w.y), bf_hi(w.y)}; }
                        else bv[mm][bj][n] = *(const gf32x4*)(base + ro + bj * 128 + n * 16); } }
#pragma unroll
            for (int mm = 0; mm < 2; ++mm) { const size_t ro = (size_t)(rl0 + ai * 128 + (m0 + mm) * 16) * D + col0;
#pragma unroll
                for (int bj = 0; bj < 2; ++bj)
#pragma unroll
                    for (int n = 0; n < 2; ++n) { const f32x4 y = bv[mm][bj][n] + gv[bj][n] * acc[ai][bj][m0 + mm][n];
                        if constexpr (BB) { u32x2 w; w.x = cvt_pk_bf16(y[0], y[1]); w.y = cvt_pk_bf16(y[2], y[3]); *(gu32x2*)((gbf16*)base_lat + (size_t)(R0 - NCTX) * D + ro + bj * 128 + n * 16) = w; }
                        else *(gf32x4*)(o + ro + bj * 128 + n * 16) = y; } } }
    }
};
using EpiResid = EpiResidT<false>;
__device__ __forceinline__ float softcap_gate(float g) {
    const float e = fast_exp(-2.0f * g * (1.0f / 15.0f)); return 15.0f * (1.0f - e) / (1.0f + e);
}
__device__ __forceinline__ float log_sigmoid_(float g) { return fminf(g, 0.0f) - __logf(1.0f + fast_exp(-fabsf(g))); }
struct EpiMlstmIn {
    static constexpr bool PERM = true; static constexpr int MXE0 = 0, MXE1 = 0;
    gbf16 *Q, *Kb, *V, *O;
    __device__ __forceinline__ void operator()(const f32x4 (&acc)[2][2][4][2], const Unit& u, int wr, int wc, int fr, int fq) const {
        const int row0 = u.pm * 256 + wr * 64 + fr;
        {
            gbf16* dst; int ld, ct; float sc = 1.0f;
            if (u.pn < 4) { dst = Q; ld = 1024; ct = u.pn; } else if (u.pn < 8) { dst = Kb; ld = 1024; ct = u.pn - 4; sc = 0.08838834764831845f; }
            else if (u.pn < 16) { dst = V; ld = 2048; ct = u.pn - 8; } else { dst = O; ld = 2048; ct = u.pn - 16; }
            const int col = ct * 256 + wc * 32 + 8 * fq;
#pragma unroll
            for (int ai = 0; ai < 2; ++ai)
#pragma unroll
                for (int m = 0; m < 4; ++m)
#pragma unroll
                    for (int bj = 0; bj < 2; ++bj) {
                        const f32x4 a0 = acc[ai][bj][m][0] * sc, a1 = acc[ai][bj][m][1] * sc;
                        u32x4 w; w.x = cvt_pk_bf16(a0[0], a0[1]); w.y = cvt_pk_bf16(a0[2], a0[3]); w.z = cvt_pk_bf16(a1[0], a1[1]); w.w = cvt_pk_bf16(a1[2], a1[3]);
                        *(gu32x4*)(dst + (size_t)(row0 + ai * 128 + m * 16) * ld + col + bj * 128) = w; }
        }
    }
};
struct EpiSwiglu {
    static constexpr bool PERM = true;
    static constexpr int MXE0 = -6, MXE1 = -2;
    gu8* ACT;
    __device__ __forceinline__ void operator()(const f32x4 (&acc)[2][2][4][2], const Unit& u, int wr, int wc, int fr, int fq) const {
        const int row0 = u.row0 + wr * 64 + fr, col = u.pn * 128 + wc * 32 + 8 * fq;
#pragma unroll
        for (int ai = 0; ai < 2; ++ai)
#pragma unroll
            for (int m = 0; m < 4; ++m) {
                f32x4 a0, a1;
#pragma unroll
                for (int j = 0; j < 4; ++j) { a0[j] = siluf_(acc[ai][0][m][0][j]) * acc[ai][1][m][0][j]; a1[j] = siluf_(acc[ai][0][m][1][j]) * acc[ai][1][m][1][j]; }
                u32x2 w; w.x = pk4_fp8(a0); w.y = pk4_fp8(a1);
                *(gu32x2*)(ACT + (size_t)(row0 + ai * 128 + m * 16) * ED + col) = w; }
    }
};
struct EpiDown {
    static constexpr bool PERM = true;
    static constexpr int MXE0 = -9, MXE1 = -9;
    gu8* Y;
    __device__ __forceinline__ void operator()(const f32x4 (&acc)[2][2][4][2], const Unit& u, int wr, int wc, int fr, int fq) const {
        const int row0 = u.row0 + wr * 64 + fr, col = u.pn * 256 + wc * 64 + 16 * fq;
#pragma unroll
        for (int ai = 0; ai < 2; ++ai)
#pragma unroll
            for (int m = 0; m < 4; ++m) { const int slot = row0 + ai * 128 + m * 16;
                u32x4 w; w.x = pk4_fp8(acc[ai][0][m][0]); w.y = pk4_fp8(acc[ai][0][m][1]); w.z = pk4_fp8(acc[ai][1][m][0]); w.w = pk4_fp8(acc[ai][1][m][1]);
                *(gu32x4*)(Y + (size_t)slot * D + col) = w; }
    }
};

constexpr int LDS_UNITS = RING_BYTES;
struct ExpertOrder {
    const LAS i32x4* units; const gchar* A; const gchar* Bt; const gi32* tok_of; int K, erows;
    __device__ __forceinline__ bool next(int i, Unit& u) const {
        const i32x4 d = units[i];
        u.e = __builtin_amdgcn_readfirstlane(d.x); u.pm = __builtin_amdgcn_readfirstlane(d.y); u.pn = __builtin_amdgcn_readfirstlane(d.z); u.row0 = __builtin_amdgcn_readfirstlane(d.w);
        return u.e >= 0;
    }
    __device__ __forceinline__ const gchar* a_base(const Unit& u) const { return tok_of ? A : A + (size_t)u.row0 * K * 2; }
    __device__ __forceinline__ const gchar* b_base(const Unit& u) const { return Bt + ((size_t)u.e * erows + (size_t)u.pn * 256) * K * 2; }
    __device__ __forceinline__ int gather_row(const Unit& u, int r) const { return tok_of[u.row0 + r]; }
};
__device__ __forceinline__ const LAS i32x4* stage_units(Frame& F, const gi32x4* g, int n) {
    LAS i32x4* l = (LAS i32x4*)(F.lds + LDS_UNITS);
    if (F.tid < n) l[F.tid] = g[F.tid];
    __syncthreads();
    return l;
}
__device__ __forceinline__ bool class_unit(const LAS int* tot, const LAS int* pst, int x, int q, int npn, int shs, int shn, i32x4& d) {
#pragma unroll 1
    for (int kk = 0; kk < 8; ++kk) { const int e = x + 8 * kk; const int n = ((tot[e] + 255) >> 8) * npn;
        if (q < n) { const int mt = q / npn; d = (i32x4){e, mt, q - mt * npn, pst[e] + 256 * mt}; return true; } q -= n; }
    if (q < shn * npn) { const int mt = shs + q / npn; d = (i32x4){64, mt, q % npn, SH_BASE + 256 * mt}; return true; }
    d = (i32x4){-1, 0, 0, 0}; return false;
}
__device__ __forceinline__ void shared_share(const LAS int* rt, int S, int x, int& shs, int& shn) {
    int R = 0;
#pragma unroll
    for (int y = 0; y < 8; ++y) R += rt[y];
    int lv = (R + S + 7) >> 3;
#pragma unroll 1
    for (;;) { int cap = 0;
#pragma unroll
        for (int y = 0; y < 8; ++y) cap += max(0, lv - rt[y]);
        if (cap >= S) break; ++lv; }
    int left = S; shs = 0; shn = 0;
#pragma unroll
    for (int y = 0; y < 8; ++y) { const int n = min(max(0, lv - rt[y]), left); if (y == x) { shs = S - left; shn = n; } left -= n; }
}

__device__ __forceinline__ int down_row(int c) { return (c & ~255) + 128 * ((c >> 3) & 1) + 32 * ((c >> 6) & 3) + 8 * ((c >> 4) & 3) + (c & 7); }
__device__ __forceinline__ void tr_item(const gf32* __restrict__ W, int ldw, int K, gbf16* WT, int drow, int k0, int n0src, LAS float* scr, int lane, bool dperm = false, float fp8 = 0.f) {
    float tv[32];
    const gf32* wp = W + (size_t)(k0 + (lane >> 5)) * ldw + n0src + (lane & 31);
#pragma unroll
    for (int i = 0; i < 32; ++i) tv[i] = __builtin_nontemporal_load(wp + (size_t)(2 * i) * ldw);
#pragma unroll
    for (int i = 0; i < 32; ++i) scr[(2 * i + (lane >> 5)) * 33 + (lane & 31)] = tv[i];
    LDS_WAIT(); asm volatile("" ::: "memory");
    if (fp8 != 0.f) {
        const int c4 = lane & 3; gu8* W8 = (gu8*)WT;
#pragma unroll
        for (int j = 0; j < 2; ++j) { const int n = (lane >> 2) + 16 * j; const LAS float* s = scr + (16 * c4) * 33 + n; u32x4 o;
#pragma unroll
            for (int q = 0; q < 4; ++q) o[q] = pk4_fp8((f32x4){s[(4 * q) * 33], s[(4 * q + 1) * 33], s[(4 * q + 2) * 33], s[(4 * q + 3) * 33]} * fp8);
            *(gu32x4*)(W8 + (size_t)(dperm ? down_row(drow + n) : drow + n) * K + k0 + 16 * c4) = o; }
        LDS_WAIT(); asm volatile("" ::: "memory");
        return; }
    const int c = lane & 7;
#pragma unroll
    for (int j = 0; j < 4; ++j) { const int n = (lane >> 3) + 8 * j; const LAS float* s = scr + (8 * c) * 33 + n;
        u32x4 o; o.x = cvt_pk_bf16(s[0 * 33], s[1 * 33]); o.y = cvt_pk_bf16(s[2 * 33], s[3 * 33]); o.z = cvt_pk_bf16(s[4 * 33], s[5 * 33]); o.w = cvt_pk_bf16(s[6 * 33], s[7 * 33]);
        *(gu32x4*)(WT + (size_t)(dperm ? down_row(drow + n) : drow + n) * K + k0 + 8 * c) = o; }
    LDS_WAIT(); asm volatile("" ::: "memory");
}
__device__ __forceinline__ void tr_job(int r, const gf32* src, int ldw, int col0, int K, int N, size_t sbatch, gbf16* dst, size_t dbatch, int row_off, int seg, int segs, LAS float* scr, int lane, bool dperm = false, float fp8 = 0.f) {
    const int nblk = N >> 5, ipb = (K >> 6) * nblk;
    const int bt = r / ipb, rr = r - bt * ipb, kb = rr / nblk, nb = rr - kb * nblk, n0 = nb << 5;
    tr_item(src + (size_t)bt * sbatch, ldw, K, dst + (size_t)bt * dbatch, row_off + (n0 / seg) * segs + (n0 % seg), kb << 6, col0 + n0, scr, lane, dperm, fp8);
}
__device__ __forceinline__ void phase_prologue(Frame& F) {
    if (F.bid < 192) {
        LAS float* cond = (LAS float*)F.lds;
        LAS float* red = (LAS float*)(F.lds + 9 * 2048 * 4);
        for (int i = F.tid; i < 9 * 2048; i += NTHR) { const int r = i >> 11, k = i & 2047; const float v = (r < 8) ? INP(IN_C)[r * D + k] : INP(IN_CCTX)[k]; cond[i] = siluf_(v); }
        __syncthreads();
        const int l = F.bid / 96, col0 = (F.bid % 96) * 128, cg = F.tid & 31, kl = F.tid >> 5;
        const gf32* W = INP(IN_ADAW) + (size_t)l * D * ADA_N + col0 + 4 * cg;
        f32x4 acc[9];
#pragma unroll
        for (int r = 0; r < 9; ++r) acc[r] = (f32x4){0.f, 0.f, 0.f, 0.f};
#pragma unroll 8
        for (int k = kl; k < D; k += 16) { const f32x4 w4 = __builtin_nontemporal_load((const gf32x4*)(W + (size_t)k * ADA_N));
#pragma unroll
            for (int r = 0; r < 9; ++r) acc[r] += cond[r * 2048 + k] * w4; }
#pragma unroll
        for (int r = 0; r < 9; ++r) *(LAS f32x4*)(red + (kl * 9 + r) * 128 + 4 * cg) = acc[r];
        __syncthreads();
        gf32* mod = (gf32*)(F.ws + WS_MOD);
        for (int o = F.tid; o < 9 * 128; o += NTHR) { const int r = o >> 7, c = o & 127; float s = 0.f;
#pragma unroll
            for (int q = 0; q < 16; ++q) s += red[(q * 9 + r) * 128 + c];
            mod[(size_t)(l * 9 + r) * ADA_N + col0 + c] = s + INP(IN_ADAB)[l * ADA_N + col0 + c]; }
        __syncthreads();
    }
    LAS float* scr = (LAS float*)(F.lds + F.wave * 8704);
    const int gw = F.bid * NWAVES + F.wave, NGW = GRID * NWAVES;
    gbf16* convin_t = (gbf16*)(F.ws + WS_CONVIN_T); gbf16* convout_t = (gbf16*)(F.ws + WS_CONVOUT_T);
    gbf16* mlin_t = (gbf16*)(F.ws + WS_MLIN_T); gbf16* mlout_t = (gbf16*)(F.ws + WS_MLOUT_T);
    constexpr int I_SQ = 32 * 64, I_MLIN = 32 * 193, I_RT = 32 * 2, I_EGU = 64 * 32 * 16, I_EDN = 64 * 8 * 64, I_SGU = 32 * 16, I_SDN = 8 * 64;
    constexpr int I_MOE = I_RT + 2 * I_EGU + I_EDN + 2 * I_SGU + I_SDN;
    constexpr int NITEMS = 4 * I_SQ + I_MLIN + I_SQ + 2 * I_MOE;
    gi32* ctr = (gi32*)(F.ws + WS_CTL) + CW_P0CTR;
    (void)gw; (void)NGW;
    for (;;) {
        int base = 0; if (F.lane == 0) base = __hip_atomic_fetch_add(ctr, 16, __ATOMIC_RELAXED, __HIP_MEMORY_SCOPE_AGENT);
        base = __builtin_amdgcn_readfirstlane(base);
        if (base >= NITEMS) break;
        const int lim = (base + 16 < NITEMS) ? base + 16 : NITEMS;
      for (int it = base; it < lim; ++it) {
        int r = it;
        if (r < I_SQ) { tr_job(r, INP(IN_CONVIN), 3 * D, 2048, D, D, 0, convin_t, 0, 0, 128, 256, scr, F.lane); continue; } r -= I_SQ;
        if (r < I_SQ) { tr_job(r, INP(IN_CONVIN), 3 * D, 4096, D, D, 0, convin_t, 0, 128, 128, 256, scr, F.lane); continue; } r -= I_SQ;
        if (r < I_SQ) { tr_job(r, INP(IN_CONVIN), 3 * D, 0, D, D, 0, convin_t, 0, 4096, D, 0, scr, F.lane); continue; } r -= I_SQ;
        if (r < I_SQ) { tr_job(r, INP(IN_CONVOUT), D, 0, D, D, 0, convout_t, 0, 0, D, 0, scr, F.lane); continue; } r -= I_SQ;
        if (r < I_MLIN) { tr_job(r, INP(IN_MLIN), MLSTM_N, 0, D, MLSTM_N, 0, mlin_t, 0, 0, 8192, 0, scr, F.lane); continue; } r -= I_MLIN;
        if (r < I_SQ) { tr_job(r, INP(IN_MLOUT), D, 0, D, D, 0, mlout_t, 0, 0, D, 0, scr, F.lane); continue; } r -= I_SQ;
        const int l = r / I_MOE; r -= l * I_MOE;
        gu8* moe = F.ws + WS_MOE0 + (size_t)l * MOE_STRIDE;
        gbf16* gu_t = (gbf16*)(moe + MOE_GU); gbf16* dn_t = (gbf16*)(moe + MOE_DN); gbf16* rt_t = (gbf16*)(moe + MOE_RT);
        if (r < I_RT) { tr_job(r, INP(IN_RW) + (size_t)l * D * NE, NE, 0, D, NE, 0, rt_t, 0, 0, NE, 0, scr, F.lane); continue; } r -= I_RT;
        if (r < I_EGU) { tr_job(r, INP(IN_EG) + (size_t)l * NE * D * ED, ED, 0, D, ED, (size_t)D * ED, gu_t, (size_t)512 * D, 0, 128, 256, scr, F.lane, false, GU_WSCALE); continue; } r -= I_EGU;
        if (r < I_EGU) { tr_job(r, INP(IN_EU) + (size_t)l * NE * D * ED, ED, 0, D, ED, (size_t)D * ED, gu_t, (size_t)512 * D, 128, 128, 256, scr, F.lane, false, GU_WSCALE); continue; } r -= I_EGU;
        if (r < I_EDN) { tr_job(r, INP(IN_ED) + (size_t)l * NE * ED * D, D, 0, ED, D, (size_t)ED * D, dn_t, (size_t)D * ED / 2, 0, D, 0, scr, F.lane, true, DN_WSCALE); continue; } r -= I_EDN;
        if (r < I_SGU) { tr_job(r, INP(IN_SG) + (size_t)l * D * ED, ED, 0, D, ED, 0, gu_t + (size_t)64 * 512 * D, 0, 0, 128, 256, scr, F.lane, false, GU_WSCALE); continue; } r -= I_SGU;
        if (r < I_SGU) { tr_job(r, INP(IN_SU) + (size_t)l * D * ED, ED, 0, D, ED, 0, gu_t + (size_t)64 * 512 * D, 0, 128, 128, 256, scr, F.lane, false, GU_WSCALE); continue; } r -= I_SGU;
        tr_job(r, INP(IN_SD) + (size_t)l * ED * D, D, 0, ED, D, 0, dn_t + (size_t)64 * D * ED / 2, 0, 0, D, 0, scr, F.lane, true, DN_WSCALE);
      }
    }
    { gu32x4* z = (gu32x4*)(mlin_t + (size_t)MLSTM_N * D); const int n16 = (MLSTM_NP - MLSTM_N) * D * 2 / 16;
      for (int i = F.bid * NTHR + F.tid; i < n16; i += GRID * NTHR) z[i] = (u32x4){0u, 0u, 0u, 0u}; }
}

template <bool LB> __device__ __forceinline__ int col_of(int lane, int j) { return LB ? 16 * lane + 1024 * (j >> 2) + 4 * (j & 3) : 4 * lane + 256 * j; }
template <bool TO_LDS, bool LB = false>
__device__ __forceinline__ void norm_mod_store(const f32x4 (&v)[8], float rstd, const gf32* w, const gf32* shift, const gf32* scale, gbf16* orow, LAS bf16_t* lrow, int lane) {
#pragma unroll
    for (int j = 0; j < 8; ++j) { const int c = col_of<LB>(lane, j);
        const f32x4 w4 = *(const gf32x4*)(w + c), sc = *(const gf32x4*)(scale + c), sh = *(const gf32x4*)(shift + c);
        const f32x4 y = (v[j] * rstd) * w4 * (sc + 1.0f) + sh;
        u32x2 o; o.x = cvt_pk_bf16(y[0], y[1]); o.y = cvt_pk_bf16(y[2], y[3]);
        *(gu32x2*)(orow + c) = o;
        if (TO_LDS) *(LAS u32x2*)(lrow + c) = o; }
}
__device__ __forceinline__ float row_ssq(const f32x4 (&v)[8]) {
    float s = 0.f;
#pragma unroll
    for (int j = 0; j < 8; ++j) s += (v[j][0] * v[j][0] + v[j][1] * v[j][1]) + (v[j][2] * v[j][2] + v[j][3] * v[j][3]);
    return wave_sum(s);
}

__device__ __forceinline__ void phase_norm0(Frame& F) {
    gbf16* H = (gbf16*)(F.ws + WS_H);
    const int gw = F.bid * NWAVES + F.wave, NGW = GRID * NWAVES;
    for (int r = gw; r < NTOK; r += NGW) {
        const gf32* xr = (r < NCTX) ? INP(IN_CTX) + (size_t)r * D : INP(IN_X) + (size_t)(r - NCTX) * D;
        f32x4 v[8];
#pragma unroll
        for (int j = 0; j < 8; ++j) v[j] = *(const gf32x4*)(xr + 4 * F.lane + 256 * j);
        const float rstd = rsqrtf(row_ssq(v) * (1.0f / D) + EPS);
        const int mr = mod_row(r);
        norm_mod_store<false>(v, rstd, INP(IN_NMIXW), mod_ptr(F, 0, mr, 0), mod_ptr(F, 0, mr, 1), H + (size_t)r * D, (LAS bf16_t*)F.lds, F.lane);
    }
}

__device__ __forceinline__ void phase_conv(Frame& F) {
    const gbf16* U = (const gbf16*)(F.ws + WS_U); const gbf16* BMt = (const gbf16*)(F.ws + WS_BM); gbf16* Z = (gbf16*)(F.ws + WS_Z);
    const gf32* dw = INP(IN_CONVDW);
    const int total = NTOK * (D / 8);
    for (int i = F.bid * NTHR + F.tid; i < total; i += GRID * NTHR) {
        const int r = i >> 8, c = (i & 255) * 8;
        const int pos = (r < NCTX) ? (r & 255) : (r & 63), seglen = (r < NCTX) ? 256 : 64;
        const u32x4 z4 = (u32x4){0u, 0u, 0u, 0u};
        const u32x4 um = (pos > 0) ? *(const gu32x4*)(U + (size_t)(r - 1) * D + c) : z4;
        const u32x4 u0 = *(const gu32x4*)(U + (size_t)r * D + c);
        const u32x4 up = (pos < seglen - 1) ? *(const gu32x4*)(U + (size_t)(r + 1) * D + c) : z4;
        const u32x4 bb = *(const gu32x4*)(BMt + (size_t)r * D + c);
        float w0[8], w1[8], w2[8];
#pragma unroll
        for (int q = 0; q < 2; ++q) { const f32x4 a = *(const gf32x4*)(dw + c + 4 * q), b = *(const gf32x4*)(dw + D + c + 4 * q), d = *(const gf32x4*)(dw + 2 * D + c + 4 * q);
#pragma unroll
            for (int j = 0; j < 4; ++j) { w0[4 * q + j] = a[j]; w1[4 * q + j] = b[j]; w2[4 * q + j] = d[j]; } }
        u32x4 o;
#pragma unroll
        for (int q = 0; q < 4; ++q) {
            const float y0 = bf_lo(bb[q]) * (w0[2 * q] * bf_lo(um[q]) + w1[2 * q] * bf_lo(u0[q]) + w2[2 * q] * bf_lo(up[q]));
            const float y1 = bf_hi(bb[q]) * (w0[2 * q + 1] * bf_hi(um[q]) + w1[2 * q + 1] * bf_hi(u0[q]) + w2[2 * q + 1] * bf_hi(up[q]));
            o[q] = cvt_pk_bf16(y0, y1); }
        *(gu32x4*)(Z + (size_t)r * D + c) = o;
    }
}

constexpr int HS_PITCH = 2056;
constexpr int RL_HS = 0, RL_PART = 16 * HS_PITCH * 2, RL_LOGIT = RL_PART + 8 * 16 * 64 * 4, RL_IDX = RL_LOGIT + 16 * 64 * 4;
template <int NT>
__device__ __forceinline__ void tile16_mfma(const LAS bf16_t* hs, const gbf16* Wt, LAS float* part, int wave, int lane) {
    f32x4 acc[NT];
#pragma unroll
    for (int nt = 0; nt < NT; ++nt) acc[nt] = (f32x4){0.f, 0.f, 0.f, 0.f};
    const int fr = lane & 15, fq = lane >> 4;
#pragma unroll 4
    for (int ks = 0; ks < 8; ++ks) { const int k0 = 256 * wave + 32 * ks + 8 * fq;
        const bf16x8 a = *(const LAS bf16x8*)(hs + fr * HS_PITCH + k0);
#pragma unroll
        for (int nt = 0; nt < NT; ++nt) { const bf16x8 b = *(const gbf16x8*)(Wt + (size_t)(16 * nt + fr) * D + k0);
            acc[nt] = __builtin_amdgcn_mfma_f32_16x16x32_bf16(a, b, acc[nt], 0, 0, 0); } }
#pragma unroll
    for (int nt = 0; nt < NT; ++nt)
#pragma unroll
        for (int j = 0; j < 4; ++j) part[wave * (256 * NT) + (4 * fq + j) * (16 * NT) + 16 * nt + fr] = acc[nt][j];
}
constexpr int R_HS = 0, R_PART = 0, R_LOGIT = 32 * HS_PITCH * 2, R_VSEL = R_LOGIT + 8192, R_TSC = R_VSEL + 8192, R_BIDX = R_TSC + 1024, R_CNT = R_BIDX + 1728;
static_assert(R_CNT + 2048 <= LDSCTL_OFF, "router LDS map");
template <bool XB16>
__device__ __forceinline__ void phase_router(Frame& F, int layer, int rowbase, int rpb) {
    const gf32* X = (const gf32*)(F.ws + WS_X); gu8* H8 = (gu8*)(F.ws + WS_H8);
    const gbf16* rt_t = (const gbf16*)(F.ws + WS_MOE0 + (size_t)layer * MOE_STRIDE + MOE_RT);
    gi32* sel_idx = (gi32*)(F.ws + RT_SELIDX); gf32* sel_gate = (gf32*)(F.ws + RT_SELGATE); gi32* sel_rank = (gi32*)(F.ws + RT_SELRANK); gi32* hist = (gi32*)(F.ws + RT_HIST);
    LAS bf16_t* hs = (LAS bf16_t*)(F.lds + R_HS); LAS float* part = (LAS float*)(F.lds + R_PART); LAS float* logit = (LAS float*)(F.lds + R_LOGIT);
    LAS float* vsel = (LAS float*)(F.lds + R_VSEL); LAS float* tsc = (LAS float*)(F.lds + R_TSC); LAS int* bidx = (LAS int*)(F.lds + R_BIDX); LAS int* wcnt = (LAS int*)(F.lds + R_CNT);
    const int r0 = rowbase + F.bid * rpb, ngroups = (rpb + 31) >> 5;
    const gf32* nw = INP(IN_NFFNW) + layer * D; const float bias = INP(IN_RB)[layer * NE + F.lane];
    const int fr = F.lane & 15, fq = F.lane >> 4;
#define RT_BAR() do { asm volatile("s_waitcnt lgkmcnt(0)" ::: "memory"); __builtin_amdgcn_s_barrier(); asm volatile("" ::: "memory"); } while (0)
    f32x4 cw[8], cs[8]; int cur_mr = -1;
    for (int g = 0; g < ngroups; ++g) {
#pragma unroll 1
        for (int pr = 0; pr < 2; ++pr) { const int lr = 4 * F.wave + 2 * pr, br = 32 * g + lr; LAS bf16_t* lrow = hs + lr * HS_PITCH;
            if (br < rpb) { const int r = r0 + br, mr = mod_row(r); const gf32* xr = X + (size_t)r * D; f32x4 va[8], vb[8];
                if constexpr (XB16) { const gbf16* xb = (const gbf16*)(F.ws + WS_XB) + (size_t)(r - NCTX) * D;
#pragma unroll
                    for (int j = 0; j < 8; ++j) { const u32x2 w0 = *(const gu32x2*)(xb + 4 * F.lane + 256 * j), w1 = *(const gu32x2*)(xb + D + 4 * F.lane + 256 * j);
                        va[j] = (f32x4){bf_lo(w0.x), bf_hi(w0.x), bf_lo(w0.y), bf_hi(w0.y)}; vb[j] = (f32x4){bf_lo(w1.x), bf_hi(w1.x), bf_lo(w1.y), bf_hi(w1.y)}; }
                } else {
#pragma unroll
                for (int j = 0; j < 8; ++j) { va[j] = *(const gf32x4*)(xr + 4 * F.lane + 256 * j); vb[j] = *(const gf32x4*)(xr + D + 4 * F.lane + 256 * j); } }
                if (mr != cur_mr) { cur_mr = mr; const gf32* sc = mod_ptr(F, layer, mr, 4); const gf32* sh = mod_ptr(F, layer, mr, 3);
#pragma unroll
                    for (int j = 0; j < 8; ++j) { const int c = 4 * F.lane + 256 * j; cw[j] = *(const gf32x4*)(nw + c) * (*(const gf32x4*)(sc + c) + 1.0f); cs[j] = *(const gf32x4*)(sh + c); } }
                const float rstd0 = rsqrtf(row_ssq(va) * (1.0f / D) + EPS), rstd1 = rsqrtf(row_ssq(vb) * (1.0f / D) + EPS);
#pragma unroll
                for (int j = 0; j < 8; ++j) { const int c = 4 * F.lane + 256 * j;
                    const f32x4 y0 = (va[j] * rstd0) * cw[j] + cs[j], y1 = (vb[j] * rstd1) * cw[j] + cs[j];
                    u32x2 o0, o1; o0.x = cvt_pk_bf16(y0[0], y0[1]); o0.y = cvt_pk_bf16(y0[2], y0[3]); o1.x = cvt_pk_bf16(y1[0], y1[1]); o1.y = cvt_pk_bf16(y1[2], y1[3]);
                    *(GAS unsigned*)(H8 + (size_t)r * D + c) = pk4_fp8(y0); *(GAS unsigned*)(H8 + (size_t)(r + 1) * D + c) = pk4_fp8(y1);
                    *(LAS u32x2*)(lrow + c) = o0; *(LAS u32x2*)(lrow + HS_PITCH + c) = o1; }
            } else {
#pragma unroll
                for (int j = 0; j < 8; ++j) { *(LAS u32x2*)(lrow + 4 * F.lane + 256 * j) = (u32x2){0u, 0u}; *(LAS u32x2*)(lrow + HS_PITCH + 4 * F.lane + 256 * j) = (u32x2){0u, 0u}; } } }
        RT_BAR();
        f32x4 acc[2][4];
#pragma unroll
        for (int t = 0; t < 2; ++t)
#pragma unroll
            for (int nt = 0; nt < 4; ++nt) acc[t][nt] = (f32x4){0.f, 0.f, 0.f, 0.f};
#pragma unroll 4
        for (int ks = 0; ks < 8; ++ks) { const int k0 = 256 * F.wave + 32 * ks + 8 * fq;
            const bf16x8 a0 = *(const LAS bf16x8*)(hs + fr * HS_PITCH + k0), a1 = *(const LAS bf16x8*)(hs + (16 + fr) * HS_PITCH + k0);
#pragma unroll
            for (int nt = 0; nt < 4; ++nt) { const bf16x8 bfr = *(const gbf16x8*)(rt_t + (size_t)(16 * nt + fr) * D + k0);
                acc[0][nt] = __builtin_amdgcn_mfma_f32_16x16x32_bf16(a0, bfr, acc[0][nt], 0, 0, 0); acc[1][nt] = __builtin_amdgcn_mfma_f32_16x16x32_bf16(a1, bfr, acc[1][nt], 0, 0, 0); } }
        RT_BAR();
#pragma unroll
        for (int t = 0; t < 2; ++t)
#pragma unroll
            for (int nt = 0; nt < 4; ++nt)
#pragma unroll
                for (int j = 0; j < 4; ++j) part[F.wave * 2048 + (16 * t + 4 * fq + j) * 64 + 16 * nt + fr] = acc[t][nt][j];
        RT_BAR();
#pragma unroll
        for (int q = 0; q < 4; ++q) { const int o = F.tid + 512 * q; float s = 0.f;
#pragma unroll
            for (int w = 0; w < 8; ++w) s += part[w * 2048 + o];
            const float sc = sigmoidf_(s); logit[o] = sc; vsel[o] = sc + bias; }
        RT_BAR();
#pragma unroll 1
        for (int q = 0; q < 4; ++q) { const int lr = 4 * F.wave + q, br = 32 * g + lr;
            if (br < rpb) { const int r = r0 + br;
                const float myv = vsel[lr * 64 + F.lane], mysc = logit[lr * 64 + F.lane]; int rank = 0;
#pragma unroll 4
                for (int j4 = 0; j4 < 16; ++j4) { const f32x4 o = *(const LAS f32x4*)(vsel + lr * 64 + 4 * j4);
#pragma unroll
                    for (int t = 0; t < 4; ++t) rank += (o[t] > myv || (o[t] == myv && (4 * j4 + t) < F.lane)) ? 1 : 0; }
                const bool sel = rank < TOPK;
                if (sel) tsc[lr * 8 + rank] = mysc;
                asm volatile("s_waitcnt lgkmcnt(0)" ::: "memory");
                float ssum = 0.f;
#pragma unroll
                for (int k = 0; k < TOPK; ++k) ssum += tsc[lr * 8 + k];
                if (sel) { sel_idx[(size_t)r * TOPK + rank] = F.lane; sel_gate[(size_t)r * TOPK + rank] = mysc / ssum * 2.5f; bidx[br * TOPK + rank] = F.lane; } } }
    }
    __syncthreads();
    { const int rw = rpb >> 3, rb = F.wave * rw; int cnt = 0;
      for (int rr = rb; rr < rb + rw; ++rr) {
#pragma unroll
          for (int k = 0; k < TOPK; ++k) cnt += (bidx[rr * TOPK + k] == F.lane) ? 1 : 0; }
      wcnt[F.wave * 64 + F.lane] = cnt;
      __syncthreads();
      int base = 0, tot = 0;
#pragma unroll
      for (int w = 0; w < 8; ++w) { const int c = wcnt[w * 64 + F.lane]; base += (w < F.wave) ? c : 0; tot += c; }
      for (int rr = rb; rr < rb + rw; ++rr) {
#pragma unroll
          for (int k = 0; k < TOPK; ++k) { if (bidx[rr * TOPK + k] == F.lane) { sel_rank[(size_t)(r0 + rr) * TOPK + k] = base; ++base; } } }
      if (F.wave == 0) hist[F.bid * NE + F.lane] = tot; }
    __syncthreads();
#undef RT_BAR
}

__device__ __forceinline__ void phase_scatter(Frame& F, int rowbase, int rpb, int ntok) {
    const gi32* hist = (const gi32*)(F.ws + RT_HIST); gi32* einfo = (gi32*)(F.ws + RT_EINFO);
    const gi32* sel_idx = (const gi32*)(F.ws + RT_SELIDX); const gf32* sel_gate = (const gf32*)(F.ws + RT_SELGATE); const gi32* sel_rank = (const gi32*)(F.ws + RT_SELRANK);
    gi32* slot_of = (gi32*)(F.ws + RT_SLOTOF); gi32* tok_of = (gi32*)(F.ws + RT_TOKOF); gf32* gate_of = (gf32*)(F.ws + RT_GATEOF);
    LAS int* tot8 = (LAS int*)F.lds; LAS int* pre8 = tot8 + 512; LAS int* tot = pre8 + 512; LAS int* boff = tot + 64; LAS int* pst = boff + 64;
    { const int e = F.tid & 63, p = F.tid >> 6; int s = 0, pre = 0;
      for (int b = 32 * p; b < 32 * p + 32; ++b) { const int h = hist[b * NE + e]; s += h; pre += (b < F.bid) ? h : 0; }
      tot8[p * 64 + e] = s; pre8[p * 64 + e] = pre; }
    __syncthreads();
    if (F.tid < 64) { int s = 0, pre = 0;
#pragma unroll
        for (int p = 0; p < 8; ++p) { s += tot8[p * 64 + F.tid]; pre += pre8[p * 64 + F.tid]; }
        tot[F.tid] = s; boff[F.tid] = pre; }
    __syncthreads();
    LAS int* rtl = pst + 64;
    if (F.tid == 0) { int a = 0; for (int e = 0; e < NE; ++e) { pst[e] = a; a += (tot[e] + 255) & ~255; } }
    if (F.tid >= 64 && F.tid < 72) { const int x = F.tid - 64; int t = 0;
#pragma unroll
        for (int kk = 0; kk < 8; ++kk) t += (tot[x + 8 * kk] + 255) >> 8;
        rtl[x] = t; }
    __syncthreads();
    const int r0 = rowbase + F.bid * rpb;
    for (int a = F.tid; a < rpb * TOPK; a += NTHR) { const size_t ga = (size_t)r0 * TOPK + a; const int e = sel_idx[ga];
        const int slot = pst[e] + boff[e] + sel_rank[ga];
        tok_of[slot] = r0 + a / TOPK; gate_of[slot] = sel_gate[ga]; slot_of[ga] = slot; }
    for (int rr = F.tid; rr < rpb; rr += NTHR) { const int s = SH_BASE + (r0 - rowbase) + rr; tok_of[s] = r0 + rr; gate_of[s] = 1.0f; }
    if (F.bid < NE) { const int e = F.bid, lo = pst[e] + tot[e], hi = pst[e] + ((tot[e] + 255) & ~255);
        for (int s = lo + F.tid; s < hi; s += NTHR) { tok_of[s] = rowbase; gate_of[s] = 0.0f; } }
    if (F.bid == 0) {
        if (F.tid < NE) { einfo[F.tid] = tot[F.tid]; einfo[128 + F.tid] = pst[F.tid]; einfo[256 + F.tid] = (tot[F.tid] + 255) >> 8; }
        if (F.tid == NE) { einfo[NE] = ntok; einfo[128 + NE] = SH_BASE; einfo[256 + NE] = ntok >> 8; } }
    { const int x = F.bid & 7, j = F.bid >> 3;
      gi32x4* u1 = (gi32x4*)(F.ws + RT_UNITS1) + F.bid * MAXU1; gi32x4* u2 = (gi32x4*)(F.ws + RT_UNITS2) + F.bid * MAXU2;
      if (F.tid < 128 + MAXU2) { int shs, shn; shared_share(rtl, ntok >> 8, x, shs, shn);
        if (F.tid < MAXU1) { i32x4 d; class_unit(tot, pst, x, F.tid * 32 + j, 4, shs, shn, d); u1[F.tid] = d; }
        else if (F.tid >= 128) { const int i = F.tid - 128; i32x4 d; class_unit(tot, pst, x, i * 32 + j, 8, shs, shn, d); u2[i] = d; } } }
    __syncthreads();
}

template <int MODE>
__device__ __forceinline__ void phase_combine(Frame& F) {
    gf32* X = (gf32*)(F.ws + WS_X); gbf16* H = (gbf16*)(F.ws + WS_H); const gu8* Y = (const gu8*)(F.ws + WS_Y);
    const gi32* slot_of = (const gi32*)(F.ws + RT_SLOTOF);
    const int layer = MODE, rowbase = MODE ? NCTX : 0, nrows = MODE ? NLAT : NTOK;
    const int gw = F.bid * NWAVES + F.wave, NGW = GRID * NWAVES;
    const gf32* sel_gate = (const gf32*)(F.ws + RT_SELGATE);
    int sln[TOPK]; float gln[TOPK];
    if (gw < nrows) {
#pragma unroll
        for (int k = 0; k < TOPK; ++k) { sln[k] = slot_of[(size_t)(rowbase + gw) * TOPK + k]; gln[k] = sel_gate[(size_t)(rowbase + gw) * TOPK + k]; } }
    for (int rr = gw; rr < nrows; rr += NGW) { const int r = rowbase + rr;
        int sl[7]; float gk[7];
#pragma unroll
        for (int k = 0; k < TOPK; ++k) { sl[k] = __builtin_amdgcn_readfirstlane(sln[k]); gk[k] = __int_as_float(__builtin_amdgcn_readfirstlane(__float_as_int(gln[k]))); }
        if (rr + NGW < nrows) {
#pragma unroll
            for (int k = 0; k < TOPK; ++k) { sln[k] = slot_of[(size_t)(r + NGW) * TOPK + k]; gln[k] = sel_gate[(size_t)(r + NGW) * TOPK + k]; } }
        sl[6] = SH_BASE + rr; gk[6] = 1.0f;
        const int mr = mod_row(r); const gf32* g2 = mod_ptr(F, layer, mr, 5);
        f32x4 v[8];
#pragma unroll
        for (int hh = 0; hh < 2; ++hh) {
            f32x4 m[4];
#pragma unroll
            for (int q = 0; q < 4; ++q) m[q] = (f32x4){0.f, 0.f, 0.f, 0.f};
#pragma unroll
            for (int k = 0; k < 7; ++k) { const u32x4 y = *(const gu32x4*)(Y + (size_t)sl[k] * D + 16 * F.lane + 1024 * hh);
                acc4_fp8s(m[0], y.x, gk[k]); acc4_fp8s(m[1], y.y, gk[k]); acc4_fp8s(m[2], y.z, gk[k]); acc4_fp8s(m[3], y.w, gk[k]); }
            if constexpr (MODE == 1) {
                const gbf16* xb = (const gbf16*)(F.ws + WS_XB) + (size_t)rr * D + 16 * F.lane + 1024 * hh; const u32x4 x0 = *(const gu32x4*)xb, x1 = *(const gu32x4*)(xb + 8);
                const f32x4 b4[4] = {(f32x4){bf_lo(x0.x), bf_hi(x0.x), bf_lo(x0.y), bf_hi(x0.y)}, (f32x4){bf_lo(x0.z), bf_hi(x0.z), bf_lo(x0.w), bf_hi(x0.w)}, (f32x4){bf_lo(x1.x), bf_hi(x1.x), bf_lo(x1.y), bf_hi(x1.y)}, (f32x4){bf_lo(x1.z), bf_hi(x1.z), bf_lo(x1.w), bf_hi(x1.w)}};
#pragma unroll
                for (int q = 0; q < 4; ++q) { const int c = 16 * F.lane + 1024 * hh + 4 * q; v[4 * hh + q] = b4[q] + *(const gf32x4*)(g2 + c) * m[q]; }
            } else {
#pragma unroll
            for (int q = 0; q < 4; ++q) { const int c = 16 * F.lane + 1024 * hh + 4 * q; v[4 * hh + q] = *(const gf32x4*)(X + (size_t)r * D + c) + *(const gf32x4*)(g2 + c) * m[q]; } } }
        const float rstd = rsqrtf(row_ssq(v) * (1.0f / D) + EPS);
        if (MODE == 0) {
#pragma unroll
            for (int j = 0; j < 8; ++j) *(gf32x4*)(X + (size_t)r * D + col_of<true>(F.lane, j)) = v[j];
            norm_mod_store<false, true>(v, rstd, INP(IN_NMIXW) + D, mod_ptr(F, 1, mr, 0), mod_ptr(F, 1, mr, 1), H + (size_t)r * D, (LAS bf16_t*)F.lds, F.lane);
        } else {
#pragma unroll
            for (int j = 0; j < 8; ++j) { const int c = col_of<true>(F.lane, j); *(gf32x4*)(F.out + (size_t)rr * D + c) = (v[j] * rstd) * *(const gf32x4*)(INP(IN_FNW) + c); }
        }
    }
}

__device__ __forceinline__ void phase_combine0_gates(Frame& F) {
    gf32* X = (gf32*)(F.ws + WS_X); gbf16* H = (gbf16*)(F.ws + WS_H); const gu8* Y = (const gu8*)(F.ws + WS_Y);
    const gi32* slot_of = (const gi32*)(F.ws + RT_SLOTOF); gf32* G = (gf32*)(F.ws + WS_GATES);
    const gbf16* Wg = (const gbf16*)(F.ws + WS_MLIN_T) + (size_t)6144 * D;
    LAS bf16_t* hs = (LAS bf16_t*)(F.lds + R_HS); LAS float* part = (LAS float*)(F.lds + R_PART);
    constexpr int rpb = NTOK / GRID;
    const int r0 = F.bid * rpb, ngroups = (rpb + 31) >> 5;
    const int fr = F.lane & 15, fq = F.lane >> 4;
#define CG_BAR() do { asm volatile("s_waitcnt lgkmcnt(0)" ::: "memory"); __builtin_amdgcn_s_barrier(); asm volatile("" ::: "memory"); } while (0)
    f32x4 cw[8]; int cur_mr = -1;
    for (int g = 0; g < ngroups; ++g) {
        const int lr0 = 4 * F.wave, br0 = 32 * g + lr0;
        if (br0 < rpb) {
            const int slv = slot_of[(size_t)(r0 + br0) * TOPK + (F.lane < 24 ? F.lane : 0)];
            const int glv = __float_as_int(((const gf32*)(F.ws + RT_SELGATE))[(size_t)(r0 + br0) * TOPK + (F.lane < 24 ? F.lane : 0)]);
#pragma unroll 1
            for (int q = 0; q < 4; ++q) { const int r = r0 + br0 + q, mr = mod_row(r); LAS bf16_t* lrow = hs + (lr0 + q) * HS_PITCH;
                int sl[7]; float gk[7];
#pragma unroll
                for (int k = 0; k < TOPK; ++k) { sl[k] = __builtin_amdgcn_readlane(slv, 6 * q + k); gk[k] = __int_as_float(__builtin_amdgcn_readlane(glv, 6 * q + k)); }
                sl[6] = SH_BASE + r; gk[6] = 1.0f;
                const gf32* g2 = mod_ptr(F, 0, mr, 5); const gf32* sh = mod_ptr(F, 1, mr, 0);
                if (mr != cur_mr) { cur_mr = mr; const gf32* sc = mod_ptr(F, 1, mr, 1); const gf32* nw = INP(IN_NMIXW) + D;
#pragma unroll
                    for (int j = 0; j < 8; ++j) { const int c = col_of<true>(F.lane, j); cw[j] = *(const gf32x4*)(nw + c) * (*(const gf32x4*)(sc + c) + 1.0f); } }
                f32x4 v[8];
#pragma unroll
                for (int hh = 0; hh < 2; ++hh) {
                    f32x4 m[4];
#pragma unroll
                    for (int qq = 0; qq < 4; ++qq) m[qq] = (f32x4){0.f, 0.f, 0.f, 0.f};
#pragma unroll
                    for (int k = 0; k < 7; ++k) { const u32x4 y = *(const gu32x4*)(Y + (size_t)sl[k] * D + 16 * F.lane + 1024 * hh);
                        acc4_fp8s(m[0], y.x, gk[k]); acc4_fp8s(m[1], y.y, gk[k]); acc4_fp8s(m[2], y.z, gk[k]); acc4_fp8s(m[3], y.w, gk[k]); }
#pragma unroll
                    for (int qq = 0; qq < 4; ++qq) { const int c = 16 * F.lane + 1024 * hh + 4 * qq; v[4 * hh + qq] = *(const gf32x4*)(X + (size_t)r * D + c) + *(const gf32x4*)(g2 + c) * m[qq]; } }
                const float rstd = rsqrtf(row_ssq(v) * (1.0f / D) + EPS);
                if (r >= NCTX) {
                    gbf16* xb = (gbf16*)(F.ws + WS_XB) + (size_t)(r - NCTX) * D;
#pragma unroll
                    for (int hh = 0; hh < 2; ++hh) {
                        u32x4 w0, w1;
                        w0.x = cvt_pk_bf16(v[4 * hh][0], v[4 * hh][1]); w0.y = cvt_pk_bf16(v[4 * hh][2], v[4 * hh][3]); w0.z = cvt_pk_bf16(v[4 * hh + 1][0], v[4 * hh + 1][1]); w0.w = cvt_pk_bf16(v[4 * hh + 1][2], v[4 * hh + 1][3]);
                        w1.x = cvt_pk_bf16(v[4 * hh + 2][0], v[4 * hh + 2][1]); w1.y = cvt_pk_bf16(v[4 * hh + 2][2], v[4 * hh + 2][3]); w1.z = cvt_pk_bf16(v[4 * hh + 3][0], v[4 * hh + 3][1]); w1.w = cvt_pk_bf16(v[4 * hh + 3][2], v[4 * hh + 3][3]);
                        *(gu32x4*)(xb + 16 * F.lane + 1024 * hh) = w0; *(gu32x4*)(xb + 16 * F.lane + 1024 * hh + 8) = w1; } }
#pragma unroll
                for (int j = 0; j < 8; ++j) { const int c = col_of<true>(F.lane, j);
                    const f32x4 y = (v[j] * rstd) * cw[j] + *(const gf32x4*)(sh + c);
                    u32x2 o; o.x = cvt_pk_bf16(y[0], y[1]); o.y = cvt_pk_bf16(y[2], y[3]);
                    *(gu32x2*)(H + (size_t)r * D + c) = o; *(LAS u32x2*)(lrow + c) = o; } }
        } else {
#pragma unroll
            for (int q = 0; q < 4; ++q)
#pragma unroll
                for (int j = 0; j < 8; ++j) *(LAS u32x2*)(hs + (lr0 + q) * HS_PITCH + 4 * F.lane + 256 * j) = (u32x2){0u, 0u}; }
        CG_BAR();
        f32x4 acc[2][2];
#pragma unroll
        for (int t = 0; t < 2; ++t)
#pragma unroll
            for (int nt = 0; nt < 2; ++nt) acc[t][nt] = (f32x4){0.f, 0.f, 0.f, 0.f};
#pragma unroll 4
        for (int ks = 0; ks < 8; ++ks) { const int k0 = 256 * F.wave + 32 * ks + 8 * fq;
            const bf16x8 a0 = *(const LAS bf16x8*)(hs + fr * HS_PITCH + k0), a1 = *(const LAS bf16x8*)(hs + (16 + fr) * HS_PITCH + k0);
#pragma unroll
            for (int nt = 0; nt < 2; ++nt) { const bf16x8 bfr = *(const gbf16x8*)(Wg + (size_t)(16 * nt + fr) * D + k0);
                acc[0][nt] = __builtin_amdgcn_mfma_f32_16x16x32_bf16(a0, bfr, acc[0][nt], 0, 0, 0); acc[1][nt] = __builtin_amdgcn_mfma_f32_16x16x32_bf16(a1, bfr, acc[1][nt], 0, 0, 0); } }
        CG_BAR();
#pragma unroll
        for (int t = 0; t < 2; ++t)
#pragma unroll
            for (int nt = 0; nt < 2; ++nt)
#pragma unroll
                for (int j = 0; j < 4; ++j) part[F.wave * 1024 + (16 * t + 4 * fq + j) * 32 + 16 * nt + fr] = acc[t][nt][j];
        CG_BAR();
#pragma unroll
        for (int q = 0; q < 2; ++q) { const int o = F.tid + 512 * q, row = o >> 5, cidx = o & 31, br = 32 * g + row; float sacc = 0.f;
#pragma unroll
            for (int w = 0; w < 8; ++w) sacc += part[w * 1024 + o];
            if (br < rpb) { float gt = softcap_gate(sacc + INP(IN_MLGB)[cidx]); if ((cidx >> 3) & 1) gt = log_sigmoid_(gt); G[(size_t)(r0 + br) * 32 + cidx] = gt; } }
        CG_BAR();
    }
#undef CG_BAR
}

__device__ __forceinline__ void phase_headnorm(Frame& F) {
    const gbf16* HF = (const gbf16*)(F.ws + WS_HF); const gbf16* HB = (const gbf16*)(F.ws + WS_HB); const gbf16* O = (const gbf16*)(F.ws + WS_O); gbf16* YIN = (gbf16*)(F.ws + WS_YIN);
    const gf32* nw = INP(IN_MLNW);
    const int gw = F.bid * NWAVES + F.wave, NGW = GRID * NWAVES;
    const int c0 = 32 * F.lane;
    f32x4 w4[8];
#pragma unroll
    for (int q = 0; q < 8; ++q) w4[q] = *(const gf32x4*)(nw + c0 + 4 * q);
    for (int rr = gw; rr < NLAT; rr += NGW) {
        u32x4 a[4], b[4], o[4];
#pragma unroll
        for (int q = 0; q < 4; ++q) { a[q] = *(const gu32x4*)(HF + (size_t)rr * D + c0 + 8 * q); b[q] = *(const gu32x4*)(HB + (size_t)rr * D + c0 + 8 * q); o[q] = *(const gu32x4*)(O + (size_t)(NCTX + rr) * D + c0 + 8 * q); }
        float h[32]; float ss = 0.f;
#pragma unroll
        for (int q = 0; q < 4; ++q)
#pragma unroll
            for (int e = 0; e < 4; ++e) { const float h0 = bf_lo(a[q][e]) + bf_lo(b[q][e]), h1 = bf_hi(a[q][e]) + bf_hi(b[q][e]); h[8 * q + 2 * e] = h0; h[8 * q + 2 * e + 1] = h1; ss += h0 * h0 + h1 * h1; }
        ss += dpp_mov<0xB1>(ss); ss += dpp_mov<0x4E>(ss); ss += dpp_mov<0x141>(ss);
        const float rstd = rsqrtf(ss * (1.0f / 256.0f) + EPS);
#pragma unroll
        for (int q = 0; q < 4; ++q) { u32x4 w;
#pragma unroll
            for (int e = 0; e < 4; ++e) { const int i0 = 8 * q + 2 * e;
                const float y0 = h[i0] * rstd * w4[i0 >> 2][i0 & 3] * sigmoidf_(bf_lo(o[q][e])), y1 = h[i0 + 1] * rstd * w4[(i0 + 1) >> 2][(i0 + 1) & 3] * sigmoidf_(bf_hi(o[q][e]));
                w[e] = cvt_pk_bf16(y0, y1); }
            *(gu32x4*)(YIN + (size_t)rr * D + c0 + 8 * q) = w; }
    }
}

constexpr int ML_Q = 0, ML_K = 16384, ML_V = 32768, ML_VW = 49152, ML_S = 65536, ML_CT = 74752, ML_F = 113920, ML_G = 118784;
constexpr int ML_SP = 144, ML_CTP = 272;
__device__ __forceinline__ unsigned off_b(unsigned row, unsigned ch) { return 256u * row + 16u * (ch ^ (((row & 3u) << 2) | ((row >> 2) & 3u))); }
__device__ __forceinline__ unsigned rowrd16(unsigned lane, unsigned rb, unsigned s) { return off_b((lane & 15u) + 16u * rb, 4u * s + (lane >> 4)); }
__device__ __forceinline__ unsigned trrd16(unsigned lane, unsigned c, unsigned ks, unsigned t) {
    const unsigned g = lane >> 4, q = (lane & 15u) >> 2, p = lane & 3u;
    return off_b(32u * ks + 8u * g + 4u * t + q, 2u * c + (p >> 1)) + 8u * (p & 1u);
}
__device__ __forceinline__ bf16x8 tr_frag(LAS unsigned char* img, unsigned lane, unsigned c, unsigned ks) {
    const s16x4 lo = __builtin_amdgcn_ds_read_tr16_b64_v4i16((LAS s16x4*)(img + trrd16(lane, c, ks, 0)));
    const s16x4 hi = __builtin_amdgcn_ds_read_tr16_b64_v4i16((LAS s16x4*)(img + trrd16(lane, c, ks, 1)));
    return (bf16x8){lo[0], lo[1], lo[2], lo[3], hi[0], hi[1], hi[2], hi[3]};
}
__device__ __forceinline__ int ml_row(int b, int dir, int p) {
    return (p < CTXL) ? b * CTXL + (dir ? (CTXL - 1 - p) : p) : NCTX + b * SEQ + (dir ? (SEQ - 1 - (p - CTXL)) : (p - CTXL));
}
__device__ __forceinline__ void phase_mlstm(Frame& F) {
    const gbf16* Qb = (const gbf16*)(F.ws + WS_Q); const gbf16* Kb = (const gbf16*)(F.ws + WS_K); const gbf16* Vb = (const gbf16*)(F.ws + WS_V);
    const gf32* G = (const gf32*)(F.ws + WS_GATES);
    const int wi = F.bid, b = wi >> 5, hd = (wi >> 2) & 7, dir = (wi >> 1) & 1, half = wi & 1;
    gbf16* HD = (gbf16*)(F.ws + (dir ? WS_HB : WS_HF));
    LAS unsigned char* L = F.lds;
    LAS float* fct = (LAS float*)(L + ML_F); LAS float* frs = fct + 64; LAS float* fwi = frs + 64; LAS float* fem = fwi + 64; LAS float* fsc = fem + 64;
    LAS bf16_t* wkb = (LAS bf16_t*)(fsc + 16); LAS float* fwk = (LAS float*)(wkb + 64);
    const unsigned lane = (unsigned)F.lane; const int w = F.wave, fr = F.lane & 15, fq = F.lane >> 4;
    for (int i = F.tid; i < 144 * ML_CTP / 16; i += NTHR) *(LAS u32x4*)(L + ML_CT + 16 * i) = (u32x4){0u, 0u, 0u, 0u};
    f32x4 cst[9];
#pragma unroll
    for (int v = 0; v < 9; ++v) cst[v] = (f32x4){0.f, 0.f, 0.f, 0.f};
    LAS float* BC = (LAS float*)(L + ML_G); LAS float* RS = BC + 2304; LAS float* CM = RS + 2304; LAS float* BL = CM + 2304; LAS float* CML = BL + 40; LAS float* MST = CML + 40; LAS float* MNW = MST + 40; LAS float* DEC = MNW + 40;
    for (int c = w; c < 36; c += 8) { const int p = 64 * c + F.lane; const size_t gr = (size_t)ml_row(b, dir, p);
        const float li = G[gr * 32 + (2 * dir) * 8 + hd], lf = G[gr * 32 + (2 * dir + 1) * 8 + hd];
        float bc = lf;
#pragma unroll
        for (int o = 1; o < 64; o <<= 1) { const float t = __shfl_up(bc, o); if (F.lane >= o) bc += t; }
        const float rsv = li - bc; float cm = rsv;
#pragma unroll
        for (int o = 1; o < 64; o <<= 1) { const float t = __shfl_up(cm, o); if (F.lane >= o) cm = fmaxf(cm, t); }
        BC[p] = bc; RS[p] = rsv; CM[p] = cm;
        if (F.lane == 63) { BL[c] = bc; CML[c] = cm; } }
    __syncthreads();
    if (F.tid == 0) { float m = -1.0e30f;
        for (int c = 0; c < 36; ++c) { const float bl = BL[c], mn = fmaxf(bl + m, bl + CML[c]); MST[c] = m; MNW[c] = mn; DEC[c] = fast_exp(bl + m - mn); m = mn; } }
    __syncthreads();
    u32x4 gq[2], gk[2], gv[2];
#define ML_LOAD_CHUNK(P0) do { _Pragma("unroll") for (int i = 0; i < 2; ++i) { const int cid = F.tid + 512 * i, row = cid >> 4, ch = cid & 15; const size_t gr = (size_t)ml_row(b, dir, (P0) + row); \
            gq[i] = *(const gu32x4*)(Qb + gr * 1024 + hd * 128 + 8 * ch); gk[i] = *(const gu32x4*)(Kb + gr * 1024 + hd * 128 + 8 * ch); \
            gv[i] = *(const gu32x4*)(Vb + gr * 2048 + hd * 256 + half * 128 + 8 * ch); } } while (0)
    ML_LOAD_CHUNK(0);
#define ML_BAR() do { asm volatile("s_waitcnt lgkmcnt(0)" ::: "memory"); __builtin_amdgcn_s_barrier(); asm volatile("" ::: "memory"); } while (0)
#pragma unroll 1
    for (int c = 0; c < 36; ++c) {
        const int p0 = 64 * c;
        if (F.tid < 64) { const float m_st = MST[c], mnew = MNW[c], bc = BC[p0 + F.tid], rsv = RS[p0 + F.tid], cm = CM[p0 + F.tid];
            const float mrow = bc + fmaxf(m_st, cm), wk = fast_exp(BL[c] + rsv - mnew);
            fct[F.tid] = bc - mrow; frs[F.tid] = rsv; fwi[F.tid] = fast_exp(bc + m_st - mrow); fem[F.tid] = fast_exp(-mrow); fwk[F.tid] = wk;
            if (F.tid == 0) { fsc[0] = DEC[c]; fsc[1] = mnew; } }
#pragma unroll
        for (int i = 0; i < 2; ++i) { const int cid = F.tid + 512 * i, row = cid >> 4, ch = cid & 15; const unsigned o = off_b(row, ch);
            *(LAS u32x4*)(L + ML_Q + o) = gq[i]; *(LAS u32x4*)(L + ML_K + o) = gk[i]; *(LAS u32x4*)(L + ML_V + o) = gv[i]; }
        if (c + 1 < 36) ML_LOAD_CHUNK(p0 + 64);
        ML_BAR();
        const float decay = fsc[0];
#pragma unroll
        for (int v = 0; v < 9; ++v) cst[v] *= decay;
#pragma unroll
        for (int ks = 0; ks < 2; ++ks) {
            const bf16x8 a0 = tr_frag(L + ML_K, lane, (unsigned)w, ks);
            const f32x4 wk0 = *(const LAS f32x4*)(fwk + 32 * ks + 8 * fq), wk1 = *(const LAS f32x4*)(fwk + 32 * ks + 8 * fq + 4);
            bf16x8 a;
            { const unsigned p0 = cvt_pk_bf16(__uint_as_float((unsigned)(unsigned short)a0[0] << 16) * wk0[0], __uint_as_float((unsigned)(unsigned short)a0[1] << 16) * wk0[1]);
              const unsigned p1 = cvt_pk_bf16(__uint_as_float((unsigned)(unsigned short)a0[2] << 16) * wk0[2], __uint_as_float((unsigned)(unsigned short)a0[3] << 16) * wk0[3]);
              const unsigned p2 = cvt_pk_bf16(__uint_as_float((unsigned)(unsigned short)a0[4] << 16) * wk1[0], __uint_as_float((unsigned)(unsigned short)a0[5] << 16) * wk1[1]);
              const unsigned p3 = cvt_pk_bf16(__uint_as_float((unsigned)(unsigned short)a0[6] << 16) * wk1[2], __uint_as_float((unsigned)(unsigned short)a0[7] << 16) * wk1[3]);
              a = __builtin_bit_cast(bf16x8, (u32x4){p0, p1, p2, p3}); }
#pragma unroll
            for (int v = 0; v < 8; ++v) { const bf16x8 bb = tr_frag(L + ML_V, lane, v, ks); cst[v] = __builtin_amdgcn_mfma_f32_16x16x32_bf16(a, bb, cst[v], 0, 0, 0); }
            const bf16x8 ba = (bf16x8){(short)0x3F80, (short)0x3F80, (short)0x3F80, (short)0x3F80, (short)0x3F80, (short)0x3F80, (short)0x3F80, (short)0x3F80};
            cst[8] = __builtin_amdgcn_mfma_f32_16x16x32_bf16(a, ba, cst[8], 0, 0, 0);
        }
        if (c >= 4) {
            const int tt = w >> 1;
            bf16x8 qf[4];
#pragma unroll
            for (int ks = 0; ks < 4; ++ks) qf[ks] = *(const LAS bf16x8*)(L + ML_Q + rowrd16(lane, tt, ks));
            const int t = 16 * tt + fr; const float ctt = fct[t];
#pragma unroll
            for (int si = 0; si < 2; ++si) { const int st = 2 * (w & 1) + si; f32x4 acc = (f32x4){0.f, 0.f, 0.f, 0.f};
                if (st <= tt)
#pragma unroll
                for (int ks = 0; ks < 4; ++ks) { const bf16x8 kf = *(const LAS bf16x8*)(L + ML_K + rowrd16(lane, st, ks)); acc = __builtin_amdgcn_mfma_f32_16x16x32_bf16(kf, qf[ks], acc, 0, 0, 0); }
                const int s0 = 16 * st + 4 * fq; float sv[4];
#pragma unroll
                for (int j = 0; j < 4; ++j) sv[j] = (s0 + j <= t) ? acc[j] * fast_exp(ctt + frs[s0 + j]) : 0.f;
                u32x2 o; o.x = cvt_pk_bf16(sv[0], sv[1]); o.y = cvt_pk_bf16(sv[2], sv[3]);
                *(LAS u32x2*)(L + ML_S + t * ML_SP + s0 * 2) = o; }
        }
        ML_BAR();
        if (c >= 4) {
            const int tt = w >> 1;
            f32x4 sv[5], qc[5];
#pragma unroll
            for (int i = 0; i < 5; ++i) { sv[i] = (f32x4){0.f, 0.f, 0.f, 0.f}; qc[i] = (f32x4){0.f, 0.f, 0.f, 0.f}; }
#pragma unroll
            for (int ks = 0; ks < 2; ++ks) { const bf16x8 a = *(const LAS bf16x8*)(L + ML_S + (fr + 16 * tt) * ML_SP + (32 * ks + 8 * fq) * 2);
#pragma unroll
                for (int i = 0; i < 4; ++i) { const bf16x8 bb = tr_frag(L + ML_V, lane, 4 * (w & 1) + i, ks); sv[i] = __builtin_amdgcn_mfma_f32_16x16x32_bf16(a, bb, sv[i], 0, 0, 0); }
                const bf16x8 bo = (bf16x8){(short)0x3F80, (short)0x3F80, (short)0x3F80, (short)0x3F80, (short)0x3F80, (short)0x3F80, (short)0x3F80, (short)0x3F80};
                sv[4] = __builtin_amdgcn_mfma_f32_16x16x32_bf16(a, bo, sv[4], 0, 0, 0); }
#pragma unroll
            for (int ks = 0; ks < 4; ++ks) { const bf16x8 a = *(const LAS bf16x8*)(L + ML_Q + rowrd16(lane, tt, ks));
#pragma unroll
                for (int i = 0; i < 5; ++i) { const int vt = (i < 4) ? 4 * (w & 1) + i : 8;
                    const bf16x8 bb = *(const LAS bf16x8*)(L + ML_CT + (fr + 16 * vt) * ML_CTP + (32 * ks + 8 * fq) * 2); qc[i] = __builtin_amdgcn_mfma_f32_16x16x32_bf16(a, bb, qc[i], 0, 0, 0); } }
#pragma unroll
            for (int j = 0; j < 4; ++j) { const int tl = 16 * tt + 4 * fq + j; const float wi_ = fwi[tl], em = fem[tl];
                const float den = sv[4][j] + wi_ * qc[4][j];
                const float inv = 1.0f / fmaxf(fabsf(den), em);
                LAS bf16_t* op = (LAS bf16_t*)(L + ML_VW) + tl * 128 + fr;
#pragma unroll
                for (int i = 0; i < 4; ++i) { const float h = (sv[i][j] + wi_ * qc[i][j]) * inv; op[16 * (4 * (w & 1) + i)] = (bf16_t)(cvt_pk_bf16(h, 0.f) & 0xffffu); } }
        }
        ML_BAR();
        if (c >= 4) {
#pragma unroll
            for (int i = 0; i < 2; ++i) { const int cid = F.tid + 512 * i, row = cid >> 4, ch = cid & 15; const size_t rr = (size_t)(ml_row(b, dir, p0 + row) - NCTX);
                *(gu32x4*)(HD + rr * D + hd * 256 + half * 128 + 8 * ch) = *(const LAS u32x4*)(L + ML_VW + row * 256 + 16 * ch); } }
#pragma unroll
        for (int v = 0; v < 9; ++v) { u32x2 o; o.x = cvt_pk_bf16(cst[v][0], cst[v][1]); o.y = cvt_pk_bf16(cst[v][2], cst[v][3]);
            *(LAS u32x2*)(L + ML_CT + (16 * v + fr) * ML_CTP + (16 * w + 4 * fq) * 2) = o; }
    }
    __syncthreads();
}

constexpr int N_PHASES = 19;
#ifndef PHASE_MASK
#define PHASE_MASK 0x7ffff
#endif
__global__ void __launch_bounds__(NTHR, 2) fwd(Args args) {
    extern __shared__ __attribute__((aligned(16))) unsigned char lds_raw[];
    if (threadIdx.x < 4) ((LAS unsigned*)((LAS unsigned char*)lds_raw + LDSCTL_OFF))[threadIdx.x] = 0u;
    __syncthreads();
#if !MK_PER_PHASE
    XcdBarrier bar = xcd_barrier_post((unsigned*)(args.ws + WS_CTL) + CW_BAR + args.li * 4096, (volatile LAS unsigned*)((LAS unsigned char*)lds_raw + LDSCTL_OFF));
#define SEAM(k) do { if (IN(k) && IN((k) + 1)) xcd_barrier(bar); } while (0)
#else
#define SEAM(k) do { } while (0)
#endif
    const int lo = args.ph_lo, hi = args.ph_hi;
#define IN(k) (((PHASE_MASK >> (k)) & 1) && lo <= (k) && (k) < hi)
#ifndef REPEAT_MASK
#define REPEAT_MASK 0
#endif
#ifndef REPEAT_N
#define REPEAT_N 1
#endif
#define REP(k) for (int rep_ = 0; rep_ < ((((REPEAT_MASK) >> (k)) & 1) ? (REPEAT_N) : 1); ++rep_, __syncthreads())
#define PHASE_FRAME() Frame F; gu8* ws; { gu8* w_ = (gu8*)args.ws; asm volatile("" : "+s"(w_)); int t_ = threadIdx.x; asm volatile("" : "+v"(t_)); ws = w_; \
        F.lds = (LAS unsigned char*)lds_raw; F.tid = t_; F.lane = t_ & 63; F.wave = __builtin_amdgcn_readfirstlane(t_ >> 6); F.bid = blockIdx.x; F.a = &args; F.out = (gf32*)args.out; F.ws = w_; }

    if (IN(0)) REP(0) { PHASE_FRAME(); (void)ws; phase_prologue(F); } SEAM(0);
    if (IN(1)) REP(1) { PHASE_FRAME(); (void)ws; phase_norm0(F); } SEAM(1);
    if (IN(2)) REP(2) { PHASE_FRAME(); pg8::DenseOrder S; S.init(ws + WS_H, ws + WS_CONVIN_T, NTOK, 3 * D, D, GRID, F.bid);
        EpiConvIn E{(gbf16*)(ws + WS_U), (gbf16*)(ws + WS_BM)};
        pg8::gemm_phase<EpiConvIn, pg8::DenseOrder, false>(F.lds, D, S, E); } SEAM(2);
    if (IN(3)) REP(3) { PHASE_FRAME(); (void)ws; phase_conv(F); } SEAM(3);
    if (IN(4)) REP(4) { PHASE_FRAME(); pg8::DenseOrder S; S.init(ws + WS_Z, ws + WS_CONVOUT_T, NTOK, D, D, GRID, F.bid);
        EpiResid E{INP(IN_CTX), INP(IN_X), (gf32*)(ws + WS_X), mod_ptr(F, 0, 0, 2), 0};
        pg8::gemm_phase<EpiResid, pg8::DenseOrder, false>(F.lds, D, S, E); } SEAM(4);
    if (IN(5)) REP(5) { PHASE_FRAME(); (void)ws; phase_router<false>(F, 0, 0, NTOK / GRID); } SEAM(5);
    if (IN(6)) REP(6) { PHASE_FRAME(); (void)ws; phase_scatter(F, 0, NTOK / GRID, NTOK); } SEAM(6);
    if (IN(7)) REP(7) { PHASE_FRAME(); ExpertOrder S{stage_units(F, (const gi32x4*)(ws + RT_UNITS1) + F.bid * MAXU1, MAXU1), (const gchar*)(ws + WS_H8), (const gchar*)(ws + WS_MOE0 + MOE_GU), (const gi32*)(ws + RT_TOKOF), D / 2, 1024};
        EpiSwiglu E{(gu8*)(ws + WS_ACT)};
        pg8::gemm_phase<EpiSwiglu, ExpertOrder, true, true>(F.lds, D / 2, S, E); } SEAM(7);
    if (IN(8)) REP(8) { PHASE_FRAME(); ExpertOrder S{stage_units(F, (const gi32x4*)(ws + RT_UNITS2) + F.bid * MAXU2, MAXU2), (const gchar*)(ws + WS_ACT), (const gchar*)(ws + WS_MOE0 + MOE_DN), nullptr, ED / 2, 2048};
        EpiDown E{(gu8*)(ws + WS_Y)};
        pg8::gemm_phase<EpiDown, ExpertOrder, false, true>(F.lds, ED / 2, S, E); } SEAM(8);
    if (IN(9)) REP(9) { PHASE_FRAME(); (void)ws; phase_combine0_gates(F); } SEAM(9);
    if (IN(10)) REP(10) { PHASE_FRAME(); pg8::DenseOrder S; S.init(ws + WS_H, ws + WS_MLIN_T, NTOK, 3 * D, D, GRID, F.bid);
        EpiMlstmIn E{(gbf16*)(ws + WS_Q), (gbf16*)(ws + WS_K), (gbf16*)(ws + WS_V), (gbf16*)(ws + WS_O)};
        pg8::gemm_phase<EpiMlstmIn, pg8::DenseOrder, false>(F.lds, D, S, E); } SEAM(10);
    if (IN(11)) REP(11) { PHASE_FRAME(); (void)ws; phase_mlstm(F); } SEAM(11);
    if (IN(12)) REP(12) { PHASE_FRAME(); (void)ws; phase_headnorm(F); } SEAM(12);
    if (IN(13)) REP(13) { PHASE_FRAME(); pg8::DenseOrder S; S.init(ws + WS_YIN, ws + WS_MLOUT_T, NLAT, D, D, GRID, F.bid);
        gf32* X = (gf32*)(ws + WS_X);
        EpiResidT<true> E{X, (const gf32*)(ws + WS_XB), X, mod_ptr(F, 1, 0, 2), NCTX};
        pg8::gemm_phase<EpiResidT<true>, pg8::DenseOrder, false>(F.lds, D, S, E); } SEAM(13);
    if (IN(14)) REP(14) { PHASE_FRAME(); (void)ws; phase_router<true>(F, 1, NCTX, NLAT / GRID); } SEAM(14);
    if (IN(15)) REP(15) { PHASE_FRAME(); (void)ws; phase_scatter(F, NCTX, NLAT / GRID, NLAT); } SEAM(15);
    if (IN(16)) REP(16) { PHASE_FRAME(); ExpertOrder S{stage_units(F, (const gi32x4*)(ws + RT_UNITS1) + F.bid * MAXU1, MAXU1), (const gchar*)(ws + WS_H8), (const gchar*)(ws + WS_MOE0 + MOE_STRIDE + MOE_GU), (const gi32*)(ws + RT_TOKOF), D / 2, 1024};
        EpiSwiglu E{(gu8*)(ws + WS_ACT)};
        pg8::gemm_phase<EpiSwiglu, ExpertOrder, true, true>(F.lds, D / 2, S, E); } SEAM(16);
    if (IN(17)) REP(17) { PHASE_FRAME(); ExpertOrder S{stage_units(F, (const gi32x4*)(ws + RT_UNITS2) + F.bid * MAXU2, MAXU2), (const gchar*)(ws + WS_ACT), (const gchar*)(ws + WS_MOE0 + MOE_STRIDE + MOE_DN), nullptr, ED / 2, 2048};
        EpiDown E{(gu8*)(ws + WS_Y)};
        pg8::gemm_phase<EpiDown, ExpertOrder, false, true>(F.lds, ED / 2, S, E); } SEAM(17);
    if (IN(18)) REP(18) { PHASE_FRAME(); (void)ws; phase_combine<1>(F); }
#undef IN
#undef SEAM
}

extern "C" void kernel_launch(void* const* d_in, const int* in_sizes, int n_in, void* d_out, int out_size, void* d_ws, size_t ws_size, hipStream_t stream) {
    static int ready = 0;
    if (ready == 0) {
        if (n_in != N_IN || out_size != NLAT * D || ws_size < WS_END) { fprintf(stderr, "kernel_launch: unexpected problem shape (n_in %d, out %d, ws %zu)\n", n_in, out_size, ws_size); ready = -1; return; }
        if (hipFuncSetAttribute((const void*)fwd, hipFuncAttributeMaxDynamicSharedMemorySize, LDS_BYTES) != hipSuccess) { fprintf(stderr, "kernel_launch: hipFuncSetAttribute failed\n"); ready = -1; return; }
        int per_cu = 0;
        if (hipOccupancyMaxActiveBlocksPerMultiprocessor(&per_cu, (const void*)fwd, NTHR, LDS_BYTES) != hipSuccess || per_cu < 1) fprintf(stderr, "kernel_launch: note: occupancy query reports %d blocks per CU\n", per_cu);
        (void)hipGetLastError();
        ready = 1;
    }
    if (ready < 0) return;
    (void)hipMemsetAsync((char*)d_ws + WS_CTL, 0, CTL_BYTES, stream);
    Args a{};
    for (int i = 0; i < N_IN; ++i) a.in[i] = (const float*)d_in[i];
    a.out = (float*)d_out; a.ws = (unsigned char*)d_ws; a.pad = 0;
#if MK_PER_PHASE
    for (int p = 0; p < N_PHASES; ++p) { a.ph_lo = p; a.ph_hi = p + 1; a.li = 0; hipLaunchKernelGGL(fwd, dim3(GRID), dim3(NTHR), LDS_BYTES, stream, a); }
#else
    a.ph_lo = 0; a.ph_hi = N_PHASES; a.li = 0;
    hipLaunchKernelGGL(fwd, dim3(GRID), dim3(NTHR), LDS_BYTES, stream, a);
#endif
}
```

```cpp
#include <hip/hip_runtime.h>
#include <stdint.h>
#include <stdio.h>

#ifndef STAGGER_TICKS
#define STAGGER_TICKS 0
#endif
#ifndef MK_PER_PHASE
#define MK_PER_PHASE 0
#endif

#define GAS __attribute__((address_space(1)))
#define LAS __attribute__((address_space(3)))
typedef unsigned short bf16_t;
typedef short bf16x8 __attribute__((ext_vector_type(8)));
typedef short s16x4 __attribute__((ext_vector_type(4)));
typedef float f32x4 __attribute__((ext_vector_type(4)));
typedef float f32x2 __attribute__((ext_vector_type(2)));
typedef unsigned u32x4 __attribute__((ext_vector_type(4)));
typedef unsigned u32x2 __attribute__((ext_vector_type(2)));
typedef int i32x4 __attribute__((ext_vector_type(4)));
typedef long i64x2 __attribute__((ext_vector_type(2)));
typedef int i32x8 __attribute__((ext_vector_type(8)));
typedef GAS float gf32; typedef GAS bf16_t gbf16; typedef GAS int gi32; typedef GAS unsigned char gu8; typedef GAS char gchar;
typedef GAS f32x4 gf32x4; typedef GAS u32x4 gu32x4; typedef GAS u32x2 gu32x2; typedef GAS bf16x8 gbf16x8; typedef GAS i32x4 gi32x4;

constexpr int D = 2048, NBATCH = 8, SEQ = 2048, CTXL = 256;
constexpr int NCTX = NBATCH * CTXL;
constexpr int NLAT = NBATCH * SEQ;
constexpr int NTOK = NCTX + NLAT;
constexpr int NE = 64, TOPK = 6, ED = 512;
constexpr int ADA_N = 6 * D;
constexpr int MLSTM_N = 6176, MLSTM_NP = 6400;
constexpr int NWAVES = 8, NTHR = 512, GRID = 256;
constexpr int SH_BASE = 126976;
constexpr int NSLOT = SH_BASE + NTOK;
constexpr float EPS = 1e-6f;

constexpr size_t MiB = 1u << 20, KiB = 1024;
constexpr size_t WS_CTL = 0, CTL_BYTES = 64 * KiB;
constexpr size_t WS_MOD = 1 * MiB;
constexpr size_t WS_RT = 2 * MiB;
constexpr size_t RT_HIST = WS_RT;
constexpr size_t RT_EINFO = WS_RT + 64 * KiB;
constexpr size_t RT_SELIDX = WS_RT + 128 * KiB;
constexpr size_t RT_SELGATE = WS_RT + 640 * KiB;
constexpr size_t RT_SELRANK = WS_RT + 1152 * KiB;
constexpr size_t RT_SLOTOF = WS_RT + 1664 * KiB;
constexpr size_t RT_TOKOF = WS_RT + 2176 * KiB;
constexpr size_t RT_GATEOF = WS_RT + 2816 * KiB;
constexpr size_t RT_UNITS1 = WS_RT + 3584 * KiB;
constexpr size_t RT_UNITS2 = WS_RT + 3840 * KiB;
constexpr int MAXU1 = 64, MAXU2 = 128;
constexpr size_t WS_GATES = 10 * MiB;
constexpr size_t WS_CONVIN_T = 13 * MiB;
constexpr size_t WS_CONVOUT_T = 37 * MiB;
constexpr size_t WS_MLIN_T = 45 * MiB;
constexpr size_t WS_MLOUT_T = 70 * MiB;
constexpr size_t WS_MOE0 = 78 * MiB, MOE_STRIDE = 392 * MiB;
constexpr size_t MOE_GU = 0, MOE_DN = 260 * MiB, MOE_RT = 390 * MiB;
constexpr size_t WS_H = 862 * MiB;
constexpr size_t WS_X = 934 * MiB;
constexpr size_t WS_ACT = 1078 * MiB;
constexpr size_t WS_Y = 1220 * MiB;
constexpr size_t WS_U = WS_Y, WS_BM = WS_Y + 72 * MiB, WS_Z = WS_Y + 144 * MiB;
constexpr size_t WS_Q = WS_Y, WS_K = WS_Y + 36 * MiB, WS_V = WS_Y + 72 * MiB, WS_O = WS_Y + 144 * MiB;
constexpr size_t WS_HF = WS_Y + 216 * MiB, WS_HB = WS_Y + 280 * MiB, WS_YIN = WS_Y + 344 * MiB;
constexpr size_t WS_H8 = 1788 * MiB;
constexpr size_t WS_XB = 1824 * MiB;
constexpr size_t WS_END = 1888 * MiB;
constexpr float DN_WSCALE = 32.0f, ACT_SCALE = 16.0f;
constexpr float GU_WSCALE = 64.0f;
constexpr int CW_BAR = 4096;
constexpr int CW_P0CTR = 64;

constexpr int RING_BYTES = 131072;
constexpr int LDSCTL_OFF = 150 * 1024;
constexpr int LDS_BYTES = 151 * 1024;

#define LDS_WAIT() asm volatile("s_waitcnt lgkmcnt(0)" ::: "memory")
#define VM_WAIT() asm volatile("s_waitcnt vmcnt(0)" ::: "memory")
__device__ __forceinline__ unsigned cvt_pk_bf16(float lo, float hi) { unsigned r; asm volatile("v_cvt_pk_bf16_f32 %0, %1, %2" : "=v"(r) : "v"(lo), "v"(hi)); return r; }
__device__ __forceinline__ unsigned pk4_fp8(const f32x4 v) { int w = 0;
    w = __builtin_amdgcn_cvt_pk_fp8_f32(__builtin_amdgcn_fmed3f(v[0], -448.0f, 448.0f), __builtin_amdgcn_fmed3f(v[1], -448.0f, 448.0f), w, false);
    w = __builtin_amdgcn_cvt_pk_fp8_f32(__builtin_amdgcn_fmed3f(v[2], -448.0f, 448.0f), __builtin_amdgcn_fmed3f(v[3], -448.0f, 448.0f), w, true); return (unsigned)w; }
__device__ __forceinline__ void acc4_fp8(f32x4& m, unsigned w) { const f32x2 lo = __builtin_amdgcn_cvt_pk_f32_fp8((int)w, false), hi = __builtin_amdgcn_cvt_pk_f32_fp8((int)w, true); m[0] += lo[0]; m[1] += lo[1]; m[2] += hi[0]; m[3] += hi[1]; }
__device__ __forceinline__ void acc4_fp8s(f32x4& m, unsigned w, float g) { const f32x2 lo = __builtin_amdgcn_cvt_pk_f32_fp8((int)w, false), hi = __builtin_amdgcn_cvt_pk_f32_fp8((int)w, true); m[0] += g * lo[0]; m[1] += g * lo[1]; m[2] += g * hi[0]; m[3] += g * hi[1]; }
__device__ __forceinline__ float bf_lo(unsigned u) { return __uint_as_float(u << 16); }
__device__ __forceinline__ float bf_hi(unsigned u) { return __uint_as_float(u & 0xffff0000u); }
template <int CTRL> __device__ __forceinline__ float dpp_mov(float v) { return __int_as_float(__builtin_amdgcn_update_dpp(0, __float_as_int(v), CTRL, 0xf, 0xf, true)); }
__device__ __forceinline__ float wave_sum(float v) {
    v += dpp_mov<0xB1>(v); v += dpp_mov<0x4E>(v); v += dpp_mov<0x141>(v); v += dpp_mov<0x140>(v);
    const int b = __float_as_int(v);
    return (__int_as_float(__builtin_amdgcn_readlane(b, 0)) + __int_as_float(__builtin_amdgcn_readlane(b, 16))) + (__int_as_float(__builtin_amdgcn_readlane(b, 32)) + __int_as_float(__builtin_amdgcn_readlane(b, 48)));
}
__device__ __forceinline__ float fast_exp(float x) { return __builtin_amdgcn_exp2f(x * 1.44269504088896341f); }
__device__ __forceinline__ float sigmoidf_(float x) { return 1.0f / (1.0f + fast_exp(-x)); }
__device__ __forceinline__ float siluf_(float x) { return x / (1.0f + fast_exp(-x)); }

#define XB_TMO      128
#define XB_XCNT(j)  (256  + 64 * (j))
#define XB_XSUB(j)  (1280 + 64 * (j))
#define XB_XGEN(j)  (2304 + 64 * (j))
#define XB_TOP      3328
#define XB_TOPGEN   3392
#define XCD_BAR_WORDS 3456
#define XB_SPIN_CAP (1u << 22)

__device__ __forceinline__ unsigned xb_ld(unsigned* p)              { return __hip_atomic_load(p, __ATOMIC_RELAXED, __HIP_MEMORY_SCOPE_AGENT); }
__device__ __forceinline__ unsigned xb_add(unsigned* p, unsigned v) { return __hip_atomic_fetch_add(p, v, __ATOMIC_RELAXED, __HIP_MEMORY_SCOPE_AGENT); }
__device__ __forceinline__ unsigned xb_xcc_id() { return (unsigned)__builtin_amdgcn_s_getreg((3 << 11) | 20) & 0xFu; }
#define XB_SPIN(cond, bar) do { unsigned _sp = 0; while (cond) { __builtin_amdgcn_s_sleep(1); \
    if ((++_sp & 255u) == 0u) { if (xb_ld(&(bar)[XB_TMO])) break; if (_sp > XB_SPIN_CAP) { atomicAdd(&(bar)[XB_TMO], 1u); break; } } } } while (0)

struct XcdBarrier { unsigned* bar; unsigned x; volatile LAS unsigned* st; };

__device__ __forceinline__ XcdBarrier xcd_barrier_post(unsigned* bar, volatile LAS unsigned* st) {
    XcdBarrier b; b.bar = bar; b.x = xb_xcc_id(); b.st = st;
    if (threadIdx.x == 0) (void)xb_add(&bar[XB_XCNT(b.x)], 1u);
    return b;
}
__device__ __forceinline__ void xcd_barrier_complete(unsigned* bar, unsigned x, unsigned& nloc, unsigned& nx) {
    const unsigned G = gridDim.x * gridDim.y * gridDim.z;
    unsigned sum, cnt, mine, sp = 0u;
    for (;;) {
        sum = 0u; cnt = 0u; mine = 0u;
#pragma unroll
        for (unsigned j = 0; j < 16; ++j) { const unsigned c = xb_ld(&bar[XB_XCNT(j)]); sum += c; cnt += (c > 0u) ? 1u : 0u; mine = (j == x) ? c : mine; }
        if (sum == G) break;
        __builtin_amdgcn_s_sleep(1);
        if ((++sp & 255u) == 0u) { if (xb_ld(&bar[XB_TMO])) break; if (sp > XB_SPIN_CAP) { atomicAdd(&bar[XB_TMO], 1u); break; } }
    }
    nloc = mine > 0u ? mine : 1u; nx = cnt > 0u ? cnt : 1u;
}
__device__ __forceinline__ void xcd_barrier(const XcdBarrier& b) {
    asm volatile("s_waitcnt vmcnt(0)" ::: "memory");
    __syncthreads();
    if (threadIdx.x == 0) {
        unsigned* bar = b.bar;
        __builtin_amdgcn_s_waitcnt(0);
        unsigned nloc = b.st[0], nx = b.st[1];
        if (nloc == 0u) { xcd_barrier_complete(bar, b.x, nloc, nx); b.st[0] = nloc; b.st[1] = nx; }
        const unsigned old = xb_add(&bar[XB_XSUB(b.x)], 1u);
        const unsigned gen = old / nloc;
        if (old + 1u == (gen + 1u) * nloc) {
            __builtin_amdgcn_fence(__ATOMIC_RELEASE, "agent");
            asm volatile("s_waitcnt vmcnt(0)" ::: "memory");
            const unsigned og = xb_add(&bar[XB_TOP], 1u);
            const unsigned tg = og / nx;
            if (og + 1u == (tg + 1u) * nx) xb_add(&bar[XB_TOPGEN], 1u);
            else XB_SPIN(xb_ld(&bar[XB_TOPGEN]) == tg, bar);
            __builtin_amdgcn_fence(__ATOMIC_ACQUIRE, "agent");
            xb_add(&bar[XB_XGEN(b.x)], 1u);
            asm volatile("s_waitcnt vmcnt(0)" ::: "memory");
        } else {
            XB_SPIN(xb_ld(&bar[XB_XGEN(b.x)]) == gen, bar);
            __builtin_amdgcn_fence(__ATOMIC_ACQUIRE, "agent");
            asm volatile("s_waitcnt vmcnt(0)" ::: "memory");
        }
    }
    __syncthreads();
}

namespace pg8 {
constexpr int BM = 256, BK = 64, HALF = 128, HTB = HALF * BK * 2, STAGE_BYTES = 8 * HTB, NXCD = 8, WGM = 8;
__host__ __device__ __forceinline__ int lds_byte(int r, int c) { const int st = (r >> 4) * 2 + (c >> 5), rr = r & 15, cc = c & 31, ob = rr * 64 + cc * 2; return st * 1024 + (ob ^ (((ob >> 9) & 1) << 5)); }
__host__ __device__ __forceinline__ void stage_rc(int b, int& R, int& C) { const int st = b / 1024, sb = b % 1024, swz = sb ^ (((sb >> 9) & 1) << 5); R = (st >> 1) * 16 + swz / 64; C = (st & 1) * 32 + (swz % 64) / 2; }
__host__ __device__ __forceinline__ int perm32(int rho) { const int n = rho >> 4, i = rho & 15; return 8 * (i >> 2) + 4 * n + (i & 3); }

struct Unit { int pm, pn, e, row0; };

struct DenseOrder {
    int nM, nN, nwg, G, c; const gchar* A; const gchar* Bt; size_t tstep;
    __device__ void init(const GAS void* A_, const GAS void* Bt_, int M, int N, int K, int G_, int c_) { A = (const gchar*)A_; Bt = (const gchar*)Bt_; nM = M / BM; nN = N / BM; nwg = nM * nN; G = G_; c = c_; tstep = (size_t)BM * K * 2; }
    __device__ __forceinline__ bool next(int i, Unit& u) const {
        const long L = (long)i * G + c; if (L >= nwg) return false;
        int wgid = (int)L; { const int q = nwg / NXCD, r = nwg % NXCD, xcd = wgid % NXCD, off = wgid / NXCD; wgid = (xcd < r ? xcd * (q + 1) : r * (q + 1) + (xcd - r) * q) + off; }
        const int nig = WGM * nN, gid = wgid / nig, fm = gid * WGM, gsz = (nM - fm) < WGM ? (nM - fm) : WGM;
        u.pm = fm + ((wgid % nig) % gsz); u.pn = (wgid % nig) / gsz; u.e = 0; u.row0 = u.pm * BM; return true;
    }
    __device__ __forceinline__ const gchar* a_base(const Unit& u) const { return A + (size_t)u.pm * tstep; }
    __device__ __forceinline__ const gchar* b_base(const Unit& u) const { return Bt + (size_t)u.pn * tstep; }
    __device__ __forceinline__ int gather_row(const Unit&, int) const { return 0; }
};

template <class Epi, class Sched, bool GATHER, bool FP8 = false>
__device__ __forceinline__ void gemm_phase(LAS unsigned char* lds, const int K, const Sched& S, const Epi& E) {
    const int tid = threadIdx.x, wid = __builtin_amdgcn_readfirstlane(tid >> 6), lane = tid & 63, wr = wid >> 2, wc = wid & 3, fr = lane & 15, fq = lane >> 4;
    const int nt = K / BK;
    int Rst[2], Cst[2];
    unsigned voffA[2], voffB[2];
#pragma unroll
    for (int i = 0; i < 2; ++i) { int R, C; stage_rc(tid * 16 + i * 8192, R, C); const int Rb = Epi::PERM ? ((R & ~31) + perm32(R & 31)) : R;
        Rst[i] = R; Cst[i] = C; voffA[i] = (unsigned)(R * K + C) * 2u; voffB[i] = (unsigned)(Rb * K + C) * 2u; }
    const size_t kstep = (size_t)(BK * 2);
    const size_t hstep = (size_t)HALF * K * 2;
    const unsigned ldsw = (unsigned)wid * 1024u;
    const int aoff = lds_byte(wr * 64 + fr, fq * 8), boff = lds_byte(wc * 32 + fr, fq * 8);
#define PG8_SA(b, h) (((b) * 2 + (h)) * HTB)
#define PG8_SB(b, h) ((4 + (b) * 2 + (h)) * HTB)
#define PG8_STAGE(bufoff, gbase, voff) do { _Pragma("unroll") for (int _i = 0; _i < 2; ++_i) \
        __builtin_amdgcn_global_load_lds((const GAS unsigned*)((const gchar*)(gbase) + (voff)[_i]), (LAS unsigned*)(lds + (bufoff) + ldsw + _i * 8192), 16, 0, 0); } while (0)
#define PG8_LDA(dst, b, h) do { _Pragma("unroll") for (int m = 0; m < 4; ++m) _Pragma("unroll") for (int k = 0; k < 2; ++k) dst[m][k] = *(const LAS bf16x8*)(lds + PG8_SA(b, h) + aoff + m * 2048 + k * 1024); } while (0)
#define PG8_LDB(dst, b, h) do { _Pragma("unroll") for (int n = 0; n < 2; ++n) _Pragma("unroll") for (int k = 0; k < 2; ++k) dst[n][k] = *(const LAS bf16x8*)(lds + PG8_SB(b, h) + boff + n * 2048 + k * 1024); } while (0)
#define PG8_CAT(x) __builtin_shufflevector(__builtin_bit_cast(i32x4, (x)[0]), __builtin_bit_cast(i32x4, (x)[1]), 0, 1, 2, 3, 4, 5, 6, 7)
#define PG8_MMA(ai, bj, At, Bt) do { __builtin_amdgcn_s_setprio(1); \
        if constexpr (FP8) { i32x8 _a8[4], _b8[2]; _Pragma("unroll") for (int m = 0; m < 4; ++m) _a8[m] = PG8_CAT(At[m]); _Pragma("unroll") for (int n = 0; n < 2; ++n) _b8[n] = PG8_CAT(Bt[n]); \
            _Pragma("unroll") for (int m = 0; m < 4; ++m) _Pragma("unroll") for (int n = 0; n < 2; ++n) \
                asm volatile("v_mfma_scale_f32_16x16x128_f8f6f4 %0, %1, %2, %0, %3, %4 op_sel_hi:[0,0,0]" : "+v"(acc[ai][bj][m][n]) : "v"(_b8[n]), "v"(_a8[m]), "v"(mx_sc[bj]), "v"(mx_one)); } \
        else { _Pragma("unroll") for (int m = 0; m < 4; ++m) _Pragma("unroll") for (int n = 0; n < 2; ++n) _Pragma("unroll") for (int k = 0; k < 2; ++k) \
            acc[ai][bj][m][n] = __builtin_amdgcn_mfma_f32_16x16x32_bf16(Bt[n][k], At[m][k], acc[ai][bj][m][n], 0, 0, 0); } __builtin_amdgcn_s_setprio(0); } while (0)
#define PG8_MMAZ(ai, bj, At, Bt) do { __builtin_amdgcn_s_setprio(1); \
        if constexpr (FP8) { i32x8 _a8[4], _b8[2]; _Pragma("unroll") for (int m = 0; m < 4; ++m) _a8[m] = PG8_CAT(At[m]); _Pragma("unroll") for (int n = 0; n < 2; ++n) _b8[n] = PG8_CAT(Bt[n]); \
            _Pragma("unroll") for (int m = 0; m < 4; ++m) _Pragma("unroll") for (int n = 0; n < 2; ++n) \
                asm volatile("v_mfma_scale_f32_16x16x128_f8f6f4 %0, %1, %2, 0, %3, %4 op_sel_hi:[0,0,0]" : "=&v"(acc[ai][bj][m][n]) : "v"(_b8[n]), "v"(_a8[m]), "v"(mx_sc[bj]), "v"(mx_one)); } \
        else { _Pragma("unroll") for (int m = 0; m < 4; ++m) _Pragma("unroll") for (int n = 0; n < 2; ++n) { \
            acc[ai][bj][m][n] = __builtin_amdgcn_mfma_f32_16x16x32_bf16(Bt[n][0], At[m][0], (f32x4){0.f, 0.f, 0.f, 0.f}, 0, 0, 0); \
            acc[ai][bj][m][n] = __builtin_amdgcn_mfma_f32_16x16x32_bf16(Bt[n][1], At[m][1], acc[ai][bj][m][n], 0, 0, 0); } } __builtin_amdgcn_s_setprio(0); } while (0)
#define PG8_MMA1(ai, bj, At, Bt) do { if (FP8 && t == 0) PG8_MMAZ(ai, bj, At, Bt); else PG8_MMA(ai, bj, At, Bt); } while (0)
#define PG8_WAIT_V(n) asm volatile("s_waitcnt vmcnt(" #n ")" ::: "memory")
#define PG8_WAIT_L(n) asm volatile("s_waitcnt lgkmcnt(" #n ")" ::: "memory")
#define PG8_BAR __builtin_amdgcn_s_barrier()
#define PG8_SCHED __builtin_amdgcn_sched_barrier(0)
    Unit cur, nxt; int ui = 0;
    if (!S.next(0, cur)) return;
#if STAGGER_TICKS
    {
      const unsigned long long t0 = __builtin_amdgcn_s_memrealtime(); const unsigned long long dt = (unsigned long long)((blockIdx.x >> 3) & 3) * STAGGER_TICKS;
      while (__builtin_amdgcn_s_memrealtime() - t0 < dt) __builtin_amdgcn_s_sleep(8); }
#endif
    f32x4 acc[2][2][4][2];
#pragma unroll
    for (int a = 0; a < 2; ++a)
#pragma unroll
        for (int b = 0; b < 2; ++b)
#pragma unroll
            for (int m = 0; m < 4; ++m)
#pragma unroll
                for (int n = 0; n < 2; ++n) acc[a][b][m][n] = (f32x4){0.f, 0.f, 0.f, 0.f};
    bf16x8 At[4][2], B0[2][2], B1[2][2]; int mx_one = 0x7f7f7f7f; asm volatile("" : "+v"(mx_one));
    int mx_sc[2] = {0x7f7f7f7f, 0x7f7f7f7f};
    if constexpr (FP8) { mx_sc[0] = 0x01010101 * (127 + Epi::MXE0); mx_sc[1] = 0x01010101 * (127 + Epi::MXE1); asm volatile("" : "+v"(mx_sc[0]), "+v"(mx_sc[1])); }
    const gchar* cA = S.a_base(cur); const gchar* cB = S.b_base(cur);
    unsigned vc0[2], vc1[2], vn0[2], vn1[2];
    if constexpr (GATHER) {
#pragma unroll
        for (int i = 0; i < 2; ++i) { vc0[i] = ((unsigned)S.gather_row(cur, Rst[i]) * (unsigned)K + (unsigned)Cst[i]) * 2u; vc1[i] = ((unsigned)S.gather_row(cur, HALF + Rst[i]) * (unsigned)K + (unsigned)Cst[i]) * 2u; vn0[i] = vc0[i]; vn1[i] = vc1[i]; }
    } else {
#pragma unroll
        for (int i = 0; i < 2; ++i) { vc0[i] = voffA[i]; vc1[i] = voffA[i] + (unsigned)hstep; vn0[i] = vc0[i]; vn1[i] = vc1[i]; }
    }
    PG8_STAGE(PG8_SB(0, 0), cB, voffB); PG8_STAGE(PG8_SA(0, 0), cA, vc0); PG8_STAGE(PG8_SB(0, 1), cB + hstep, voffB); PG8_STAGE(PG8_SA(0, 1), cA, vc1);
    if (wr == 1) PG8_BAR;
    PG8_WAIT_V(4); PG8_BAR;
    PG8_STAGE(PG8_SB(1, 0), cB + kstep, voffB); PG8_STAGE(PG8_SA(1, 0), cA + kstep, vc0); PG8_STAGE(PG8_SB(1, 1), cB + hstep + kstep, voffB);
    PG8_WAIT_V(6); PG8_BAR;
    for (;;) {
        const bool has_next = S.next(ui + 1, nxt);
        const gchar* nA = has_next ? S.a_base(nxt) : cA; const gchar* nB = has_next ? S.b_base(nxt) : cB;
        for (int t = 0; t < nt; t += 2) {
            const bool last = (t == nt - 2);
            const gchar* a1 = cA + (size_t)(t + 1) * kstep;
            const gchar* a2 = last ? nA : cA + (size_t)(t + 2) * kstep; const gchar* b2 = last ? nB : cB + (size_t)(t + 2) * kstep;
            const gchar* a3 = a2 + kstep; const gchar* b3 = b2 + kstep;
            unsigned s0[2], s1[2];
            if constexpr (GATHER) {
                if (last && has_next) {
#pragma unroll
                    for (int i = 0; i < 2; ++i) { vn0[i] = ((unsigned)S.gather_row(nxt, Rst[i]) * (unsigned)K + (unsigned)Cst[i]) * 2u; vn1[i] = ((unsigned)S.gather_row(nxt, HALF + Rst[i]) * (unsigned)K + (unsigned)Cst[i]) * 2u; }
                }
#pragma unroll
                for (int i = 0; i < 2; ++i) { s0[i] = last ? vn0[i] : vc0[i]; s1[i] = last ? vn1[i] : vc1[i]; }
            } else {
#pragma unroll
                for (int i = 0; i < 2; ++i) { s0[i] = vc0[i]; s1[i] = vc1[i]; }
            }
            PG8_LDB(B0, 0, 0); PG8_SCHED; PG8_LDA(At, 0, 0); PG8_STAGE(PG8_SA(1, 1), a1, vc1);
            PG8_WAIT_L(8); PG8_BAR; PG8_WAIT_L(0); PG8_MMA1(0, 0, At, B0); PG8_BAR; PG8_SCHED;
            PG8_LDB(B1, 0, 1); PG8_STAGE(PG8_SB(0, 0), b2, voffB);
            PG8_BAR; PG8_WAIT_L(0); PG8_MMA1(0, 1, At, B1); PG8_BAR;
            PG8_LDA(At, 0, 1); PG8_STAGE(PG8_SA(0, 0), a2, s0);
            PG8_BAR; PG8_WAIT_L(0); PG8_MMA1(1, 0, At, B0); PG8_BAR; PG8_SCHED;
            PG8_STAGE(PG8_SB(0, 1), b2 + hstep, voffB);
            PG8_WAIT_V(6); PG8_BAR; PG8_MMA1(1, 1, At, B1); PG8_BAR;
            PG8_LDB(B0, 1, 0); PG8_SCHED; PG8_LDA(At, 1, 0); PG8_STAGE(PG8_SA(0, 1), a2, s1);
            PG8_WAIT_L(8); PG8_BAR; PG8_WAIT_L(0); PG8_MMA(0, 0, At, B0); PG8_BAR; PG8_SCHED;
            PG8_LDB(B1, 1, 1); PG8_STAGE(PG8_SB(1, 0), b3, voffB);
            PG8_BAR; PG8_WAIT_L(0); PG8_MMA(0, 1, At, B1); PG8_BAR;
            PG8_LDA(At, 1, 1); PG8_STAGE(PG8_SA(1, 0), a3, s0);
            PG8_BAR; PG8_WAIT_L(0); PG8_MMA(1, 0, At, B0); PG8_BAR; PG8_SCHED;
            PG8_STAGE(PG8_SB(1, 1), b3 + hstep, voffB);
            PG8_WAIT_V(6); PG8_BAR; PG8_MMA(1, 1, At, B1); PG8_BAR;
        }
        if constexpr (FP8) {
            asm volatile("s_nop 15\n\ts_nop 3" : "+v"(acc[1][1][0][0]), "+v"(acc[1][1][0][1]), "+v"(acc[1][1][1][0]), "+v"(acc[1][1][1][1]), "+v"(acc[1][1][2][0]), "+v"(acc[1][1][2][1]), "+v"(acc[1][1][3][0]), "+v"(acc[1][1][3][1])); }
        E(acc, cur, wr, wc, fr, fq);
        if (!has_next) break;
        if constexpr (!FP8) {
#pragma unroll
            for (int a = 0; a < 2; ++a)
#pragma unroll
                for (int b = 0; b < 2; ++b)
#pragma unroll
                    for (int m = 0; m < 4; ++m)
#pragma unroll
                        for (int n = 0; n < 2; ++n) acc[a][b][m][n] = (f32x4){0.f, 0.f, 0.f, 0.f}; }
        cur = nxt; cA = nA; cB = nB; ++ui;
#pragma unroll
        for (int i = 0; i < 2; ++i) { vc0[i] = vn0[i]; vc1[i] = vn1[i]; }
    }
    PG8_WAIT_V(0);
    if (wr == 0) PG8_BAR;
    PG8_BAR;
#undef PG8_SA
#undef PG8_SB
#undef PG8_STAGE
#undef PG8_LDA
#undef PG8_LDB
#undef PG8_MMA
#undef PG8_MMAZ
#undef PG8_MMA1
#undef PG8_CAT
#undef PG8_WAIT_V
#undef PG8_WAIT_L
#undef PG8_BAR
#undef PG8_SCHED
}
}
using pg8::Unit;

enum { IN_X = 0, IN_C, IN_CTX, IN_CCTX, IN_ADAW, IN_ADAB, IN_NMIXW, IN_NFFNW, IN_CONVIN, IN_CONVDW, IN_CONVOUT, IN_MLIN, IN_MLGB, IN_MLNW, IN_MLOUT,
       IN_RW, IN_RB, IN_EG, IN_EU, IN_ED, IN_SG, IN_SU, IN_SD, IN_FNW, N_IN };
struct Args { const float* in[N_IN]; float* out; unsigned char* ws; int ph_lo, ph_hi, li, pad; };

#define INP(i) ((const gf32*)F.a->in[i])
struct Frame {
    LAS unsigned char* lds;
    int tid, lane, wave, bid;
    const Args* a; gf32* out; gu8* ws;
};

__device__ __forceinline__ const gf32* mod_ptr(const Frame& F, int layer, int mr, int chunk) { return (const gf32*)(F.ws + WS_MOD) + ((size_t)(layer * 9 + mr) * ADA_N + (size_t)chunk * D); }
__device__ __forceinline__ int mod_row(int r) { return r < NCTX ? 8 : ((r - NCTX) >> 11); }

struct EpiConvIn {
    static constexpr bool PERM = true; static constexpr int MXE0 = 0, MXE1 = 0;
    gbf16* U; gbf16* BMt;
    __device__ __forceinline__ void operator()(const f32x4 (&acc)[2][2][4][2], const Unit& u, int wr, int wc, int fr, int fq) const {
        const int row0 = u.pm * 256 + wr * 64 + fr;
        if (u.pn < 16) {
            const int col = u.pn * 128 + wc * 32 + 8 * fq;
#pragma unroll
            for (int ai = 0; ai < 2; ++ai)
#pragma unroll
                for (int m = 0; m < 4; ++m) {
                    const f32x4 a0 = acc[ai][0][m][0] * acc[ai][1][m][0], a1 = acc[ai][0][m][1] * acc[ai][1][m][1];
                    u32x4 w; w.x = cvt_pk_bf16(a0[0], a0[1]); w.y = cvt_pk_bf16(a0[2], a0[3]); w.z = cvt_pk_bf16(a1[0], a1[1]); w.w = cvt_pk_bf16(a1[2], a1[3]);
                    *(gu32x4*)(U + (size_t)(row0 + ai * 128 + m * 16) * D + col) = w; }
        } else {
            const int col = (u.pn - 16) * 256 + wc * 32 + 8 * fq;
#pragma unroll
            for (int ai = 0; ai < 2; ++ai)
#pragma unroll
                for (int m = 0; m < 4; ++m)
#pragma unroll
                    for (int bj = 0; bj < 2; ++bj) {
                        const f32x4 a0 = acc[ai][bj][m][0], a1 = acc[ai][bj][m][1];
                        u32x4 w; w.x = cvt_pk_bf16(a0[0], a0[1]); w.y = cvt_pk_bf16(a0[2], a0[3]); w.z = cvt_pk_bf16(a1[0], a1[1]); w.w = cvt_pk_bf16(a1[2], a1[3]);
                        *(gu32x4*)(BMt + (size_t)(row0 + ai * 128 + m * 16) * D + col + bj * 128) = w; }
        }
    }
};
template <bool BB, bool OB = false>
struct EpiResidT {
    static constexpr bool PERM = false; static constexpr int MXE0 = 0, MXE1 = 0;
    const gf32* base_ctx; const gf32* base_lat; gf32* X; const gf32* gmod; int row_off;
    __device__ __forceinline__ void operator()(const f32x4 (&acc)[2][2][4][2], const Unit& u, int wr, int wc, int fr, int fq) const {
        const int R0 = row_off + u.pm * 256;
        const gf32* base = (R0 < NCTX) ? base_ctx + (size_t)R0 * D : base_lat + (size_t)(R0 - NCTX) * D;
        const gf32* g = gmod + (size_t)mod_row(R0) * ADA_N;
        gf32* o = X + (size_t)R0 * D;
        const int rl0 = wr * 64 + fr, col0 = u.pn * 256 + wc * 32 + 4 * fq;
        f32x4 gv[2][2];
#pragma unroll
        for (int bj = 0; bj < 2; ++bj)
#pragma unroll
            for (int n = 0; n < 2; ++n) gv[bj][n] = *(const gf32x4*)(g + col0 + bj * 128 + n * 16);
#pragma unroll
        for (int ah = 0; ah < 4; ++ah) { const int ai = ah >> 1, m0 = (ah & 1) * 2;
            f32x4 bv[2][2][2];
#pragma unroll
            for (int mm = 0; mm < 2; ++mm) { const size_t ro = (size_t)(rl0 + ai * 128 + (m0 + mm) * 16) * D + col0;
#pragma unroll
                for (int bj = 0; bj < 2; ++bj)
#pragma unroll
                    for (int n = 0; n < 2; ++n) {
                        if constexpr (BB) { const u32x2 w = *(const gu32x2*)((const gbf16*)base_lat + (size_t)(R0 - NCTX) * D + ro + bj * 128 + n * 16); bv[mm][bj][n] = (f32x4){bf_lo(w.x), bf_hi(w.x), bf_lo(w.y), bf_hi(w.y)}; }
                        else bv[mm][bj][n] = *(const gf32x4*)(base + ro + bj * 128 + n * 16); } }
#pragma unroll
            for (int mm = 0; mm < 2; ++mm) { const size_t ro = (size_t)(rl0 + ai * 128 + (m0 + mm) * 16) * D + col0;
#pragma unroll
                for (int bj = 0; bj < 2; ++bj)
#pragma unroll
                    for (int n = 0; n < 2; ++n) { const f32x4 y = bv[mm][bj][n] + gv[bj][n] * acc[ai][bj][m0 + mm][n];
                        if constexpr (BB) { u32x2 w; w.x = cvt_pk_bf16(y[0], y[1]); w.y = cvt_pk_bf16(y[2], y[3]); *(gu32x2*)((gbf16*)base_lat + (size_t)(R0 - NCTX) * D + ro + bj * 128 + n * 16) = w; }
                        else if constexpr (OB) { u32x2 w; w.x = cvt_pk_bf16(y[0], y[1]); w.y = cvt_pk_bf16(y[2], y[3]); *(gu32x2*)((gbf16*)X + (size_t)R0 * D + ro + bj * 128 + n * 16) = w; }
                        else *(gf32x4*)(o + ro + bj * 128 + n * 16) = y; } } }
    }
};
using EpiResid = EpiResidT<false>;
__device__ __forceinline__ float softcap_gate(float g) {
    const float e = fast_exp(-2.0f * g * (1.0f / 15.0f)); return 15.0f * (1.0f - e) / (1.0f + e);
}
__device__ __forceinline__ float log_sigmoid_(float g) { return fminf(g, 0.0f) - __logf(1.0f + fast_exp(-fabsf(g))); }
struct EpiMlstmIn {
    static constexpr bool PERM = true; static constexpr int MXE0 = 0, MXE1 = 0;
    gbf16 *Q, *Kb, *V, *O;
    __device__ __forceinline__ void operator()(const f32x4 (&acc)[2][2][4][2], const Unit& u, int wr, int wc, int fr, int fq) const {
        const int row0 = u.pm * 256 + wr * 64 + fr;
        {
            gbf16* dst; int ld, ct; float sc = 1.0f;
            if (u.pn < 4) { dst = Q; ld = 1024; ct = u.pn; } else if (u.pn < 8) { dst = Kb; ld = 1024; ct = u.pn - 4; sc = 0.08838834764831845f; }
            else if (u.pn < 16) { dst = V; ld = 2048; ct = u.pn - 8; } else { dst = O; ld = 2048; ct = u.pn - 16; }
            const int col = ct * 256 + wc * 32 + 8 * fq;
#pragma unroll
            for (int ai = 0; ai < 2; ++ai)
#pragma unroll
                for (int m = 0; m < 4; ++m)
#pragma unroll
                    for (int bj = 0; bj < 2; ++bj) {
                        const f32x4 a0 = acc[ai][bj][m][0] * sc, a1 = acc[ai][bj][m][1] * sc;
                        u32x4 w; w.x = cvt_pk_bf16(a0[0], a0[1]); w.y = cvt_pk_bf16(a0[2], a0[3]); w.z = cvt_pk_bf16(a1[0], a1[1]); w.w = cvt_pk_bf16(a1[2], a1[3]);
                        *(gu32x4*)(dst + (size_t)(row0 + ai * 128 + m * 16) * ld + col + bj * 128) = w; }
        }
    }
};
struct EpiSwiglu {
    static constexpr bool PERM = true;
    static constexpr int MXE0 = -6, MXE1 = -2;
    gu8* ACT;
    __device__ __forceinline__ void operator()(const f32x4 (&acc)[2][2][4][2], const Unit& u, int wr, int wc, int fr, int fq) const {
        const int row0 = u.row0 + wr * 64 + fr, col = u.pn * 128 + wc * 32 + 8 * fq;
#pragma unroll
        for (int ai = 0; ai < 2; ++ai)
#pragma unroll
            for (int m = 0; m < 4; ++m) {
                f32x4 a0, a1;
#pragma unroll
                for (int j = 0; j < 4; ++j) { a0[j] = siluf_(acc[ai][0][m][0][j]) * acc[ai][1][m][0][j]; a1[j] = siluf_(acc[ai][0][m][1][j]) * acc[ai][1][m][1][j]; }
                u32x2 w; w.x = pk4_fp8(a0); w.y = pk4_fp8(a1);
                *(gu32x2*)(ACT + (size_t)(row0 + ai * 128 + m * 16) * ED + col) = w; }
    }
};
struct EpiDown {
    static constexpr bool PERM = true;
    static constexpr int MXE0 = -9, MXE1 = -9;
    gu8* Y;
    __device__ __forceinline__ void operator()(const f32x4 (&acc)[2][2][4][2], const Unit& u, int wr, int wc, int fr, int fq) const {
        const int row0 = u.row0 + wr * 64 + fr, col = u.pn * 256 + wc * 64 + 16 * fq;
#pragma unroll
        for (int ai = 0; ai < 2; ++ai)
#pragma unroll
            for (int m = 0; m < 4; ++m) { const int slot = row0 + ai * 128 + m * 16;
                u32x4 w; w.x = pk4_fp8(acc[ai][0][m][0]); w.y = pk4_fp8(acc[ai][0][m][1]); w.z = pk4_fp8(acc[ai][1][m][0]); w.w = pk4_fp8(acc[ai][1][m][1]);
                *(gu32x4*)(Y + (size_t)slot * D + col) = w; }
    }
};

constexpr int LDS_UNITS = RING_BYTES;
struct ExpertOrder {
    const LAS i32x4* units; const gchar* A; const gchar* Bt; const gi32* tok_of; int K, erows;
    __device__ __forceinline__ bool next(int i, Unit& u) const {
        const i32x4 d = units[i];
        u.e = __builtin_amdgcn_readfirstlane(d.x); u.pm = __builtin_amdgcn_readfirstlane(d.y); u.pn = __builtin_amdgcn_readfirstlane(d.z); u.row0 = __builtin_amdgcn_readfirstlane(d.w);
        return u.e >= 0;
    }
    __device__ __forceinline__ const gchar* a_base(const Unit& u) const { return tok_of ? A : A + (size_t)u.row0 * K * 2; }
    __device__ __forceinline__ const gchar* b_base(const Unit& u) const { return Bt + ((size_t)u.e * erows + (size_t)u.pn * 256) * K * 2; }
    __device__ __forceinline__ int gather_row(const Unit& u, int r) const { return tok_of[u.row0 + r]; }
};
__device__ __forceinline__ const LAS i32x4* stage_units(Frame& F, const gi32x4* g, int n) {
    LAS i32x4* l = (LAS i32x4*)(F.lds + LDS_UNITS);
    if (F.tid < n) l[F.tid] = g[F.tid];
    __syncthreads();
    return l;
}
__device__ __forceinline__ bool class_unit(const LAS int* tot, const LAS int* pst, int x, int q, int npn, int shs, int shn, i32x4& d) {
#pragma unroll 1
    for (int kk = 0; kk < 8; ++kk) { const int e = x + 8 * kk; const int n = ((tot[e] + 255) >> 8) * npn;
        if (q < n) { const int mt = q / npn; d = (i32x4){e, mt, q - mt * npn, pst[e] + 256 * mt}; return true; } q -= n; }
    if (q < shn * npn) { const int mt = shs + q / npn; d = (i32x4){64, mt, q % npn, SH_BASE + 256 * mt}; return true; }
    d = (i32x4){-1, 0, 0, 0}; return false;
}
__device__ __forceinline__ void shared_share(const LAS int* rt, int S, int x, int& shs, int& shn) {
    int R = 0;
#pragma unroll
    for (int y = 0; y < 8; ++y) R += rt[y];
    int lv = (R + S + 7) >> 3;
#pragma unroll 1
    for (;;) { int cap = 0;
#pragma unroll
        for (int y = 0; y < 8; ++y) cap += max(0, lv - rt[y]);
        if (cap >= S) break; ++lv; }
    int left = S; shs = 0; shn = 0;
#pragma unroll
    for (int y = 0; y < 8; ++y) { const int n = min(max(0, lv - rt[y]), left); if (y == x) { shs = S - left; shn = n; } left -= n; }
}

__device__ __forceinline__ int down_row(int c) { return (c & ~255) + 128 * ((c >> 3) & 1) + 32 * ((c >> 6) & 3) + 8 * ((c >> 4) & 3) + (c & 7); }
__device__ __forceinline__ void tr_item(const gf32* __restrict__ W, int ldw, int K, gbf16* WT, int drow, int k0, int n0src, LAS float* scr, int lane, bool dperm = false, float fp8 = 0.f) {
    float tv[32];
    const gf32* wp = W + (size_t)(k0 + (lane >> 5)) * ldw + n0src + (lane & 31);
#pragma unroll
    for (int i = 0; i < 32; ++i) tv[i] = __builtin_nontemporal_load(wp + (size_t)(2 * i) * ldw);
#pragma unroll
    for (int i = 0; i < 32; ++i) scr[(2 * i + (lane >> 5)) * 33 + (lane & 31)] = tv[i];
    LDS_WAIT(); asm volatile("" ::: "memory");
    if (fp8 != 0.f) {
        const int c4 = lane & 3; gu8* W8 = (gu8*)WT;
#pragma unroll
        for (int j = 0; j < 2; ++j) { const int n = (lane >> 2) + 16 * j; const LAS float* s = scr + (16 * c4) * 33 + n; u32x4 o;
#pragma unroll
            for (int q = 0; q < 4; ++q) o[q] = pk4_fp8((f32x4){s[(4 * q) * 33], s[(4 * q + 1) * 33], s[(4 * q + 2) * 33], s[(4 * q + 3) * 33]} * fp8);
            *(gu32x4*)(W8 + (size_t)(dperm ? down_row(drow + n) : drow + n) * K + k0 + 16 * c4) = o; }
        LDS_WAIT(); asm volatile("" ::: "memory");
        return; }
    const int c = lane & 7;
#pragma unroll
    for (int j = 0; j < 4; ++j) { const int n = (lane >> 3) + 8 * j; const LAS float* s = scr + (8 * c) * 33 + n;
        u32x4 o; o.x = cvt_pk_bf16(s[0 * 33], s[1 * 33]); o.y = cvt_pk_bf16(s[2 * 33], s[3 * 33]); o.z = cvt_pk_bf16(s[4 * 33], s[5 * 33]); o.w = cvt_pk_bf16(s[6 * 33], s[7 * 33]);
        *(gu32x4*)(WT + (size_t)(dperm ? down_row(drow + n) : drow + n) * K + k0 + 8 * c) = o; }
    LDS_WAIT(); asm volatile("" ::: "memory");
}
__device__ __forceinline__ void tr_job(int r, const gf32* src, int ldw, int col0, int K, int N, size_t sbatch, gbf16* dst, size_t dbatch, int row_off, int seg, int segs, LAS float* scr, int lane, bool dperm = false, float fp8 = 0.f) {
    const int nblk = N >> 5, ipb = (K >> 6) * nblk;
    const int bt = r / ipb, rr = r - bt * ipb, kb = rr / nblk, nb = rr - kb * nblk, n0 = nb << 5;
    tr_item(src + (size_t)bt * sbatch, ldw, K, dst + (size_t)bt * dbatch, row_off + (n0 / seg) * segs + (n0 % seg), kb << 6, col0 + n0, scr, lane, dperm, fp8);
}
__device__ __forceinline__ void phase_prologue(Frame& F) {
    if (F.bid < 192) {
        LAS float* cond = (LAS float*)F.lds;
        LAS float* red = (LAS float*)(F.lds + 9 * 2048 * 4);
        for (int i = F.tid; i < 9 * 2048; i += NTHR) { const int r = i >> 11, k = i & 2047; const float v = (r < 8) ? INP(IN_C)[r * D + k] : INP(IN_CCTX)[k]; cond[i] = siluf_(v); }
        __syncthreads();
        const int l = F.bid / 96, col0 = (F.bid % 96) * 128, cg = F.tid & 31, kl = F.tid >> 5;
        const gf32* W = INP(IN_ADAW) + (size_t)l * D * ADA_N + col0 + 4 * cg;
        f32x4 acc[9];
#pragma unroll
        for (int r = 0; r < 9; ++r) acc[r] = (f32x4){0.f, 0.f, 0.f, 0.f};
#pragma unroll 8
        for (int k = kl; k < D; k += 16) { const f32x4 w4 = __builtin_nontemporal_load((const gf32x4*)(W + (size_t)k * ADA_N));
#pragma unroll
            for (int r = 0; r < 9; ++r) acc[r] += cond[r * 2048 + k] * w4; }
#pragma unroll
        for (int r = 0; r < 9; ++r) *(LAS f32x4*)(red + (kl * 9 + r) * 128 + 4 * cg) = acc[r];
        __syncthreads();
        gf32* mod = (gf32*)(F.ws + WS_MOD);
        for (int o = F.tid; o < 9 * 128; o += NTHR) { const int r = o >> 7, c = o & 127; float s = 0.f;
#pragma unroll
            for (int q = 0; q < 16; ++q) s += red[(q * 9 + r) * 128 + c];
            mod[(size_t)(l * 9 + r) * ADA_N + col0 + c] = s + INP(IN_ADAB)[l * ADA_N + col0 + c]; }
        __syncthreads();
    }
    LAS float* scr = (LAS float*)(F.lds + F.wave * 8704);
    const int gw = F.bid * NWAVES + F.wave, NGW = GRID * NWAVES;
    gbf16* convin_t = (gbf16*)(F.ws + WS_CONVIN_T); gbf16* convout_t = (gbf16*)(F.ws + WS_CONVOUT_T);
    gbf16* mlin_t = (gbf16*)(F.ws + WS_MLIN_T); gbf16* mlout_t = (gbf16*)(F.ws + WS_MLOUT_T);
    constexpr int I_SQ = 32 * 64, I_MLIN = 32 * 193, I_RT = 32 * 2, I_EGU = 64 * 32 * 16, I_EDN = 64 * 8 * 64, I_SGU = 32 * 16, I_SDN = 8 * 64;
    constexpr int I_MOE = I_RT + 2 * I_EGU + I_EDN + 2 * I_SGU + I_SDN;
    constexpr int NITEMS = 4 * I_SQ + I_MLIN + I_SQ + 2 * I_MOE;
    gi32* ctr = (gi32*)(F.ws + WS_CTL) + CW_P0CTR;
    (void)gw; (void)NGW;
    for (;;) {
        int base = 0; if (F.lane == 0) base = __hip_atomic_fetch_add(ctr, 16, __ATOMIC_RELAXED, __HIP_MEMORY_SCOPE_AGENT);
        base = __builtin_amdgcn_readfirstlane(base);
        if (base >= NITEMS) break;
        const int lim = (base + 16 < NITEMS) ? base + 16 : NITEMS;
      for (int it = base; it < lim; ++it) {
        int r = it;
        if (r < I_SQ) { tr_job(r, INP(IN_CONVIN), 3 * D, 2048, D, D, 0, convin_t, 0, 0, 128, 256, scr, F.lane); continue; } r -= I_SQ;
        if (r < I_SQ) { tr_job(r, INP(IN_CONVIN), 3 * D, 4096, D, D, 0, convin_t, 0, 128, 128, 256, scr, F.lane); continue; } r -= I_SQ;
        if (r < I_SQ) { tr_job(r, INP(IN_CONVIN), 3 * D, 0, D, D, 0, convin_t, 0, 4096, D, 0, scr, F.lane); continue; } r -= I_SQ;
        if (r < I_SQ) { tr_job(r, INP(IN_CONVOUT), D, 0, D, D, 0, convout_t, 0, 0, D, 0, scr, F.lane); continue; } r -= I_SQ;
        if (r < I_MLIN) { tr_job(r, INP(IN_MLIN), MLSTM_N, 0, D, MLSTM_N, 0, mlin_t, 0, 0, 8192, 0, scr, F.lane); continue; } r -= I_MLIN;
        if (r < I_SQ) { tr_job(r, INP(IN_MLOUT), D, 0, D, D, 0, mlout_t, 0, 0, D, 0, scr, F.lane); continue; } r -= I_SQ;
        const int l = r / I_MOE; r -= l * I_MOE;
        gu8* moe = F.ws + WS_MOE0 + (size_t)l * MOE_STRIDE;
        gbf16* gu_t = (gbf16*)(moe + MOE_GU); gbf16* dn_t = (gbf16*)(moe + MOE_DN); gbf16* rt_t = (gbf16*)(moe + MOE_RT);
        if (r < I_RT) { tr_job(r, INP(IN_RW) + (size_t)l * D * NE, NE, 0, D, NE, 0, rt_t, 0, 0, NE, 0, scr, F.lane); continue; } r -= I_RT;
        if (r < I_EGU) { tr_job(r, INP(IN_EG) + (size_t)l * NE * D * ED, ED, 0, D, ED, (size_t)D * ED, gu_t, (size_t)512 * D, 0, 128, 256, scr, F.lane, false, GU_WSCALE); continue; } r -= I_EGU;
        if (r < I_EGU) { tr_job(r, INP(IN_EU) + (size_t)l * NE * D * ED, ED, 0, D, ED, (size_t)D * ED, gu_t, (size_t)512 * D, 128, 128, 256, scr, F.lane, false, GU_WSCALE); continue; } r -= I_EGU;
        if (r < I_EDN) { tr_job(r, INP(IN_ED) + (size_t)l * NE * ED * D, D, 0, ED, D, (size_t)ED * D, dn_t, (size_t)D * ED / 2, 0, D, 0, scr, F.lane, true, DN_WSCALE); continue; } r -= I_EDN;
        if (r < I_SGU) { tr_job(r, INP(IN_SG) + (size_t)l * D * ED, ED, 0, D, ED, 0, gu_t + (size_t)64 * 512 * D, 0, 0, 128, 256, scr, F.lane, false, GU_WSCALE); continue; } r -= I_SGU;
        if (r < I_SGU) { tr_job(r, INP(IN_SU) + (size_t)l * D * ED, ED, 0, D, ED, 0, gu_t + (size_t)64 * 512 * D, 0, 128, 128, 256, scr, F.lane, false, GU_WSCALE); continue; } r -= I_SGU;
        tr_job(r, INP(IN_SD) + (size_t)l * ED * D, D, 0, ED, D, 0, dn_t + (size_t)64 * D * ED / 2, 0, 0, D, 0, scr, F.lane, true, DN_WSCALE);
      }
    }
    { gu32x4* z = (gu32x4*)(mlin_t + (size_t)MLSTM_N * D); const int n16 = (MLSTM_NP - MLSTM_N) * D * 2 / 16;
      for (int i = F.bid * NTHR + F.tid; i < n16; i += GRID * NTHR) z[i] = (u32x4){0u, 0u, 0u, 0u}; }
}

template <bool LB> __device__ __forceinline__ int col_of(int lane, int j) { return LB ? 16 * lane + 1024 * (j >> 2) + 4 * (j & 3) : 4 * lane + 256 * j; }
template <bool TO_LDS, bool LB = false>
__device__ __forceinline__ void norm_mod_store(const f32x4 (&v)[8], float rstd, const gf32* w, const gf32* shift, const gf32* scale, gbf16* orow, LAS bf16_t* lrow, int lane) {
#pragma unroll
    for (int j = 0; j < 8; ++j) { const int c = col_of<LB>(lane, j);
        const f32x4 w4 = *(const gf32x4*)(w + c), sc = *(const gf32x4*)(scale + c), sh = *(const gf32x4*)(shift + c);
        const f32x4 y = (v[j] * rstd) * w4 * (sc + 1.0f) + sh;
        u32x2 o; o.x = cvt_pk_bf16(y[0], y[1]); o.y = cvt_pk_bf16(y[2], y[3]);
        *(gu32x2*)(orow + c) = o;
        if (TO_LDS) *(LAS u32x2*)(lrow + c) = o; }
}
__device__ __forceinline__ float row_ssq(const f32x4 (&v)[8]) {
    float s = 0.f;
#pragma unroll
    for (int j = 0; j < 8; ++j) s += (v[j][0] * v[j][0] + v[j][1] * v[j][1]) + (v[j][2] * v[j][2] + v[j][3] * v[j][3]);
    return wave_sum(s);
}

__device__ __forceinline__ void phase_norm0(Frame& F) {
    gbf16* H = (gbf16*)(F.ws + WS_H);
    const int gw = F.bid * NWAVES + F.wave, NGW = GRID * NWAVES;
    for (int r = gw; r < NTOK; r += NGW) {
        const gf32* xr = (r < NCTX) ? INP(IN_CTX) + (size_t)r * D : INP(IN_X) + (size_t)(r - NCTX) * D;
        f32x4 v[8];
#pragma unroll
        for (int j = 0; j < 8; ++j) v[j] = *(const gf32x4*)(xr + 4 * F.lane + 256 * j);
        const float rstd = rsqrtf(row_ssq(v) * (1.0f / D) + EPS);
        const int mr = mod_row(r);
        norm_mod_store<false>(v, rstd, INP(IN_NMIXW), mod_ptr(F, 0, mr, 0), mod_ptr(F, 0, mr, 1), H + (size_t)r * D, (LAS bf16_t*)F.lds, F.lane);
    }
}

__device__ __forceinline__ void phase_conv(Frame& F) {
    const gbf16* U = (const gbf16*)(F.ws + WS_U); const gbf16* BMt = (const gbf16*)(F.ws + WS_BM); gbf16* Z = (gbf16*)(F.ws + WS_Z);
    const gf32* dw = INP(IN_CONVDW);
    const int total = NTOK * (D / 8);
    for (int i = F.bid * NTHR + F.tid; i < total; i += GRID * NTHR) {
        const int r = i >> 8, c = (i & 255) * 8;
        const int pos = (r < NCTX) ? (r & 255) : (r & 63), seglen = (r < NCTX) ? 256 : 64;
        const u32x4 z4 = (u32x4){0u, 0u, 0u, 0u};
        const u32x4 um = (pos > 0) ? *(const gu32x4*)(U + (size_t)(r - 1) * D + c) : z4;
        const u32x4 u0 = *(const gu32x4*)(U + (size_t)r * D + c);
        const u32x4 up = (pos < seglen - 1) ? *(const gu32x4*)(U + (size_t)(r + 1) * D + c) : z4;
        const u32x4 bb = *(const gu32x4*)(BMt + (size_t)r * D + c);
        float w0[8], w1[8], w2[8];
#pragma unroll
        for (int q = 0; q < 2; ++q) { const f32x4 a = *(const gf32x4*)(dw + c + 4 * q), b = *(const gf32x4*)(dw + D + c + 4 * q), d = *(const gf32x4*)(dw + 2 * D + c + 4 * q);
#pragma unroll
            for (int j = 0; j < 4; ++j) { w0[4 * q + j] = a[j]; w1[4 * q + j] = b[j]; w2[4 * q + j] = d[j]; } }
        u32x4 o;
#pragma unroll
        for (int q = 0; q < 4; ++q) {
            const float y0 = bf_lo(bb[q]) * (w0[2 * q] * bf_lo(um[q]) + w1[2 * q] * bf_lo(u0[q]) + w2[2 * q] * bf_lo(up[q]));
            const float y1 = bf_hi(bb[q]) * (w0[2 * q + 1] * bf_hi(um[q]) + w1[2 * q + 1] * bf_hi(u0[q]) + w2[2 * q + 1] * bf_hi(up[q]));
            o[q] = cvt_pk_bf16(y0, y1); }
        *(gu32x4*)(Z + (size_t)r * D + c) = o;
    }
}

constexpr int HS_PITCH = 2056;
constexpr int RL_HS = 0, RL_PART = 16 * HS_PITCH * 2, RL_LOGIT = RL_PART + 8 * 16 * 64 * 4, RL_IDX = RL_LOGIT + 16 * 64 * 4;
template <int NT>
__device__ __forceinline__ void tile16_mfma(const LAS bf16_t* hs, const gbf16* Wt, LAS float* part, int wave, int lane) {
    f32x4 acc[NT];
#pragma unroll
    for (int nt = 0; nt < NT; ++nt) acc[nt] = (f32x4){0.f, 0.f, 0.f, 0.f};
    const int fr = lane & 15, fq = lane >> 4;
#pragma unroll 4
    for (int ks = 0; ks < 8; ++ks) { const int k0 = 256 * wave + 32 * ks + 8 * fq;
        const bf16x8 a = *(const LAS bf16x8*)(hs + fr * HS_PITCH + k0);
#pragma unroll
        for (int nt = 0; nt < NT; ++nt) { const bf16x8 b = *(const gbf16x8*)(Wt + (size_t)(16 * nt + fr) * D + k0);
            acc[nt] = __builtin_amdgcn_mfma_f32_16x16x32_bf16(a, b, acc[nt], 0, 0, 0); } }
#pragma unroll
    for (int nt = 0; nt < NT; ++nt)
#pragma unroll
        for (int j = 0; j < 4; ++j) part[wave * (256 * NT) + (4 * fq + j) * (16 * NT) + 16 * nt + fr] = acc[nt][j];
}
constexpr int R_HS = 0, R_PART = 0, R_LOGIT = 32 * HS_PITCH * 2, R_VSEL = R_LOGIT + 8192, R_TSC = R_VSEL + 8192, R_BIDX = R_TSC + 1024, R_CNT = R_BIDX + 1728;
static_assert(R_CNT + 2048 <= LDSCTL_OFF, "router LDS map");
__device__ __forceinline__ void phase_router(Frame& F, int layer, int rowbase, int rpb, const gbf16* xsrc, int xrow0) {
    gu8* H8 = (gu8*)(F.ws + WS_H8);
    const gbf16* rt_t = (const gbf16*)(F.ws + WS_MOE0 + (size_t)layer * MOE_STRIDE + MOE_RT);
    gi32* sel_idx = (gi32*)(F.ws + RT_SELIDX); gf32* sel_gate = (gf32*)(F.ws + RT_SELGATE); gi32* sel_rank = (gi32*)(F.ws + RT_SELRANK); gi32* hist = (gi32*)(F.ws + RT_HIST);
    LAS bf16_t* hs = (LAS bf16_t*)(F.lds + R_HS); LAS float* part = (LAS float*)(F.lds + R_PART); LAS float* logit = (LAS float*)(F.lds + R_LOGIT);
    LAS float* vsel = (LAS float*)(F.lds + R_VSEL); LAS float* tsc = (LAS float*)(F.lds + R_TSC); LAS int* bidx = (LAS int*)(F.lds + R_BIDX); LAS int* wcnt = (LAS int*)(F.lds + R_CNT);
    const int r0 = rowbase + F.bid * rpb, ngroups = (rpb + 31) >> 5;
    const gf32* nw = INP(IN_NFFNW) + layer * D; const float bias = INP(IN_RB)[layer * NE + F.lane];
    const int fr = F.lane & 15, fq = F.lane >> 4;
#define RT_BAR() do { asm volatile("s_waitcnt lgkmcnt(0)" ::: "memory"); __builtin_amdgcn_s_barrier(); asm volatile("" ::: "memory"); } while (0)
    f32x4 cw[8], cs[8]; int cur_mr = -1;
    for (int g = 0; g < ngroups; ++g) {
#pragma unroll 1
        for (int pr = 0; pr < 2; ++pr) { const int lr = 4 * F.wave + 2 * pr, br = 32 * g + lr; LAS bf16_t* lrow = hs + lr * HS_PITCH;
            if (br < rpb) { const int r = r0 + br, mr = mod_row(r); f32x4 va[8], vb[8];
                { const gbf16* xb = xsrc + (size_t)(r - xrow0) * D;
#pragma unroll
                    for (int j = 0; j < 8; ++j) { const u32x2 w0 = *(const gu32x2*)(xb + 4 * F.lane + 256 * j), w1 = *(const gu32x2*)(xb + D + 4 * F.lane + 256 * j);
                        va[j] = (f32x4){bf_lo(w0.x), bf_hi(w0.x), bf_lo(w0.y), bf_hi(w0.y)}; vb[j] = (f32x4){bf_lo(w1.x), bf_hi(w1.x), bf_lo(w1.y), bf_hi(w1.y)}; } }
                if (mr != cur_mr) { cur_mr = mr; const gf32* sc = mod_ptr(F, layer, mr, 4); const gf32* sh = mod_ptr(F, layer, mr, 3);
#pragma unroll
                    for (int j = 0; j < 8; ++j) { const int c = 4 * F.lane + 256 * j; cw[j] = *(const gf32x4*)(nw + c) * (*(const gf32x4*)(sc + c) + 1.0f); cs[j] = *(const gf32x4*)(sh + c); } }
                const float rstd0 = rsqrtf(row_ssq(va) * (1.0f / D) + EPS), rstd1 = rsqrtf(row_ssq(vb) * (1.0f / D) + EPS);
#pragma unroll
                for (int j = 0; j < 8; ++j) { const int c = 4 * F.lane + 256 * j;
                    const f32x4 y0 = (va[j] * rstd0) * cw[j] + cs[j], y1 = (vb[j] * rstd1) * cw[j] + cs[j];
                    u32x2 o0, o1; o0.x = cvt_pk_bf16(y0[0], y0[1]); o0.y = cvt_pk_bf16(y0[2], y0[3]); o1.x = cvt_pk_bf16(y1[0], y1[1]); o1.y = cvt_pk_bf16(y1[2], y1[3]);
                    *(GAS unsigned*)(H8 + (size_t)r * D + c) = pk4_fp8(y0); *(GAS unsigned*)(H8 + (size_t)(r + 1) * D + c) = pk4_fp8(y1);
                    *(LAS u32x2*)(lrow + c) = o0; *(LAS u32x2*)(lrow + HS_PITCH + c) = o1; }
            } else {
#pragma unroll
                for (int j = 0; j < 8; ++j) { *(LAS u32x2*)(lrow + 4 * F.lane + 256 * j) = (u32x2){0u, 0u}; *(LAS u32x2*)(lrow + HS_PITCH + 4 * F.lane + 256 * j) = (u32x2){0u, 0u}; } } }
        RT_BAR();
        f32x4 acc[2][4];
#pragma unroll
        for (int t = 0; t < 2; ++t)
#pragma unroll
            for (int nt = 0; nt < 4; ++nt) acc[t][nt] = (f32x4){0.f, 0.f, 0.f, 0.f};
#pragma unroll 4
        for (int ks = 0; ks < 8; ++ks) { const int k0 = 256 * F.wave + 32 * ks + 8 * fq;
            const bf16x8 a0 = *(const LAS bf16x8*)(hs + fr * HS_PITCH + k0), a1 = *(const LAS bf16x8*)(hs + (16 + fr) * HS_PITCH + k0);
#pragma unroll
            for (int nt = 0; nt < 4; ++nt) { const bf16x8 bfr = *(const gbf16x8*)(rt_t + (size_t)(16 * nt + fr) * D + k0);
                acc[0][nt] = __builtin_amdgcn_mfma_f32_16x16x32_bf16(a0, bfr, acc[0][nt], 0, 0, 0); acc[1][nt] = __builtin_amdgcn_mfma_f32_16x16x32_bf16(a1, bfr, acc[1][nt], 0, 0, 0); } }
        RT_BAR();
#pragma unroll
        for (int t = 0; t < 2; ++t)
#pragma unroll
            for (int nt = 0; nt < 4; ++nt)
#pragma unroll
                for (int j = 0; j < 4; ++j) part[F.wave * 2048 + (16 * t + 4 * fq + j) * 64 + 16 * nt + fr] = acc[t][nt][j];
        RT_BAR();
#pragma unroll
        for (int q = 0; q < 4; ++q) { const int o = F.tid + 512 * q; float s = 0.f;
#pragma unroll
            for (int w = 0; w < 8; ++w) s += part[w * 2048 + o];
            const float sc = sigmoidf_(s); logit[o] = sc; vsel[o] = sc + bias; }
        RT_BAR();
#pragma unroll 1
        for (int q = 0; q < 4; ++q) { const int lr = 4 * F.wave + q, br = 32 * g + lr;
            if (br < rpb) { const int r = r0 + br;
                const float myv = vsel[lr * 64 + F.lane], mysc = logit[lr * 64 + F.lane]; int rank = 0;
#pragma unroll 4
                for (int j4 = 0; j4 < 16; ++j4) { const f32x4 o = *(const LAS f32x4*)(vsel + lr * 64 + 4 * j4);
#pragma unroll
                    for (int t = 0; t < 4; ++t) rank += (o[t] > myv || (o[t] == myv && (4 * j4 + t) < F.lane)) ? 1 : 0; }
                const bool sel = rank < TOPK;
                if (sel) tsc[lr * 8 + rank] = mysc;
                asm volatile("s_waitcnt lgkmcnt(0)" ::: "memory");
                float ssum = 0.f;
#pragma unroll
                for (int k = 0; k < TOPK; ++k) ssum += tsc[lr * 8 + k];
                if (sel) { sel_idx[(size_t)r * TOPK + rank] = F.lane; sel_gate[(size_t)r * TOPK + rank] = mysc / ssum * 2.5f; bidx[br * TOPK + rank] = F.lane; } } }
    }
    __syncthreads();
    { const int rw = rpb >> 3, rb = F.wave * rw; int cnt = 0;
      for (int rr = rb; rr < rb + rw; ++rr) {
#pragma unroll
          for (int k = 0; k < TOPK; ++k) cnt += (bidx[rr * TOPK + k] == F.lane) ? 1 : 0; }
      wcnt[F.wave * 64 + F.lane] = cnt;
      __syncthreads();
      int base = 0, tot = 0;
#pragma unroll
      for (int w = 0; w < 8; ++w) { const int c = wcnt[w * 64 + F.lane]; base += (w < F.wave) ? c : 0; tot += c; }
      for (int rr = rb; rr < rb + rw; ++rr) {
#pragma unroll
          for (int k = 0; k < TOPK; ++k) { if (bidx[rr * TOPK + k] == F.lane) { sel_rank[(size_t)(r0 + rr) * TOPK + k] = base; ++base; } } }
      if (F.wave == 0) hist[F.bid * NE + F.lane] = tot; }
    __syncthreads();
#undef RT_BAR
}

__device__ __forceinline__ void phase_scatter(Frame& F, int rowbase, int rpb, int ntok) {
    const gi32* hist = (const gi32*)(F.ws + RT_HIST); gi32* einfo = (gi32*)(F.ws + RT_EINFO);
    const gi32* sel_idx = (const gi32*)(F.ws + RT_SELIDX); const gf32* sel_gate = (const gf32*)(F.ws + RT_SELGATE); const gi32* sel_rank = (const gi32*)(F.ws + RT_SELRANK);
    gi32* slot_of = (gi32*)(F.ws + RT_SLOTOF); gi32* tok_of = (gi32*)(F.ws + RT_TOKOF); gf32* gate_of = (gf32*)(F.ws + RT_GATEOF);
    LAS int* tot8 = (LAS int*)F.lds; LAS int* pre8 = tot8 + 512; LAS int* tot = pre8 + 512; LAS int* boff = tot + 64; LAS int* pst = boff + 64;
    { const int e = F.tid & 63, p = F.tid >> 6; int s = 0, pre = 0;
      for (int b = 32 * p; b < 32 * p + 32; ++b) { const int h = hist[b * NE + e]; s += h; pre += (b < F.bid) ? h : 0; }
      tot8[p * 64 + e] = s; pre8[p * 64 + e] = pre; }
    __syncthreads();
    if (F.tid < 64) { int s = 0, pre = 0;
#pragma unroll
        for (int p = 0; p < 8; ++p) { s += tot8[p * 64 + F.tid]; pre += pre8[p * 64 + F.tid]; }
        tot[F.tid] = s; boff[F.tid] = pre; }
    __syncthreads();
    LAS int* rtl = pst + 64;
    if (F.tid == 0) { int a = 0; for (int e = 0; e < NE; ++e) { pst[e] = a; a += (tot[e] + 255) & ~255; } }
    if (F.tid >= 64 && F.tid < 72) { const int x = F.tid - 64; int t = 0;
#pragma unroll
        for (int kk = 0; kk < 8; ++kk) t += (tot[x + 8 * kk] + 255) >> 8;
        rtl[x] = t; }
    __syncthreads();
    const int r0 = rowbase + F.bid * rpb;
    for (int a = F.tid; a < rpb * TOPK; a += NTHR) { const size_t ga = (size_t)r0 * TOPK + a; const int e = sel_idx[ga];
        const int slot = pst[e] + boff[e] + sel_rank[ga];
        tok_of[slot] = r0 + a / TOPK; gate_of[slot] = sel_gate[ga]; slot_of[ga] = slot; }
    for (int rr = F.tid; rr < rpb; rr += NTHR) { const int s = SH_BASE + (r0 - rowbase) + rr; tok_of[s] = r0 + rr; gate_of[s] = 1.0f; }
    if (F.bid < NE) { const int e = F.bid, lo = pst[e] + tot[e], hi = pst[e] + ((tot[e] + 255) & ~255);
        for (int s = lo + F.tid; s < hi; s += NTHR) { tok_of[s] = rowbase; gate_of[s] = 0.0f; } }
    if (F.bid == 0) {
        if (F.tid < NE) { einfo[F.tid] = tot[F.tid]; einfo[128 + F.tid] = pst[F.tid]; einfo[256 + F.tid] = (tot[F.tid] + 255) >> 8; }
        if (F.tid == NE) { einfo[NE] = ntok; einfo[128 + NE] = SH_BASE; einfo[256 + NE] = ntok >> 8; } }
    { const int x = F.bid & 7, j = F.bid >> 3;
      gi32x4* u1 = (gi32x4*)(F.ws + RT_UNITS1) + F.bid * MAXU1; gi32x4* u2 = (gi32x4*)(F.ws + RT_UNITS2) + F.bid * MAXU2;
      if (F.tid < 128 + MAXU2) { int shs, shn; shared_share(rtl, ntok >> 8, x, shs, shn);
        if (F.tid < MAXU1) { i32x4 d; class_unit(tot, pst, x, F.tid * 32 + j, 4, shs, shn, d); u1[F.tid] = d; }
        else if (F.tid >= 128) { const int i = F.tid - 128; i32x4 d; class_unit(tot, pst, x, i * 32 + j, 8, shs, shn, d); u2[i] = d; } } }
    __syncthreads();
}

template <int MODE>
__device__ __forceinline__ void phase_combine(Frame& F) {
    gf32* X = (gf32*)(F.ws + WS_X); gbf16* H = (gbf16*)(F.ws + WS_H); const gu8* Y = (const gu8*)(F.ws + WS_Y);
    const gi32* slot_of = (const gi32*)(F.ws + RT_SLOTOF);
    const int layer = MODE, rowbase = MODE ? NCTX : 0, nrows = MODE ? NLAT : NTOK;
    const int gw = F.bid * NWAVES + F.wave, NGW = GRID * NWAVES;
    const gf32* sel_gate = (const gf32*)(F.ws + RT_SELGATE);
    int sln[TOPK]; float gln[TOPK];
    if (gw < nrows) {
#pragma unroll
        for (int k = 0; k < TOPK; ++k) { sln[k] = slot_of[(size_t)(rowbase + gw) * TOPK + k]; gln[k] = sel_gate[(size_t)(rowbase + gw) * TOPK + k]; } }
    for (int rr = gw; rr < nrows; rr += NGW) { const int r = rowbase + rr;
        int sl[7]; float gk[7];
#pragma unroll
        for (int k = 0; k < TOPK; ++k) { sl[k] = __builtin_amdgcn_readfirstlane(sln[k]); gk[k] = __int_as_float(__builtin_amdgcn_readfirstlane(__float_as_int(gln[k]))); }
        if (rr + NGW < nrows) {
#pragma unroll
            for (int k = 0; k < TOPK; ++k) { sln[k] = slot_of[(size_t)(r + NGW) * TOPK + k]; gln[k] = sel_gate[(size_t)(r + NGW) * TOPK + k]; } }
        sl[6] = SH_BASE + rr; gk[6] = 1.0f;
        const int mr = mod_row(r); const gf32* g2 = mod_ptr(F, layer, mr, 5);
        f32x4 v[8];
#pragma unroll
        for (int hh = 0; hh < 2; ++hh) {
            f32x4 m[4];
#pragma unroll
            for (int q = 0; q < 4; ++q) m[q] = (f32x4){0.f, 0.f, 0.f, 0.f};
#pragma unroll
            for (int k = 0; k < 7; ++k) { const u32x4 y = *(const gu32x4*)(Y + (size_t)sl[k] * D + 16 * F.lane + 1024 * hh);
                acc4_fp8s(m[0], y.x, gk[k]); acc4_fp8s(m[1], y.y, gk[k]); acc4_fp8s(m[2], y.z, gk[k]); acc4_fp8s(m[3], y.w, gk[k]); }
            if constexpr (MODE == 1) {
                const gbf16* xb = (const gbf16*)(F.ws + WS_XB) + (size_t)rr * D + 16 * F.lane + 1024 * hh; const u32x4 x0 = *(const gu32x4*)xb, x1 = *(const gu32x4*)(xb + 8);
                const f32x4 b4[4] = {(f32x4){bf_lo(x0.x), bf_hi(x0.x), bf_lo(x0.y), bf_hi(x0.y)}, (f32x4){bf_lo(x0.z), bf_hi(x0.z), bf_lo(x0.w), bf_hi(x0.w)}, (f32x4){bf_lo(x1.x), bf_hi(x1.x), bf_lo(x1.y), bf_hi(x1.y)}, (f32x4){bf_lo(x1.z), bf_hi(x1.z), bf_lo(x1.w), bf_hi(x1.w)}};
#pragma unroll
                for (int q = 0; q < 4; ++q) { const int c = 16 * F.lane + 1024 * hh + 4 * q; v[4 * hh + q] = b4[q] + *(const gf32x4*)(g2 + c) * m[q]; }
            } else {
#pragma unroll
            for (int q = 0; q < 4; ++q) { const int c = 16 * F.lane + 1024 * hh + 4 * q; v[4 * hh + q] = *(const gf32x4*)(X + (size_t)r * D + c) + *(const gf32x4*)(g2 + c) * m[q]; } } }
        const float rstd = rsqrtf(row_ssq(v) * (1.0f / D) + EPS);
        if (MODE == 0) {
#pragma unroll
            for (int j = 0; j < 8; ++j) *(gf32x4*)(X + (size_t)r * D + col_of<true>(F.lane, j)) = v[j];
            norm_mod_store<false, true>(v, rstd, INP(IN_NMIXW) + D, mod_ptr(F, 1, mr, 0), mod_ptr(F, 1, mr, 1), H + (size_t)r * D, (LAS bf16_t*)F.lds, F.lane);
        } else {
#pragma unroll
            for (int j = 0; j < 8; ++j) { const int c = col_of<true>(F.lane, j); *(gf32x4*)(F.out + (size_t)rr * D + c) = (v[j] * rstd) * *(const gf32x4*)(INP(IN_FNW) + c); }
        }
    }
}

__device__ __forceinline__ void phase_combine0_gates(Frame& F) {
    gf32* X = (gf32*)(F.ws + WS_X); gbf16* H = (gbf16*)(F.ws + WS_H); const gu8* Y = (const gu8*)(F.ws + WS_Y);
    const gi32* slot_of = (const gi32*)(F.ws + RT_SLOTOF); gf32* G = (gf32*)(F.ws + WS_GATES);
    const gbf16* Wg = (const gbf16*)(F.ws + WS_MLIN_T) + (size_t)6144 * D;
    LAS bf16_t* hs = (LAS bf16_t*)(F.lds + R_HS); LAS float* part = (LAS float*)(F.lds + R_PART);
    constexpr int rpb = NTOK / GRID;
    const int r0 = F.bid * rpb, ngroups = (rpb + 31) >> 5;
    const int fr = F.lane & 15, fq = F.lane >> 4;
#define CG_BAR() do { asm volatile("s_waitcnt lgkmcnt(0)" ::: "memory"); __builtin_amdgcn_s_barrier(); asm volatile("" ::: "memory"); } while (0)
    f32x4 cw[8]; int cur_mr = -1;
    for (int g = 0; g < ngroups; ++g) {
        const int lr0 = 4 * F.wave, br0 = 32 * g + lr0;
        if (br0 < rpb) {
            const int slv = slot_of[(size_t)(r0 + br0) * TOPK + (F.lane < 24 ? F.lane : 0)];
            const int glv = __float_as_int(((const gf32*)(F.ws + RT_SELGATE))[(size_t)(r0 + br0) * TOPK + (F.lane < 24 ? F.lane : 0)]);
#pragma unroll 1
            for (int q = 0; q < 4; ++q) { const int r = r0 + br0 + q, mr = mod_row(r); LAS bf16_t* lrow = hs + (lr0 + q) * HS_PITCH;
                int sl[7]; float gk[7];
#pragma unroll
                for (int k = 0; k < TOPK; ++k) { sl[k] = __builtin_amdgcn_readlane(slv, 6 * q + k); gk[k] = __int_as_float(__builtin_amdgcn_readlane(glv, 6 * q + k)); }
                sl[6] = SH_BASE + r; gk[6] = 1.0f;
                const gf32* g2 = mod_ptr(F, 0, mr, 5); const gf32* sh = mod_ptr(F, 1, mr, 0);
                if (mr != cur_mr) { cur_mr = mr; const gf32* sc = mod_ptr(F, 1, mr, 1); const gf32* nw = INP(IN_NMIXW) + D;
#pragma unroll
                    for (int j = 0; j < 8; ++j) { const int c = col_of<true>(F.lane, j); cw[j] = *(const gf32x4*)(nw + c) * (*(const gf32x4*)(sc + c) + 1.0f); } }
                f32x4 v[8];
#pragma unroll
                for (int hh = 0; hh < 2; ++hh) {
                    f32x4 m[4];
#pragma unroll
                    for (int qq = 0; qq < 4; ++qq) m[qq] = (f32x4){0.f, 0.f, 0.f, 0.f};
#pragma unroll
                    for (int k = 0; k < 7; ++k) { const u32x4 y = *(const gu32x4*)(Y + (size_t)sl[k] * D + 16 * F.lane + 1024 * hh);
                        acc4_fp8s(m[0], y.x, gk[k]); acc4_fp8s(m[1], y.y, gk[k]); acc4_fp8s(m[2], y.z, gk[k]); acc4_fp8s(m[3], y.w, gk[k]); }
                    const gbf16* xb = (const gbf16*)X + (size_t)r * D + 16 * F.lane + 1024 * hh; const u32x4 x0 = *(const gu32x4*)xb, x1 = *(const gu32x4*)(xb + 8);
                    const f32x4 b4[4] = {(f32x4){bf_lo(x0.x), bf_hi(x0.x), bf_lo(x0.y), bf_hi(x0.y)}, (f32x4){bf_lo(x0.z), bf_hi(x0.z), bf_lo(x0.w), bf_hi(x0.w)}, (f32x4){bf_lo(x1.x), bf_hi(x1.x), bf_lo(x1.y), bf_hi(x1.y)}, (f32x4){bf_lo(x1.z), bf_hi(x1.z), bf_lo(x1.w), bf_hi(x1.w)}};
#pragma unroll
                    for (int qq = 0; qq < 4; ++qq) { const int c = 16 * F.lane + 1024 * hh + 4 * qq; v[4 * hh + qq] = b4[qq] + *(const gf32x4*)(g2 + c) * m[qq]; } }
                const float rstd = rsqrtf(row_ssq(v) * (1.0f / D) + EPS);
                if (r >= NCTX) {
                    gbf16* xb = (gbf16*)(F.ws + WS_XB) + (size_t)(r - NCTX) * D;
#pragma unroll
                    for (int hh = 0; hh < 2; ++hh) {
                        u32x4 w0, w1;
                        w0.x = cvt_pk_bf16(v[4 * hh][0], v[4 * hh][1]); w0.y = cvt_pk_bf16(v[4 * hh][2], v[4 * hh][3]); w0.z = cvt_pk_bf16(v[4 * hh + 1][0], v[4 * hh + 1][1]); w0.w = cvt_pk_bf16(v[4 * hh + 1][2], v[4 * hh + 1][3]);
                        w1.x = cvt_pk_bf16(v[4 * hh + 2][0], v[4 * hh + 2][1]); w1.y = cvt_pk_bf16(v[4 * hh + 2][2], v[4 * hh + 2][3]); w1.z = cvt_pk_bf16(v[4 * hh + 3][0], v[4 * hh + 3][1]); w1.w = cvt_pk_bf16(v[4 * hh + 3][2], v[4 * hh + 3][3]);
                        *(gu32x4*)(xb + 16 * F.lane + 1024 * hh) = w0; *(gu32x4*)(xb + 16 * F.lane + 1024 * hh + 8) = w1; } }
#pragma unroll
                for (int j = 0; j < 8; ++j) { const int c = col_of<true>(F.lane, j);
                    const f32x4 y = (v[j] * rstd) * cw[j] + *(const gf32x4*)(sh + c);
                    u32x2 o; o.x = cvt_pk_bf16(y[0], y[1]); o.y = cvt_pk_bf16(y[2], y[3]);
                    *(gu32x2*)(H + (size_t)r * D + c) = o; *(LAS u32x2*)(lrow + c) = o; } }
        } else {
#pragma unroll
            for (int q = 0; q < 4; ++q)
#pragma unroll
                for (int j = 0; j < 8; ++j) *(LAS u32x2*)(hs + (lr0 + q) * HS_PITCH + 4 * F.lane + 256 * j) = (u32x2){0u, 0u}; }
        CG_BAR();
        f32x4 acc[2][2];
#pragma unroll
        for (int t = 0; t < 2; ++t)
#pragma unroll
            for (int nt = 0; nt < 2; ++nt) acc[t][nt] = (f32x4){0.f, 0.f, 0.f, 0.f};
#pragma unroll 4
        for (int ks = 0; ks < 8; ++ks) { const int k0 = 256 * F.wave + 32 * ks + 8 * fq;
            const bf16x8 a0 = *(const LAS bf16x8*)(hs + fr * HS_PITCH + k0), a1 = *(const LAS bf16x8*)(hs + (16 + fr) * HS_PITCH + k0);
#pragma unroll
            for (int nt = 0; nt < 2; ++nt) { const bf16x8 bfr = *(const gbf16x8*)(Wg + (size_t)(16 * nt + fr) * D + k0);
                acc[0][nt] = __builtin_amdgcn_mfma_f32_16x16x32_bf16(a0, bfr, acc[0][nt], 0, 0, 0); acc[1][nt] = __builtin_amdgcn_mfma_f32_16x16x32_bf16(a1, bfr, acc[1][nt], 0, 0, 0); } }
        CG_BAR();
#pragma unroll
        for (int t = 0; t < 2; ++t)
#pragma unroll
            for (int nt = 0; nt < 2; ++nt)
#pragma unroll
                for (int j = 0; j < 4; ++j) part[F.wave * 1024 + (16 * t + 4 * fq + j) * 32 + 16 * nt + fr] = acc[t][nt][j];
        CG_BAR();
#pragma unroll
        for (int q = 0; q < 2; ++q) { const int o = F.tid + 512 * q, row = o >> 5, cidx = o & 31, br = 32 * g + row; float sacc = 0.f;
#pragma unroll
            for (int w = 0; w < 8; ++w) sacc += part[w * 1024 + o];
            if (br < rpb) { float gt = softcap_gate(sacc + INP(IN_MLGB)[cidx]); if ((cidx >> 3) & 1) gt = log_sigmoid_(gt); G[(size_t)(r0 + br) * 32 + cidx] = gt; } }
        CG_BAR();
    }
#undef CG_BAR
}

__device__ __forceinline__ void phase_headnorm(Frame& F) {
    const gbf16* HF = (const gbf16*)(F.ws + WS_HF); const gbf16* HB = (const gbf16*)(F.ws + WS_HB); const gbf16* O = (const gbf16*)(F.ws + WS_O); gbf16* YIN = (gbf16*)(F.ws + WS_YIN);
    const gf32* nw = INP(IN_MLNW);
    const int gw = F.bid * NWAVES + F.wave, NGW = GRID * NWAVES;
    const int c0 = 32 * F.lane;
    f32x4 w4[8];
#pragma unroll
    for (int q = 0; q < 8; ++q) w4[q] = *(const gf32x4*)(nw + c0 + 4 * q);
    for (int rr = gw; rr < NLAT; rr += NGW) {
        u32x4 a[4], b[4], o[4];
#pragma unroll
        for (int q = 0; q < 4; ++q) { a[q] = *(const gu32x4*)(HF + (size_t)rr * D + c0 + 8 * q); b[q] = *(const gu32x4*)(HB + (size_t)rr * D + c0 + 8 * q); o[q] = *(const gu32x4*)(O + (size_t)(NCTX + rr) * D + c0 + 8 * q); }
        float h[32]; float ss = 0.f;
#pragma unroll
        for (int q = 0; q < 4; ++q)
#pragma unroll
            for (int e = 0; e < 4; ++e) { const float h0 = bf_lo(a[q][e]) + bf_lo(b[q][e]), h1 = bf_hi(a[q][e]) + bf_hi(b[q][e]); h[8 * q + 2 * e] = h0; h[8 * q + 2 * e + 1] = h1; ss += h0 * h0 + h1 * h1; }
        ss += dpp_mov<0xB1>(ss); ss += dpp_mov<0x4E>(ss); ss += dpp_mov<0x141>(ss);
        const float rstd = rsqrtf(ss * (1.0f / 256.0f) + EPS);
#pragma unroll
        for (int q = 0; q < 4; ++q) { u32x4 w;
#pragma unroll
            for (int e = 0; e < 4; ++e) { const int i0 = 8 * q + 2 * e;
                const float y0 = h[i0] * rstd * w4[i0 >> 2][i0 & 3] * sigmoidf_(bf_lo(o[q][e])), y1 = h[i0 + 1] * rstd * w4[(i0 + 1) >> 2][(i0 + 1) & 3] * sigmoidf_(bf_hi(o[q][e]));
                w[e] = cvt_pk_bf16(y0, y1); }
            *(gu32x4*)(YIN + (size_t)rr * D + c0 + 8 * q) = w; }
    }
}

constexpr int ML_Q = 0, ML_K = 16384, ML_V = 32768, ML_VW = 49152, ML_S = 65536, ML_CT = 74752, ML_F = 113920, ML_G = 118784;
constexpr int ML_SP = 144, ML_CTP = 272;
__device__ __forceinline__ unsigned off_b(unsigned row, unsigned ch) { return 256u * row + 16u * (ch ^ (((row & 3u) << 2) | ((row >> 2) & 3u))); }
__device__ __forceinline__ unsigned rowrd16(unsigned lane, unsigned rb, unsigned s) { return off_b((lane & 15u) + 16u * rb, 4u * s + (lane >> 4)); }
__device__ __forceinline__ unsigned trrd16(unsigned lane, unsigned c, unsigned ks, unsigned t) {
    const unsigned g = lane >> 4, q = (lane & 15u) >> 2, p = lane & 3u;
    return off_b(32u * ks + 8u * g + 4u * t + q, 2u * c + (p >> 1)) + 8u * (p & 1u);
}
__device__ __forceinline__ bf16x8 tr_frag(LAS unsigned char* img, unsigned lane, unsigned c, unsigned ks) {
    const s16x4 lo = __builtin_amdgcn_ds_read_tr16_b64_v4i16((LAS s16x4*)(img + trrd16(lane, c, ks, 0)));
    const s16x4 hi = __builtin_amdgcn_ds_read_tr16_b64_v4i16((LAS s16x4*)(img + trrd16(lane, c, ks, 1)));
    return (bf16x8){lo[0], lo[1], lo[2], lo[3], hi[0], hi[1], hi[2], hi[3]};
}
__device__ __forceinline__ int ml_row(int b, int dir, int p) {
    return (p < CTXL) ? b * CTXL + (dir ? (CTXL - 1 - p) : p) : NCTX + b * SEQ + (dir ? (SEQ - 1 - (p - CTXL)) : (p - CTXL));
}
__device__ __forceinline__ void phase_mlstm(Frame& F) {
    const gbf16* Qb = (const gbf16*)(F.ws + WS_Q); const gbf16* Kb = (const gbf16*)(F.ws + WS_K); const gbf16* Vb = (const gbf16*)(F.ws + WS_V);
    const gf32* G = (const gf32*)(F.ws + WS_GATES);
    const int wi = F.bid, b = wi >> 5, hd = (wi >> 2) & 7, dir = (wi >> 1) & 1, half = wi & 1;
    gbf16* HD = (gbf16*)(F.ws + (dir ? WS_HB : WS_HF));
    LAS unsigned char* L = F.lds;
    LAS float* fct = (LAS float*)(L + ML_F); LAS float* frs = fct + 64; LAS float* fwi = frs + 64; LAS float* fem = fwi + 64; LAS float* fsc = fem + 64;
    LAS bf16_t* wkb = (LAS bf16_t*)(fsc + 16); LAS float* fwk = (LAS float*)(wkb + 64);
    const unsigned lane = (unsigned)F.lane; const int w = F.wave, fr = F.lane & 15, fq = F.lane >> 4;
    for (int i = F.tid; i < 144 * ML_CTP / 16; i += NTHR) *(LAS u32x4*)(L + ML_CT + 16 * i) = (u32x4){0u, 0u, 0u, 0u};
    f32x4 cst[9];
#pragma unroll
    for (int v = 0; v < 9; ++v) cst[v] = (f32x4){0.f, 0.f, 0.f, 0.f};
    LAS float* BC = (LAS float*)(L + ML_G); LAS float* RS = BC + 2304; LAS float* CM = RS + 2304; LAS float* BL = CM + 2304; LAS float* CML = BL + 40; LAS float* MST = CML + 40; LAS float* MNW = MST + 40; LAS float* DEC = MNW + 40;
    for (int c = w; c < 36; c += 8) { const int p = 64 * c + F.lane; const size_t gr = (size_t)ml_row(b, dir, p);
        const float li = G[gr * 32 + (2 * dir) * 8 + hd], lf = G[gr * 32 + (2 * dir + 1) * 8 + hd];
        float bc = lf;
#pragma unroll
        for (int o = 1; o < 64; o <<= 1) { const float t = __shfl_up(bc, o); if (F.lane >= o) bc += t; }
        const float rsv = li - bc; float cm = rsv;
#pragma unroll
        for (int o = 1; o < 64; o <<= 1) { const float t = __shfl_up(cm, o); if (F.lane >= o) cm = fmaxf(cm, t); }
        BC[p] = bc; RS[p] = rsv; CM[p] = cm;
        if (F.lane == 63) { BL[c] = bc; CML[c] = cm; } }
    __syncthreads();
    if (F.tid == 0) { float m = -1.0e30f;
        for (int c = 0; c < 36; ++c) { const float bl = BL[c], mn = fmaxf(bl + m, bl + CML[c]); MST[c] = m; MNW[c] = mn; DEC[c] = fast_exp(bl + m - mn); m = mn; } }
    __syncthreads();
    u32x4 gq[2], gk[2], gv[2];
#define ML_LOAD_CHUNK(P0) do { _Pragma("unroll") for (int i = 0; i < 2; ++i) { const int cid = F.tid + 512 * i, row = cid >> 4, ch = cid & 15; const size_t gr = (size_t)ml_row(b, dir, (P0) + row); \
            gq[i] = *(const gu32x4*)(Qb + gr * 1024 + hd * 128 + 8 * ch); gk[i] = *(const gu32x4*)(Kb + gr * 1024 + hd * 128 + 8 * ch); \
            gv[i] = *(const gu32x4*)(Vb + gr * 2048 + hd * 256 + half * 128 + 8 * ch); } } while (0)
    ML_LOAD_CHUNK(0);
#define ML_BAR() do { asm volatile("s_waitcnt lgkmcnt(0)" ::: "memory"); __builtin_amdgcn_s_barrier(); asm volatile("" ::: "memory"); } while (0)
#pragma unroll 1
    for (int c = 0; c < 36; ++c) {
        const int p0 = 64 * c;
        if (F.tid < 64) { const float m_st = MST[c], mnew = MNW[c], bc = BC[p0 + F.tid], rsv = RS[p0 + F.tid], cm = CM[p0 + F.tid];
            const float mrow = bc + fmaxf(m_st, cm), wk = fast_exp(BL[c] + rsv - mnew);
            fct[F.tid] = bc - mrow; frs[F.tid] = rsv; fwi[F.tid] = fast_exp(bc + m_st - mrow); fem[F.tid] = fast_exp(-mrow); fwk[F.tid] = wk;
            if (F.tid == 0) { fsc[0] = DEC[c]; fsc[1] = mnew; } }
#pragma unroll
        for (int i = 0; i < 2; ++i) { const int cid = F.tid + 512 * i, row = cid >> 4, ch = cid & 15; const unsigned o = off_b(row, ch);
            *(LAS u32x4*)(L + ML_Q + o) = gq[i]; *(LAS u32x4*)(L + ML_K + o) = gk[i]; *(LAS u32x4*)(L + ML_V + o) = gv[i]; }
        if (c + 1 < 36) ML_LOAD_CHUNK(p0 + 64);
        ML_BAR();
        const float decay = fsc[0];
#pragma unroll
        for (int v = 0; v < 9; ++v) cst[v] *= decay;
#pragma unroll
        for (int ks = 0; ks < 2; ++ks) {
            const bf16x8 a0 = tr_frag(L + ML_K, lane, (unsigned)w, ks);
            const f32x4 wk0 = *(const LAS f32x4*)(fwk + 32 * ks + 8 * fq), wk1 = *(const LAS f32x4*)(fwk + 32 * ks + 8 * fq + 4);
            bf16x8 a;
            { const unsigned p0 = cvt_pk_bf16(__uint_as_float((unsigned)(unsigned short)a0[0] << 16) * wk0[0], __uint_as_float((unsigned)(unsigned short)a0[1] << 16) * wk0[1]);
              const unsigned p1 = cvt_pk_bf16(__uint_as_float((unsigned)(unsigned short)a0[2] << 16) * wk0[2], __uint_as_float((unsigned)(unsigned short)a0[3] << 16) * wk0[3]);
              const unsigned p2 = cvt_pk_bf16(__uint_as_float((unsigned)(unsigned short)a0[4] << 16) * wk1[0], __uint_as_float((unsigned)(unsigned short)a0[5] << 16) * wk1[1]);
              const unsigned p3 = cvt_pk_bf16(__uint_as_float((unsigned)(unsigned short)a0[6] << 16) * wk1[2], __uint_as_float((unsigned)(unsigned short)a0[7] << 16) * wk1[3]);
              a = __builtin_bit_cast(bf16x8, (u32x4){p0, p1, p2, p3}); }
#pragma unroll
            for (int v = 0; v < 8; ++v) { const bf16x8 bb = tr_frag(L + ML_V, lane, v, ks); cst[v] = __builtin_amdgcn_mfma_f32_16x16x32_bf16(a, bb, cst[v], 0, 0, 0); }
            const bf16x8 ba = (bf16x8){(short)0x3F80, (short)0x3F80, (short)0x3F80, (short)0x3F80, (short)0x3F80, (short)0x3F80, (short)0x3F80, (short)0x3F80};
            cst[8] = __builtin_amdgcn_mfma_f32_16x16x32_bf16(a, ba, cst[8], 0, 0, 0);
        }
        if (c >= 4) {
            const int tt = w >> 1;
            bf16x8 qf[4];
#pragma unroll
            for (int ks = 0; ks < 4; ++ks) qf[ks] = *(const LAS bf16x8*)(L + ML_Q + rowrd16(lane, tt, ks));
            const int t = 16 * tt + fr; const float ctt = fct[t];
#pragma unroll
            for (int si = 0; si < 2; ++si) { const int st = 2 * (w & 1) + si; f32x4 acc = (f32x4){0.f, 0.f, 0.f, 0.f};
                if (st <= tt)
#pragma unroll
                for (int ks = 0; ks < 4; ++ks) { const bf16x8 kf = *(const LAS bf16x8*)(L + ML_K + rowrd16(lane, st, ks)); acc = __builtin_amdgcn_mfma_f32_16x16x32_bf16(kf, qf[ks], acc, 0, 0, 0); }
                const int s0 = 16 * st + 4 * fq; float sv[4];
#pragma unroll
                for (int j = 0; j < 4; ++j) sv[j] = (s0 + j <= t) ? acc[j] * fast_exp(ctt + frs[s0 + j]) : 0.f;
                u32x2 o; o.x = cvt_pk_bf16(sv[0], sv[1]); o.y = cvt_pk_bf16(sv[2], sv[3]);
                *(LAS u32x2*)(L + ML_S + t * ML_SP + s0 * 2) = o; }
        }
        ML_BAR();
        if (c >= 4) {
            const int tt = w >> 1;
            f32x4 sv[5], qc[5];
#pragma unroll
            for (int i = 0; i < 5; ++i) { sv[i] = (f32x4){0.f, 0.f, 0.f, 0.f}; qc[i] = (f32x4){0.f, 0.f, 0.f, 0.f}; }
#pragma unroll
            for (int ks = 0; ks < 2; ++ks) { const bf16x8 a = *(const LAS bf16x8*)(L + ML_S + (fr + 16 * tt) * ML_SP + (32 * ks + 8 * fq) * 2);
#pragma unroll
                for (int i = 0; i < 4; ++i) { const bf16x8 bb = tr_frag(L + ML_V, lane, 4 * (w & 1) + i, ks); sv[i] = __builtin_amdgcn_mfma_f32_16x16x32_bf16(a, bb, sv[i], 0, 0, 0); }
                const bf16x8 bo = (bf16x8){(short)0x3F80, (short)0x3F80, (short)0x3F80, (short)0x3F80, (short)0x3F80, (short)0x3F80, (short)0x3F80, (short)0x3F80};
                sv[4] = __builtin_amdgcn_mfma_f32_16x16x32_bf16(a, bo, sv[4], 0, 0, 0); }
#pragma unroll
            for (int ks = 0; ks < 4; ++ks) { const bf16x8 a = *(const LAS bf16x8*)(L + ML_Q + rowrd16(lane, tt, ks));
#pragma unroll
                for (int i = 0; i < 5; ++i) { const int vt = (i < 4) ? 4 * (w & 1) + i : 8;
                    const bf16x8 bb = *(const LAS bf16x8*)(L + ML_CT + (fr + 16 * vt) * ML_CTP + (32 * ks + 8 * fq) * 2); qc[i] = __builtin_amdgcn_mfma_f32_16x16x32_bf16(a, bb, qc[i], 0, 0, 0); } }
#pragma unroll
            for (int j = 0; j < 4; ++j) { const int tl = 16 * tt + 4 * fq + j; const float wi_ = fwi[tl], em = fem[tl];
                const float den = sv[4][j] + wi_ * qc[4][j];
                const float inv = 1.0f / fmaxf(fabsf(den), em);
                LAS bf16_t* op = (LAS bf16_t*)(L + ML_VW) + tl * 128 + fr;
#pragma unroll
                for (int i = 0; i < 4; ++i) { const float h = (sv[i][j] + wi_ * qc[i][j]) * inv; op[16 * (4 * (w & 1) + i)] = (bf16_t)(cvt_pk_bf16(h, 0.f) & 0xffffu); } }
        }
        ML_BAR();
        if (c >= 4) {
#pragma unroll
            for (int i = 0; i < 2; ++i) { const int cid = F.tid + 512 * i, row = cid >> 4, ch = cid & 15; const size_t rr = (size_t)(ml_row(b, dir, p0 + row) - NCTX);
                *(gu32x4*)(HD + rr * D + hd * 256 + half * 128 + 8 * ch) = *(const LAS u32x4*)(L + ML_VW + row * 256 + 16 * ch); } }
#pragma unroll
        for (int v = 0; v < 9; ++v) { u32x2 o; o.x = cvt_pk_bf16(cst[v][0], cst[v][1]); o.y = cvt_pk_bf16(cst[v][2], cst[v][3]);
            *(LAS u32x2*)(L + ML_CT + (16 * v + fr) * ML_CTP + (16 * w + 4 * fq) * 2) = o; }
    }
    __syncthreads();
}

constexpr int N_PHASES = 19;
#ifndef PHASE_MASK
#define PHASE_MASK 0x7ffff
#endif
__global__ void __launch_bounds__(NTHR, 2) fwd(Args args) {
    extern __shared__ __attribute__((aligned(16))) unsigned char lds_raw[];
    if (threadIdx.x < 4) ((LAS unsigned*)((LAS unsigned char*)lds_raw + LDSCTL_OFF))[threadIdx.x] = 0u;
    __syncthreads();
#if !MK_PER_PHASE
    XcdBarrier bar = xcd_barrier_post((unsigned*)(args.ws + WS_CTL) + CW_BAR + args.li * 4096, (volatile LAS unsigned*)((LAS unsigned char*)lds_raw + LDSCTL_OFF));
#define SEAM(k) do { if (IN(k) && IN((k) + 1)) xcd_barrier(bar); } while (0)
#else
#define SEAM(k) do { } while (0)
#endif
    const int lo = args.ph_lo, hi = args.ph_hi;
#define IN(k) (((PHASE_MASK >> (k)) & 1) && lo <= (k) && (k) < hi)
#ifndef REPEAT_MASK
#define REPEAT_MASK 0
#endif
#ifndef REPEAT_N
#define REPEAT_N 1
#endif
#define REP(k) for (int rep_ = 0; rep_ < ((((REPEAT_MASK) >> (k)) & 1) ? (REPEAT_N) : 1); ++rep_, __syncthreads())
#define PHASE_FRAME() Frame F; gu8* ws; { gu8* w_ = (gu8*)args.ws; asm volatile("" : "+s"(w_)); int t_ = threadIdx.x; asm volatile("" : "+v"(t_)); ws = w_; \
        F.lds = (LAS unsigned char*)lds_raw; F.tid = t_; F.lane = t_ & 63; F.wave = __builtin_amdgcn_readfirstlane(t_ >> 6); F.bid = blockIdx.x; F.a = &args; F.out = (gf32*)args.out; F.ws = w_; }

    if (IN(0)) REP(0) { PHASE_FRAME(); (void)ws; phase_prologue(F); } SEAM(0);
    if (IN(1)) REP(1) { PHASE_FRAME(); (void)ws; phase_norm0(F); } SEAM(1);
    if (IN(2)) REP(2) { PHASE_FRAME(); pg8::DenseOrder S; S.init(ws + WS_H, ws + WS_CONVIN_T, NTOK, 3 * D, D, GRID, F.bid);
        EpiConvIn E{(gbf16*)(ws + WS_U), (gbf16*)(ws + WS_BM)};
        pg8::gemm_phase<EpiConvIn, pg8::DenseOrder, false>(F.lds, D, S, E); } SEAM(2);
    if (IN(3)) REP(3) { PHASE_FRAME(); (void)ws; phase_conv(F); } SEAM(3);
    if (IN(4)) REP(4) { PHASE_FRAME(); pg8::DenseOrder S; S.init(ws + WS_Z, ws + WS_CONVOUT_T, NTOK, D, D, GRID, F.bid);
        EpiResidT<false, true> E{INP(IN_CTX), INP(IN_X), (gf32*)(ws + WS_X), mod_ptr(F, 0, 0, 2), 0};
        pg8::gemm_phase<EpiResidT<false, true>, pg8::DenseOrder, false>(F.lds, D, S, E); } SEAM(4);
    if (IN(5)) REP(5) { PHASE_FRAME(); phase_router(F, 0, 0, NTOK / GRID, (const gbf16*)(ws + WS_X), 0); } SEAM(5);
    if (IN(6)) REP(6) { PHASE_FRAME(); (void)ws; phase_scatter(F, 0, NTOK / GRID, NTOK); } SEAM(6);
    if (IN(7)) REP(7) { PHASE_FRAME(); ExpertOrder S{stage_units(F, (const gi32x4*)(ws + RT_UNITS1) + F.bid * MAXU1, MAXU1), (const gchar*)(ws + WS_H8), (const gchar*)(ws + WS_MOE0 + MOE_GU), (const gi32*)(ws + RT_TOKOF), D / 2, 1024};
        EpiSwiglu E{(gu8*)(ws + WS_ACT)};
        pg8::gemm_phase<EpiSwiglu, ExpertOrder, true, true>(F.lds, D / 2, S, E); } SEAM(7);
    if (IN(8)) REP(8) { PHASE_FRAME(); ExpertOrder S{stage_units(F, (const gi32x4*)(ws + RT_UNITS2) + F.bid * MAXU2, MAXU2), (const gchar*)(ws + WS_ACT), (const gchar*)(ws + WS_MOE0 + MOE_DN), nullptr, ED / 2, 2048};
        EpiDown E{(gu8*)(ws + WS_Y)};
        pg8::gemm_phase<EpiDown, ExpertOrder, false, true>(F.lds, ED / 2, S, E); } SEAM(8);
    if (IN(9)) REP(9) { PHASE_FRAME(); (void)ws; phase_combine0_gates(F); } SEAM(9);
    if (IN(10)) REP(10) { PHASE_FRAME(); pg8::DenseOrder S; S.init(ws + WS_H, ws + WS_MLIN_T, NTOK, 3 * D, D, GRID, F.bid);
        EpiMlstmIn E{(gbf16*)(ws + WS_Q), (gbf16*)(ws + WS_K), (gbf16*)(ws + WS_V), (gbf16*)(ws + WS_O)};
        pg8::gemm_phase<EpiMlstmIn, pg8::DenseOrder, false>(F.lds, D, S, E); } SEAM(10);
    if (IN(11)) REP(11) { PHASE_FRAME(); (void)ws; phase_mlstm(F); } SEAM(11);
    if (IN(12)) REP(12) { PHASE_FRAME(); (void)ws; phase_headnorm(F); } SEAM(12);
    if (IN(13)) REP(13) { PHASE_FRAME(); pg8::DenseOrder S; S.init(ws + WS_YIN, ws + WS_MLOUT_T, NLAT, D, D, GRID, F.bid);
        gf32* X = (gf32*)(ws + WS_X);
        EpiResidT<true> E{X, (const gf32*)(ws + WS_XB), X, mod_ptr(F, 1, 0, 2), NCTX};
        pg8::gemm_phase<EpiResidT<true>, pg8::DenseOrder, false>(F.lds, D, S, E); } SEAM(13);
    if (IN(14)) REP(14) { PHASE_FRAME(); phase_router(F, 1, NCTX, NLAT / GRID, (const gbf16*)(ws + WS_XB), NCTX); } SEAM(14);
    if (IN(15)) REP(15) { PHASE_FRAME(); (void)ws; phase_scatter(F, NCTX, NLAT / GRID, NLAT); } SEAM(15);
    if (IN(16)) REP(16) { PHASE_FRAME(); ExpertOrder S{stage_units(F, (const gi32x4*)(ws + RT_UNITS1) + F.bid * MAXU1, MAXU1), (const gchar*)(ws + WS_H8), (const gchar*)(ws + WS_MOE0 + MOE_STRIDE + MOE_GU), (const gi32*)(ws + RT_TOKOF), D / 2, 1024};
        EpiSwiglu E{(gu8*)(ws + WS_ACT)};
        pg8::gemm_phase<EpiSwiglu, ExpertOrder, true, true>(F.lds, D / 2, S, E); } SEAM(16);
    if (IN(17)) REP(17) { PHASE_FRAME(); ExpertOrder S{stage_units(F, (const gi32x4*)(ws + RT_UNITS2) + F.bid * MAXU2, MAXU2), (const gchar*)(ws + WS_ACT), (const gchar*)(ws + WS_MOE0 + MOE_STRIDE + MOE_DN), nullptr, ED / 2, 2048};
        EpiDown E{(gu8*)(ws + WS_Y)};
        pg8::gemm_phase<EpiDown, ExpertOrder, false, true>(F.lds, ED / 2, S, E); } SEAM(17);
    if (IN(18)) REP(18) { PHASE_FRAME(); (void)ws; phase_combine<1>(F); }
#undef IN
#undef SEAM
}

extern "C" void kernel_launch(void* const* d_in, const int* in_sizes, int n_in, void* d_out, int out_size, void* d_ws, size_t ws_size, hipStream_t stream) {
    static int ready = 0;
    if (ready == 0) {
        if (n_in != N_IN || out_size != NLAT * D || ws_size < WS_END) { fprintf(stderr, "kernel_launch: unexpected problem shape (n_in %d, out %d, ws %zu)\n", n_in, out_size, ws_size); ready = -1; return; }
        if (hipFuncSetAttribute((const void*)fwd, hipFuncAttributeMaxDynamicSharedMemorySize, LDS_BYTES) != hipSuccess) { fprintf(stderr, "kernel_launch: hipFuncSetAttribute failed\n"); ready = -1; return; }
        int per_cu = 0;
        if (hipOccupancyMaxActiveBlocksPerMultiprocessor(&per_cu, (const void*)fwd, NTHR, LDS_BYTES) != hipSuccess || per_cu < 1) fprintf(stderr, "kernel_launch: note: occupancy query reports %d blocks per CU\n", per_cu);
        (void)hipGetLastError();
        ready = 1;
    }
    if (ready < 0) return;
    (void)hipMemsetAsync((char*)d_ws + WS_CTL, 0, CTL_BYTES, stream);
    Args a{};
    for (int i = 0; i < N_IN; ++i) a.in[i] = (const float*)d_in[i];
    a.out = (float*)d_out; a.ws = (unsigned char*)d_ws; a.pad = 0;
#if MK_PER_PHASE
    for (int p = 0; p < N_PHASES; ++p) { a.ph_lo = p; a.ph_hi = p + 1; a.li = 0; hipLaunchKernelGGL(fwd, dim3(GRID), dim3(NTHR), LDS_BYTES, stream, a); }
#else
    a.ph_lo = 0; a.ph_hi = N_PHASES; a.li = 0;
    hipLaunchKernelGGL(fwd, dim3(GRID), dim3(NTHR), LDS_BYTES, stream, a);
#endif
}
```
